# Optimizing an MI355X kernel written in HIP

```python
import jax, jax.numpy as jnp
from jax import lax
import numpy as np

D_MODEL = 1024
BATCH = 8
SEQ = 2048
DEPTH = 1
DEC_BATCH = 8
DEC_SEQ = 8192
PAST_LEN = 128

HEAD_DIM = 64
A_HEADS = 8
A_KV_HEADS = 2
A_WINDOW = 128
B_GROUPS = ((128, 1), (512, 4), (2048, 16))
B_HEADS_PER_GROUP = 4
B_HEADS = B_HEADS_PER_GROUP * len(B_GROUPS)
N_BIAS_HEADS = A_HEADS + B_HEADS
REL_BUCKETS = 32
REL_MAX_DISTANCE = 1024
D_FF = 4 * D_MODEL
A_Q = A_HEADS * HEAD_DIM
A_KV = A_KV_HEADS * HEAD_DIM
B_W = B_HEADS * HEAD_DIM
B_OUT = B_HEADS_PER_GROUP * HEAD_DIM
IN_COLS = A_Q + 2 * A_KV + 3 * B_W + 2 * D_MODEL
RMS_EPS = 1e-6
NEG_INF = -1e30

kernel_name = 'hybrid_gated_window_dilated_encoder'


def _rmsnorm(x, g):
    x32 = x.astype(jnp.float32)
    y = x32 * lax.rsqrt(jnp.mean(x32 * x32, axis=-1, keepdims=True) + RMS_EPS)
    return (y * g.astype(jnp.float32)).astype(x.dtype)


def _rel_bucket(rel):
    half = REL_BUCKETS // 2
    max_exact = half // 2
    n = np.abs(rel)
    large = max_exact + (np.log(np.maximum(n, 1) / max_exact)
                         / np.log(REL_MAX_DISTANCE / max_exact) * (half - max_exact)).astype(np.int32)
    large = np.minimum(large, half - 1)
    return (np.where(rel > 0, half, 0) + np.where(n < max_exact, n, large)).astype(np.int32)


def _banded_attention(q, k, v, n, dist_scale, bias_table, sink):
    b, L, H, dh = q.shape
    G = k.shape[2]
    r = H // G
    nb = -(-L // n)
    Lp = nb * n
    qb = jnp.pad(q, ((0, 0), (0, Lp - L), (0, 0), (0, 0))).reshape(b, nb, n, G, r, dh)
    kv_pad = ((0, 0), (n, Lp - L + n), (0, 0), (0, 0))
    kp = jnp.pad(k, kv_pad).reshape(b, nb + 2, n, G, dh)
    vp = jnp.pad(v, kv_pad).reshape(b, nb + 2, n, G, dh)
    kb = jnp.concatenate([kp[:, :-2], kp[:, 1:-1], kp[:, 2:]], axis=2)
    vb = jnp.concatenate([vp[:, :-2], vp[:, 1:-1], vp[:, 2:]], axis=2)
    s = jnp.einsum('bnqgrd,bnkgd->bngrqk', qb, kb).astype(jnp.float32) * (dh ** -0.5)
    rel = np.arange(3 * n)[None, :] - n - np.arange(n)[:, None]
    bias = bias_table.astype(jnp.float32)[_rel_bucket(rel * dist_scale)]
    bias = jnp.transpose(bias.reshape(n, 3 * n, G, r), (2, 3, 0, 1))
    kpos = np.arange(nb)[:, None] * n + np.arange(3 * n)[None, :] - n
    valid = (np.abs(rel) <= n)[None] & ((kpos >= 0) & (kpos < L))[:, None, :]
    logits = jnp.where(valid[None, :, None, None], s + bias, NEG_INF)
    m = jnp.max(logits, axis=-1)
    if sink is not None:
        sink_r = sink.astype(jnp.float32).reshape(G, r)[..., None]
        m = jnp.maximum(m, sink_r)
    p = jnp.exp(logits - m[..., None])
    denom = jnp.sum(p, axis=-1)
    if sink is not None:
        denom = denom + jnp.exp(sink_r - m)
    o = jnp.einsum('bngrqk,bnkgd->bnqgrd', p.astype(vb.dtype), vb).astype(jnp.float32)
    o = o / jnp.transpose(denom, (0, 1, 4, 2, 3))[..., None]
    o = o.reshape(b, Lp, H, dh)[:, :L].astype(q.dtype)
    lse = jnp.transpose(m + jnp.log(denom), (0, 1, 4, 2, 3)).reshape(b, Lp, H)[:, :L]
    return o, lse


def _to_residues(t, dil):
    b, S = t.shape[:2]
    t = jnp.moveaxis(t.reshape((b, S // dil, dil) + t.shape[2:]), 2, 1)
    return t.reshape((b * dil, S // dil) + t.shape[3:])


def _from_residues(t, dil):
    bd, L = t.shape[:2]
    t = jnp.moveaxis(t.reshape((bd // dil, dil, L) + t.shape[2:]), 1, 2)
    return t.reshape((bd // dil, L * dil) + t.shape[3:])


def _dilated_mixture(q, k, v, bias_b):
    b, S, _, dh = q.shape
    outs, lses = [], []
    for gi, (window, dil) in enumerate(B_GROUPS):
        hs = slice(gi * B_HEADS_PER_GROUP, (gi + 1) * B_HEADS_PER_GROUP)
        o, lse = _banded_attention(_to_residues(q[:, :, hs], dil), _to_residues(k[:, :, hs], dil),
                                   _to_residues(v[:, :, hs], dil), window // (2 * dil), dil,
                                   bias_b[:, hs], None)
        outs.append(_from_residues(o, dil))
        lses.append(_from_residues(lse, dil))
    alpha = jax.nn.softmax(jnp.stack(lses), axis=0)
    o = jnp.sum(alpha[..., None] * jnp.stack(outs).astype(jnp.float32), axis=0)
    return o.astype(q.dtype).reshape(b, S, B_OUT)


def _layer(x, rel_bias, g_mix, w_in, b_gate, w_branch_a, w_branch_b, w_out, sink, g_mlp, w_up, w_down):
    b, S, _ = x.shape
    h = _rmsnorm(x, g_mix)
    z = h @ w_in
    o1 = A_Q
    o2 = o1 + A_KV
    o3 = o2 + A_KV
    o4 = o3 + B_W
    o5 = o4 + B_W
    o6 = o5 + B_W
    qa = z[..., :o1].reshape(b, S, A_HEADS, HEAD_DIM)
    ka = z[..., o1:o2].reshape(b, S, A_KV_HEADS, HEAD_DIM)
    va = z[..., o2:o3].reshape(b, S, A_KV_HEADS, HEAD_DIM)
    qb = z[..., o3:o4].reshape(b, S, B_HEADS, HEAD_DIM)
    kb = z[..., o4:o5].reshape(b, S, B_HEADS, HEAD_DIM)
    vb = z[..., o5:o6].reshape(b, S, B_HEADS, HEAD_DIM)
    gates = jax.nn.sigmoid((z[..., o6:] + b_gate).astype(jnp.float32)).astype(x.dtype)
    gates = gates.reshape(b, S, 2, D_MODEL)
    o_a, _ = _banded_attention(qa, ka, va, A_WINDOW, 1, rel_bias[:, :A_HEADS], sink)
    o_b = _dilated_mixture(qb, kb, vb, rel_bias[:, A_HEADS:])
    merged = gates[:, :, 0] * (o_a.reshape(b, S, A_Q) @ w_branch_a) + gates[:, :, 1] * (o_b @ w_branch_b)
    x = x + merged @ w_out
    h = _rmsnorm(x, g_mlp)
    return x + jnp.square(jax.nn.relu(h @ w_up)) @ w_down


def _encoder(x, rel_bias, g_mix, w_in, b_gate, w_branch_a, w_branch_b, w_out, attn_sink, g_mlp, w_up, w_down, g_final):
    for l in range(DEPTH):
        x = _layer(x, rel_bias, g_mix[l], w_in[l], b_gate[l], w_branch_a[l], w_branch_b[l], w_out[l],
                   attn_sink[l], g_mlp[l], w_up[l], w_down[l])
    return _rmsnorm(x, g_final)


def setup_inputs(seed: int = 0) -> dict:
    key = jax.random.key(seed)
    ks = jax.random.split(key, 14)

    def nrm(k, shape, scale):
        return scale * jax.random.normal(k, shape, jnp.float32)

    return {
        'x_prompt': nrm(ks[0], (BATCH, SEQ, D_MODEL), 1.0),
        'x_sample': nrm(ks[1], (DEC_BATCH, DEC_SEQ, D_MODEL), 1.0),
        'rel_bias': nrm(ks[2], (REL_BUCKETS, N_BIAS_HEADS), 0.5),
        'g_mix': 1.0 + nrm(ks[3], (DEPTH, D_MODEL), 0.05),
        'w_in': nrm(ks[4], (DEPTH, D_MODEL, IN_COLS), D_MODEL ** -0.5),
        'b_gate': nrm(ks[5], (DEPTH, 2 * D_MODEL), 0.1),
        'w_branch_a': nrm(ks[6], (DEPTH, A_Q, D_MODEL), A_Q ** -0.5),
        'w_branch_b': nrm(ks[7], (DEPTH, B_OUT, D_MODEL), B_OUT ** -0.5),
        'w_out': nrm(ks[8], (DEPTH, D_MODEL, D_MODEL), D_MODEL ** -0.5),
        'attn_sink': nrm(ks[9], (DEPTH, A_HEADS), 0.5),
        'g_mlp': 1.0 + nrm(ks[10], (DEPTH, D_MODEL), 0.05),
        'w_up': nrm(ks[11], (DEPTH, D_MODEL, D_FF), D_MODEL ** -0.5),
        'w_down': nrm(ks[12], (DEPTH, D_FF, D_MODEL), D_FF ** -0.5),
        'g_final': 1.0 + nrm(ks[13], (D_MODEL,), 0.05),
    }


def reference(x_prompt, x_sample, rel_bias, g_mix, w_in, b_gate, w_branch_a, w_branch_b, w_out,
              attn_sink, g_mlp, w_up, w_down, g_final):
    y_prompt = _encoder(x_prompt, rel_bias, g_mix, w_in, b_gate, w_branch_a, w_branch_b, w_out,
                        attn_sink, g_mlp, w_up, w_down, g_final)
    y_sample = _encoder(x_sample, rel_bias, g_mix, w_in, b_gate, w_branch_a, w_branch_b, w_out,
                        attn_sink, g_mlp, w_up, w_down, g_final)
    return (y_prompt, y_sample)
```

```cpp
#include <hip/hip_runtime.h>
#include <hip/hip_cooperative_groups.h>
#include <cstdio>
#include <cstdint>
namespace cg = cooperative_groups;
namespace pg8 {
#define PG8_LAS __attribute__((address_space(3)))
typedef unsigned short bf16_t;
typedef short bf16x8 __attribute__((ext_vector_type(8)));
typedef float f32x4 __attribute__((ext_vector_type(4)));
typedef unsigned u32x4 __attribute__((ext_vector_type(4)));
constexpr int BM = 256, BK = 64, HALF = 128, HTB = HALF * BK * 2  , STAGE_BYTES = 8 * HTB, NXCD = 8, WGM = 8;

__host__ __device__ __forceinline__ int lds_byte(int r, int c) { const int st = (r >> 4) * 2 + (c >> 5), rr = r & 15, cc = c & 31, ob = rr * 64 + cc * 2; return st * 1024 + (ob ^ (((ob >> 9) & 1) << 5)); }
__host__ __device__ __forceinline__ void stage_rc(int b, int& R, int& C) { const int st = b / 1024, sb = b % 1024, swz = sb ^ (((sb >> 9) & 1) << 5); R = (st >> 1) * 16 + swz / 64; C = (st & 1) * 32 + (swz % 64) / 2; }
__host__ __device__ __forceinline__ int perm32(int rho) { const int n = rho >> 4, i = rho & 15; return 8 * (i >> 2) + 4 * n + (i & 3); }

struct Unit { int pm, pn; };
struct Gemm { const bf16_t* A; const bf16_t* Bt; int M, N, K; };

struct StaticOrder {
    int nM, nN, nwg, G, c;
    __host__ __device__ void init(int M, int N, int G_, int c_) { nM = M / BM; nN = N / BM; nwg = nM * nN; G = G_; c = c_; }
    __host__ __device__ bool next(int i, Unit& u) const {
        const long L = (long)i * G + c; if (L >= nwg) return false;
        int wgid = (int)L; { const int q = nwg / NXCD, r = nwg % NXCD, xcd = wgid % NXCD, off = wgid / NXCD; wgid = (xcd < r ? xcd * (q + 1) : r * (q + 1) + (xcd - r) * q) + off; }
        const int nig = WGM * nN, gid = wgid / nig, fm = gid * WGM, gsz = (nM - fm) < WGM ? (nM - fm) : WGM;
        u.pm = fm + ((wgid % nig) % gsz); u.pn = (wgid % nig) / gsz; return true;
    }
    __device__ __forceinline__ void a_ready(const Unit&) const {}
    __device__ __forceinline__ void done(const Unit&) const {}
};

typedef float f32x2c_t __attribute__((ext_vector_type(2))); typedef __bf16 bf16x2c_t __attribute__((ext_vector_type(2)));
__device__ __forceinline__ unsigned cvt_pk_bf16(float lo, float hi) { const f32x2c_t v = {lo, hi}; const bf16x2c_t b = __builtin_convertvector(v, bf16x2c_t); return __builtin_bit_cast(unsigned, b); }
typedef float f32x2 __attribute__((ext_vector_type(2)));
__device__ __forceinline__ f32x2 gelu_pk(f32x2 v) {
    const f32x2 av = __builtin_elementwise_abs(v), d = av * 0.2316418882f + 1.0f;
    f32x2 t; t.x = __builtin_amdgcn_rcpf(d.x); t.y = __builtin_amdgcn_rcpf(d.y);
    f32x2 q = t * 0.5307027145f + (-0.7265760135f); q = q * t + 0.7107068705f; q = q * t + (-0.142248368f); q = q * t + 0.127414796f; q = q * t;
    const f32x2 s = (v * v) * (-0.72134752044f);
    f32x2 e; e.x = __builtin_amdgcn_exp2f(s.x); e.y = __builtin_amdgcn_exp2f(s.y);
    const f32x2 m = v * (q * e), r = v - m;
    f32x2 o; o.x = v.x < 0.f ? m.x : r.x; o.y = v.y < 0.f ? m.y : r.y; return o;
}

template <int ACT  > struct EpiBf16 {
    static constexpr bool PERM = true, AFTER_DRAIN = false; static_assert(ACT == 0 || ACT == 1, "EpiBf16: ACT is 0 (none) or 1 (gelu_pk)");
    bf16_t* O; int ldc; const float* bias; int split_cols; size_t split_stride; float scale0;
    __device__ __forceinline__ void operator()(const f32x4 (&acc)[2][2][4][2], const Unit& u, int wr, int wc, int fr, int fq) const {
        const int row0 = u.pm * BM + wr * 64 + fr; int colt = u.pn * BM; bf16_t* base = O;
        float sc = 1.f; if (split_cols) { const int t = colt / split_cols; base += (size_t)t * split_stride; colt -= t * split_cols; if (t == 0) sc = scale0; }
        const int col0 = colt + wc * 32 + 8 * fq, bcol0 = u.pn * BM + wc * 32 + 8 * fq;
        f32x4 bv[2][2];
#pragma unroll
        for (int bj = 0; bj < 2; ++bj)
#pragma unroll
            for (int n = 0; n < 2; ++n) bv[bj][n] = bias ? *(const f32x4*)(bias + bcol0 + bj * HALF + 4 * n) : (f32x4){0.f, 0.f, 0.f, 0.f};
#pragma unroll
        for (int ai = 0; ai < 2; ++ai)
#pragma unroll
            for (int m = 0; m < 4; ++m) { bf16_t* rowp = base + (size_t)(row0 + ai * HALF + m * 16) * ldc + col0;
#pragma unroll
                for (int bj = 0; bj < 2; ++bj) { f32x4 v0 = acc[ai][bj][m][0] + bv[bj][0], v1 = acc[ai][bj][m][1] + bv[bj][1];
                    if (ACT == 1) { f32x2 a = gelu_pk((f32x2){v0[0], v0[1]}), b = gelu_pk((f32x2){v0[2], v0[3]}), c = gelu_pk((f32x2){v1[0], v1[1]}), d = gelu_pk((f32x2){v1[2], v1[3]});
                        v0 = (f32x4){a.x, a.y, b.x, b.y}; v1 = (f32x4){c.x, c.y, d.x, d.y}; }
                    v0 = v0 * sc; v1 = v1 * sc; u32x4 w; w.x = cvt_pk_bf16(v0[0], v0[1]); w.y = cvt_pk_bf16(v0[2], v0[3]); w.z = cvt_pk_bf16(v1[0], v1[1]); w.w = cvt_pk_bf16(v1[2], v1[3]);
                    *(u32x4*)(rowp + bj * HALF) = w; } }
    }
};
template <class Epi, class Sched, bool ALIGN_EPI = false, bool SP2 = false>
__device__ __forceinline__ void gemm_phase(PG8_LAS unsigned char* lds, const Gemm g, const Sched& S, const Epi& E) {
    int tid_l = threadIdx.x; asm volatile("" : "+v"(tid_l));
    const int tid = tid_l, wid = __builtin_amdgcn_readfirstlane(tid >> 6), lane = tid & 63, wr = wid >> 2, wc = wid & 3, fr = lane & 15, fq = lane >> 4;
    const int K = g.K, nt = K / BK;
    unsigned voffA[2], voffB[2];
#pragma unroll
    for (int i = 0; i < 2; ++i) { int R, C; stage_rc(tid * 16 + i * 8192, R, C); const int Rb = Epi::PERM ? ((R & ~31) + perm32(R & 31)) : R;
        voffA[i] = (unsigned)(R * K + C) * 2u; voffB[i] = (unsigned)(Rb * K + C) * 2u; }
    const size_t kstep = (size_t)(BK * 2);
    const size_t hstep = (size_t)HALF * K * 2;
    const size_t tstep = 2 * hstep;
    const unsigned ldsw = (unsigned)wid * 1024u;
    const int aoff = lds_byte(wr * 64 + fr, fq * 8), boff = lds_byte(wc * 32 + fr, fq * 8);
#define PG8_SA(b, h) (((b) * 2 + (h)) * HTB)
#define PG8_SB(b, h) ((4 + (b) * 2 + (h)) * HTB)
#define PG8_STAGE(bufoff, gbase, voff) do { _Pragma("unroll") for (int _i = 0; _i < 2; ++_i) \
        __builtin_amdgcn_global_load_lds((const unsigned*)((const char*)(gbase) + (voff)[_i]), (PG8_LAS unsigned*)(lds + (bufoff) + ldsw + _i * 8192), 16, 0, 0); } while (0)
#define PG8_LDA(dst, b, h) do { _Pragma("unroll") for (int m = 0; m < 4; ++m) _Pragma("unroll") for (int k = 0; k < 2; ++k) dst[m][k] = *(const PG8_LAS bf16x8*)(lds + PG8_SA(b, h) + aoff + m * 2048 + k * 1024); } while (0)
#define PG8_LDB(dst, b, h) do { _Pragma("unroll") for (int n = 0; n < 2; ++n) _Pragma("unroll") for (int k = 0; k < 2; ++k) dst[n][k] = *(const PG8_LAS bf16x8*)(lds + PG8_SB(b, h) + boff + n * 2048 + k * 1024); } while (0)
#define PG8_MMA(ai, bj, At, Bt) do { __builtin_amdgcn_s_setprio(1); _Pragma("unroll") for (int m = 0; m < 4; ++m) _Pragma("unroll") for (int n = 0; n < 2; ++n) _Pragma("unroll") for (int k = 0; k < 2; ++k) \
        acc[ai][bj][m][n] = __builtin_amdgcn_mfma_f32_16x16x32_bf16(Bt[n][k], At[m][k], acc[ai][bj][m][n], 0, 0, 0); __builtin_amdgcn_s_setprio(0); } while (0)
#define PG8_WAIT_V(n) asm volatile("s_waitcnt vmcnt(" #n ")" ::: "memory")
#define PG8_WAIT_L(n) asm volatile("s_waitcnt lgkmcnt(" #n ")" ::: "memory")
#define PG8_BAR __builtin_amdgcn_s_barrier()
#define PG8_SCHED __builtin_amdgcn_sched_barrier(0)
    Unit cur, nxt; int ui = 0;
    if (!S.next(0, cur)) return;
    f32x4 acc[2][2][4][2];
#pragma unroll
    for (int a = 0; a < 2; ++a)
#pragma unroll
        for (int b = 0; b < 2; ++b)
#pragma unroll
            for (int m = 0; m < 4; ++m)
#pragma unroll
                for (int n = 0; n < 2; ++n) acc[a][b][m][n] = (f32x4){0.f, 0.f, 0.f, 0.f};
    bf16x8 At[4][2], B0[2][2], B1[2][2];
    const char* cA = (const char*)g.A + (size_t)cur.pm * tstep; const char* cB = (const char*)g.Bt + (size_t)cur.pn * tstep;
    S.a_ready(cur);
    if constexpr (SP2) {
        PG8_STAGE(PG8_SB(0, 0), cB, voffB); PG8_STAGE(PG8_SB(0, 1), cB + hstep, voffB); PG8_STAGE(PG8_SA(0, 0), cA, voffA); PG8_STAGE(PG8_SA(0, 1), cA + hstep, voffA);
        if (wr == 1) PG8_BAR;
        PG8_WAIT_V(2); PG8_BAR;
        PG8_STAGE(PG8_SB(1, 0), cB + kstep, voffB); PG8_STAGE(PG8_SA(1, 0), cA + kstep, voffA); PG8_STAGE(PG8_SB(1, 1), cB + hstep + kstep, voffB);
        PG8_WAIT_V(6); PG8_BAR;
    } else {
        PG8_STAGE(PG8_SB(0, 0), cB, voffB); PG8_STAGE(PG8_SA(0, 0), cA, voffA); PG8_STAGE(PG8_SB(0, 1), cB + hstep, voffB); PG8_STAGE(PG8_SA(0, 1), cA + hstep, voffA);
        if (wr == 1) PG8_BAR;
        PG8_WAIT_V(4); PG8_BAR;
        PG8_STAGE(PG8_SB(1, 0), cB + kstep, voffB); PG8_STAGE(PG8_SA(1, 0), cA + kstep, voffA); PG8_STAGE(PG8_SB(1, 1), cB + hstep + kstep, voffB);
        PG8_WAIT_V(6); PG8_BAR;
    }
    for (;;) {
        const bool has_next = S.next(ui + 1, nxt);
        const char* nA = has_next ? (const char*)g.A + (size_t)nxt.pm * tstep : cA; const char* nB = has_next ? (const char*)g.Bt + (size_t)nxt.pn * tstep : cB;
        for (int t = 0; t < nt; t += 2) {
            if constexpr (Epi::MID_T > 0) { if (t == Epi::MID_T) E.mid(acc, cur, wr, wc, fr, fq); }
            const bool last = (t == nt - 2);
            const char* a1 = cA + (size_t)(t + 1) * kstep;
            const char* a2 = last ? nA : cA + (size_t)(t + 2) * kstep; const char* b2 = last ? nB : cB + (size_t)(t + 2) * kstep;
            const char* a3 = a2 + kstep; const char* b3 = b2 + kstep;
            if (last && has_next) S.a_ready(nxt);
            if constexpr (SP2) {
            PG8_LDB(B0, 0, 0); PG8_LDB(B1, 0, 1); PG8_SCHED; PG8_LDA(At, 0, 0); PG8_STAGE(PG8_SA(1, 1), a1 + hstep, voffA);
            PG8_WAIT_V(8); PG8_WAIT_L(0); PG8_BAR; PG8_MMA(0, 0, At, B0); PG8_MMA(0, 1, At, B1); PG8_BAR; PG8_SCHED;
            PG8_LDA(At, 0, 1); PG8_STAGE(PG8_SB(0, 0), b2, voffB); PG8_STAGE(PG8_SB(0, 1), b2 + hstep, voffB); PG8_STAGE(PG8_SA(0, 0), a2, voffA);
            PG8_WAIT_V(8); PG8_WAIT_L(0); PG8_BAR; PG8_MMA(1, 0, At, B0); PG8_MMA(1, 1, At, B1); PG8_BAR; PG8_SCHED;
            PG8_LDB(B0, 1, 0); PG8_LDB(B1, 1, 1); PG8_SCHED; PG8_LDA(At, 1, 0); PG8_STAGE(PG8_SA(0, 1), a2 + hstep, voffA);
            PG8_WAIT_V(8); PG8_WAIT_L(0); PG8_BAR; PG8_MMA(0, 0, At, B0); PG8_MMA(0, 1, At, B1); PG8_BAR; PG8_SCHED;
            PG8_LDA(At, 1, 1); PG8_STAGE(PG8_SB(1, 0), b3, voffB); PG8_STAGE(PG8_SB(1, 1), b3 + hstep, voffB); PG8_STAGE(PG8_SA(1, 0), a3, voffA);
            PG8_WAIT_V(8); PG8_WAIT_L(0); PG8_BAR; PG8_MMA(1, 0, At, B0); PG8_MMA(1, 1, At, B1); PG8_BAR; PG8_SCHED;
            } else {
            PG8_LDB(B0, 0, 0); PG8_SCHED; PG8_LDA(At, 0, 0); PG8_STAGE(PG8_SA(1, 1), a1 + hstep, voffA);
            PG8_WAIT_L(8); PG8_BAR; PG8_WAIT_L(0); PG8_MMA(0, 0, At, B0); PG8_BAR; PG8_SCHED;
            PG8_LDB(B1, 0, 1); PG8_STAGE(PG8_SB(0, 0), b2, voffB);
            PG8_BAR; PG8_WAIT_L(0); PG8_MMA(0, 1, At, B1); PG8_BAR;
            PG8_LDA(At, 0, 1); PG8_STAGE(PG8_SA(0, 0), a2, voffA);
            PG8_BAR; PG8_WAIT_L(0); PG8_MMA(1, 0, At, B0); PG8_BAR; PG8_SCHED;
            PG8_STAGE(PG8_SB(0, 1), b2 + hstep, voffB);
            PG8_WAIT_V(6); PG8_BAR; PG8_MMA(1, 1, At, B1); PG8_BAR;
            PG8_LDB(B0, 1, 0); PG8_SCHED; PG8_LDA(At, 1, 0); PG8_STAGE(PG8_SA(0, 1), a2 + hstep, voffA);
            PG8_WAIT_L(8); PG8_BAR; PG8_WAIT_L(0); PG8_MMA(0, 0, At, B0); PG8_BAR; PG8_SCHED;
            PG8_LDB(B1, 1, 1); PG8_STAGE(PG8_SB(1, 0), b3, voffB);
            PG8_BAR; PG8_WAIT_L(0); PG8_MMA(0, 1, At, B1); PG8_BAR;
            PG8_LDA(At, 1, 1); PG8_STAGE(PG8_SA(1, 0), a3, voffA);
            PG8_BAR; PG8_WAIT_L(0); PG8_MMA(1, 0, At, B0); PG8_BAR; PG8_SCHED;
            PG8_STAGE(PG8_SB(1, 1), b3 + hstep, voffB);
            PG8_WAIT_V(6); PG8_BAR; PG8_MMA(1, 1, At, B1); PG8_BAR;
            }
        }
        if constexpr (ALIGN_EPI) { if (wr == 0) PG8_BAR; }
        if constexpr (!Epi::AFTER_DRAIN) { E(acc, cur, wr, wc, fr, fq); S.done(cur); }
        if (!has_next) break;
#pragma unroll
        for (int a = 0; a < 2; ++a)
#pragma unroll
            for (int b = 0; b < 2; ++b)
#pragma unroll
                for (int m = 0; m < 4; ++m)
#pragma unroll
                    for (int n = 0; n < 2; ++n) acc[a][b][m][n] = (f32x4){0.f, 0.f, 0.f, 0.f};
        cur = nxt; cA = nA; cB = nB; ++ui;
        if constexpr (ALIGN_EPI) { if (wr == 1) PG8_BAR; }
    }
    PG8_WAIT_V(0);
    if constexpr (!ALIGN_EPI) { if (wr == 0) PG8_BAR; }
    PG8_BAR;
    if constexpr (Epi::AFTER_DRAIN) { E.fused(acc, cur, wr, wc, fr, fq, lds, wid, lane); S.done(cur); }
#undef PG8_SA
#undef PG8_SB
#undef PG8_STAGE
#undef PG8_LDA
#undef PG8_LDB
#undef PG8_MMA
#undef PG8_WAIT_V
#undef PG8_WAIT_L
#undef PG8_BAR
#undef PG8_SCHED
}
}

constexpr int DM = 1024, TP = 8 * 2048, TSM = 8 * 8192, TT = TP + TSM;
constexpr int NIN = 5120, DFF = 4096, ZC = 3072, GC = 2048;
constexpr float RMS_EPS = 1e-6f, LOG2E = 1.4426950408889634f;
constexpr size_t MiB = 1u << 20;
constexpr size_t WS_WIN = 1 * MiB, WS_WA = 11 * MiB, WS_WB = 12 * MiB, WS_WOUT = 13 * MiB, WS_WUP = 15 * MiB, WS_WDN = 23 * MiB;
constexpr size_t WS_SSQ1 = 32 * MiB, WS_SSQ2 = 37 * MiB;
constexpr size_t WS_XN = 48 * MiB;
constexpr size_t WS_OA = WS_XN, WS_OB = WS_XN + 80 * MiB, WS_X1B = WS_XN;
constexpr size_t WS_Z = 208 * MiB;
constexpr size_t WS_MRG = WS_Z, WS_H = WS_Z;
constexpr size_t WS_G = 688 * MiB;
constexpr size_t WS_END = 1008 * MiB;
constexpr size_t DO_OBG = 0, DO_LSE = 120 * MiB;

constexpr int RING_BYTES = 131072, LDS_BYTES = 147456;

#define LAS __attribute__((address_space(3)))
typedef unsigned short bf16;
typedef unsigned v4u __attribute__((ext_vector_type(4)));
typedef unsigned v2u __attribute__((ext_vector_type(2)));
typedef float f32x4 __attribute__((ext_vector_type(4)));
typedef short bf16x8 __attribute__((ext_vector_type(8)));
typedef short s16x4 __attribute__((ext_vector_type(4)));

__device__ __forceinline__ unsigned cvtpk(float lo, float hi) { return pg8::cvt_pk_bf16(lo, hi); }
__device__ __forceinline__ float bf_lo(unsigned u) { return __builtin_bit_cast(float, u << 16); }
__device__ __forceinline__ float bf_hi(unsigned u) { return __builtin_bit_cast(float, u & 0xffff0000u); }

namespace pg8 {
typedef unsigned u32x2g __attribute__((ext_vector_type(2)));
struct EpiIn {
    static constexpr bool PERM = true, AFTER_DRAIN = false; static constexpr int MID_T = 0;
    bf16_t* Z; bf16_t* Gt; const float* bgate;
    __device__ __forceinline__ void operator()(const f32x4 (&acc)[2][2][4][2], const Unit& u, int wr, int wc, int fr, int fq) const {
        const int row0 = u.pm * BM + wr * 64 + fr;
        const bool isg = u.pn >= 12;
        if (isg) {
            const int col0 = (u.pn - 12) * BM + wc * 32 + 8 * fq;
            f32x4 bv[2][2];
#pragma unroll
            for (int bj = 0; bj < 2; ++bj)
#pragma unroll
                for (int n = 0; n < 2; ++n) bv[bj][n] = *(const f32x4*)(bgate + col0 + bj * HALF + 4 * n);
#pragma unroll
            for (int ai = 0; ai < 2; ++ai)
#pragma unroll
                for (int m = 0; m < 4; ++m) { unsigned char* rowp = (unsigned char*)Gt + (size_t)(row0 + ai * HALF + m * 16) * GC + col0;
#pragma unroll
                    for (int bj = 0; bj < 2; ++bj) { f32x4 v0 = acc[ai][bj][m][0] + bv[bj][0], v1 = acc[ai][bj][m][1] + bv[bj][1];
                        unsigned q[8];
#pragma unroll
                        for (int e = 0; e < 4; ++e) { q[e] = (unsigned)__builtin_rintf(255.f * __builtin_amdgcn_rcpf(1.f + __builtin_amdgcn_exp2f(-LOG2E * v0[e]))); q[4 + e] = (unsigned)__builtin_rintf(255.f * __builtin_amdgcn_rcpf(1.f + __builtin_amdgcn_exp2f(-LOG2E * v1[e]))); }
                        u32x2g w; w.x = q[0] | (q[1] << 8) | (q[2] << 16) | (q[3] << 24); w.y = q[4] | (q[5] << 8) | (q[6] << 16) | (q[7] << 24);
                        *(u32x2g*)(rowp + bj * HALF) = w; } }
        } else {
            const int seqL = (u.pm * BM < TP) ? 2048 : 8192, lsh = (u.pm * BM < TP) ? 11 : 13;
#pragma unroll
            for (int bj = 0; bj < 2; ++bj) {
                const int hslot = (u.pn * BM + bj * HALF + wc * 32) >> 6; const int within = (wc & 1) * 32 + 8 * fq;
                int dsh = 0; if (hslot >= 12) { const int gi = ((hslot - 12) % 12) >> 2; dsh = gi == 0 ? 0 : (gi == 1 ? 2 : 4); }
                bf16_t* hb = Z + (size_t)hslot * TT * 64 + within;
#pragma unroll
                for (int ai = 0; ai < 2; ++ai)
#pragma unroll
                    for (int m = 0; m < 4; ++m) { const int r = row0 + ai * HALF + m * 16; const int rr = r - TP * (r >= TP ? 1 : 0); const int seq0 = r - (rr & (seqL - 1)); const int t = rr & (seqL - 1);
                        const int pos = seq0 + ((t & ((1 << dsh) - 1)) << (lsh - dsh)) + (t >> dsh);
                        const f32x4 v0 = acc[ai][bj][m][0], v1 = acc[ai][bj][m][1];
                        u32x4 w; w.x = cvt_pk_bf16(v0[0], v0[1]); w.y = cvt_pk_bf16(v0[2], v0[3]); w.z = cvt_pk_bf16(v1[0], v1[1]); w.w = cvt_pk_bf16(v1[2], v1[3]);
                        *(u32x4*)(hb + (size_t)pos * 64) = w; } }
        }
    }
};
struct EpiGate2 {
    static constexpr bool PERM = true, AFTER_DRAIN = false; static constexpr int MID_T = 8;
    bf16_t* O; const unsigned char* Gt;
    __device__ __forceinline__ void mid(f32x4 (&acc)[2][2][4][2], const Unit& u, int wr, int wc, int fr, int fq) const {
        asm volatile("" : "+v"(fr), "+v"(fq));
        const int row0 = u.pm * BM + wr * 64 + fr, col0 = u.pn * BM + wc * 32 + 8 * fq;
#pragma unroll
        for (int ai = 0; ai < 2; ++ai)
#pragma unroll
            for (int m = 0; m < 4; ++m) { const size_t r = (size_t)(row0 + ai * HALF + m * 16);
#pragma unroll
                for (int bj = 0; bj < 2; ++bj) {
                    const u32x2g a = *(const u32x2g*)(Gt + r * GC + col0 + bj * HALF), b = *(const u32x2g*)(Gt + r * GC + DM + col0 + bj * HALF);
                    f32x4 v0 = acc[ai][bj][m][0], v1 = acc[ai][bj][m][1];
#define G2R(aw, bw, sh) ((float)(((aw) >> (sh)) & 0xffu) * __builtin_amdgcn_rcpf(fmaxf((float)(((bw) >> (sh)) & 0xffu), 0.5f)))
                    v0[0] *= G2R(a.x, b.x, 0); v0[1] *= G2R(a.x, b.x, 8); v0[2] *= G2R(a.x, b.x, 16); v0[3] *= G2R(a.x, b.x, 24);
                    v1[0] *= G2R(a.y, b.y, 0); v1[1] *= G2R(a.y, b.y, 8); v1[2] *= G2R(a.y, b.y, 16); v1[3] *= G2R(a.y, b.y, 24);
#undef G2R
                    acc[ai][bj][m][0] = v0; acc[ai][bj][m][1] = v1; }
                asm volatile("" ::: "memory"); }
    }
    __device__ __forceinline__ void operator()(const f32x4 (&acc)[2][2][4][2], const Unit& u, int wr, int wc, int fr, int fq) const {
        asm volatile("" : "+v"(fr), "+v"(fq));
        const int row0 = u.pm * BM + wr * 64 + fr, col0 = u.pn * BM + wc * 32 + 8 * fq;
#pragma unroll
        for (int ai = 0; ai < 2; ++ai)
#pragma unroll
            for (int m = 0; m < 4; ++m) { const size_t r = (size_t)(row0 + ai * HALF + m * 16);
#pragma unroll
                for (int bj = 0; bj < 2; ++bj) {
                    const u32x2g b = *(const u32x2g*)(Gt + r * GC + DM + col0 + bj * HALF);
                    f32x4 v0 = acc[ai][bj][m][0], v1 = acc[ai][bj][m][1];
#define G2B(bw, sh) fmaxf((float)(((bw) >> (sh)) & 0xffu), 0.5f)
                    v0[0] *= G2B(b.x, 0); v0[1] *= G2B(b.x, 8); v0[2] *= G2B(b.x, 16); v0[3] *= G2B(b.x, 24);
                    v1[0] *= G2B(b.y, 0); v1[1] *= G2B(b.y, 8); v1[2] *= G2B(b.y, 16); v1[3] *= G2B(b.y, 24);
#undef G2B
                    u32x4 w; w.x = cvt_pk_bf16(v0[0], v0[1]); w.y = cvt_pk_bf16(v0[2], v0[3]); w.z = cvt_pk_bf16(v1[0], v1[1]); w.w = cvt_pk_bf16(v1[2], v1[3]);
                    *(u32x4*)(O + r * DM + col0 + bj * HALF) = w; }
                asm volatile("" ::: "memory"); }
    }
};
template <bool WB> struct EpiRes {
    static constexpr bool PERM = true, AFTER_DRAIN = false; static constexpr int MID_T = 0;
    const float* xp; const float* xs;
    float* out; bf16_t* xb; float* ssq;
    __device__ __forceinline__ void operator()(const f32x4 (&acc)[2][2][4][2], const Unit& u, int wr, int wc, int fr, int fq) const {
        const int row0 = u.pm * BM + wr * 64 + fr, col0 = u.pn * BM + wc * 32 + 8 * fq;
        const float* xbase = (u.pm * BM < TP) ? xp : (xs - (size_t)TP * DM);
#pragma unroll
        for (int ai = 0; ai < 2; ++ai) {
            f32x4 xv[4][2][2];
#pragma unroll
            for (int m = 0; m < 4; ++m)
#pragma unroll
                for (int bj = 0; bj < 2; ++bj) { const size_t off = (size_t)(row0 + ai * HALF + m * 16) * DM + col0 + bj * HALF; xv[m][bj][0] = *(const f32x4*)(xbase + off); xv[m][bj][1] = *(const f32x4*)(xbase + off + 4); }
#pragma unroll
            for (int m = 0; m < 4; ++m) { const size_t r = (size_t)(row0 + ai * HALF + m * 16); float ss = 0.f;
#pragma unroll
                for (int bj = 0; bj < 2; ++bj) { const size_t off = r * DM + col0 + bj * HALF;
                    const f32x4 v0 = acc[ai][bj][m][0] + xv[m][bj][0], v1 = acc[ai][bj][m][1] + xv[m][bj][1];
                    if (!WB) { *(f32x4*)(out + off) = v0; *(f32x4*)(out + off + 4) = v1; }
                    if (WB) { u32x4 w; w.x = cvt_pk_bf16(v0[0], v0[1]); w.y = cvt_pk_bf16(v0[2], v0[3]); w.z = cvt_pk_bf16(v1[0], v1[1]); w.w = cvt_pk_bf16(v1[2], v1[3]); *(u32x4*)(xb + off) = w; }
                    ss += (v0[0] * v0[0] + v0[1] * v0[1]) + (v0[2] * v0[2] + v0[3] * v0[3]) + (v1[0] * v1[0] + v1[1] * v1[1]) + (v1[2] * v1[2] + v1[3] * v1[3]); }
                ss += __shfl_xor(ss, 16); ss += __shfl_xor(ss, 32);
                if (fq == 0) ssq[r * 16 + u.pn * 4 + wc] = ss; }
            asm volatile("" ::: "memory"); }
    }
};
struct EpiUp {
    static constexpr bool PERM = true, AFTER_DRAIN = false; static constexpr int MID_T = 0;
    bf16_t* O; const float* ssq;
    __device__ __forceinline__ void operator()(const f32x4 (&acc)[2][2][4][2], const Unit& u, int wr, int wc, int fr, int fq) const {
        const int row0 = u.pm * BM + wr * 64 + fr, col0 = u.pn * BM + wc * 32 + 8 * fq;
#pragma unroll
        for (int ai = 0; ai < 2; ++ai)
#pragma unroll
            for (int m = 0; m < 4; ++m) { const size_t r = (size_t)(row0 + ai * HALF + m * 16);
                const f32x4 pq = *(const f32x4*)(ssq + r * 16 + 4 * fq);
                float ss = (pq[0] + pq[1]) + (pq[2] + pq[3]); ss += __shfl_xor(ss, 16); ss += __shfl_xor(ss, 32);
                const float rs = __builtin_amdgcn_rsqf(ss * (1.f / DM) + RMS_EPS);
#pragma unroll
                for (int bj = 0; bj < 2; ++bj) { f32x4 v0 = acc[ai][bj][m][0] * rs, v1 = acc[ai][bj][m][1] * rs;
#pragma unroll
                    for (int e = 0; e < 4; ++e) { const float a = fmaxf(v0[e], 0.f), b = fmaxf(v1[e], 0.f); v0[e] = a * a; v1[e] = b * b; }
                    u32x4 w; w.x = cvt_pk_bf16(v0[0], v0[1]); w.y = cvt_pk_bf16(v0[2], v0[3]); w.z = cvt_pk_bf16(v1[0], v1[1]); w.w = cvt_pk_bf16(v1[2], v1[3]);
                    *(u32x4*)(O + r * DFF + col0 + bj * HALF) = w; } }
    }
};
struct EpiFinal {
    static constexpr bool PERM = true, AFTER_DRAIN = false; static constexpr int MID_T = 0;
    float* out; const bf16_t* xb; float* ssq; unsigned* cnt; const float* gfin;
    __device__ __forceinline__ void operator()(f32x4 (&acc)[2][2][4][2], const Unit& u, int wr, int wc, int fr, int fq) const {
        const int row0 = u.pm * BM + wr * 64 + fr, col0 = u.pn * BM + wc * 32 + 8 * fq;
#pragma unroll
        for (int ai = 0; ai < 2; ++ai) {
            u32x4 xv[4][2];
#pragma unroll
            for (int m = 0; m < 4; ++m)
#pragma unroll
                for (int bj = 0; bj < 2; ++bj) { const size_t off = (size_t)(row0 + ai * HALF + m * 16) * DM + col0 + bj * HALF; xv[m][bj] = *(const u32x4*)(xb + off); }
#pragma unroll
            for (int m = 0; m < 4; ++m) { const size_t r = (size_t)(row0 + ai * HALF + m * 16); float ss = 0.f;
#pragma unroll
                for (int bj = 0; bj < 2; ++bj) { const u32x4 xw = xv[m][bj];
                    const f32x4 x0 = {bf_lo(xw.x), bf_hi(xw.x), bf_lo(xw.y), bf_hi(xw.y)}, x1 = {bf_lo(xw.z), bf_hi(xw.z), bf_lo(xw.w), bf_hi(xw.w)};
                    const f32x4 v0 = acc[ai][bj][m][0] + x0, v1 = acc[ai][bj][m][1] + x1; acc[ai][bj][m][0] = v0; acc[ai][bj][m][1] = v1;
                    ss += (v0[0] * v0[0] + v0[1] * v0[1]) + (v0[2] * v0[2] + v0[3] * v0[3]) + (v1[0] * v1[0] + v1[1] * v1[1]) + (v1[2] * v1[2] + v1[3] * v1[3]); }
                ss += __shfl_xor(ss, 16); ss += __shfl_xor(ss, 32);
                if (fq == 0) __hip_atomic_store(ssq + r * 16 + u.pn * 4 + wc, ss, __ATOMIC_RELAXED, __HIP_MEMORY_SCOPE_AGENT); }
            asm volatile("" ::: "memory"); }
        asm volatile("s_waitcnt vmcnt(0)" ::: "memory");
        unsigned* pc = cnt + 64 * u.pm;
        if (fr == 0 && fq == 0) __hip_atomic_fetch_add(pc, 1u, __ATOMIC_RELAXED, __HIP_MEMORY_SCOPE_AGENT);
        { unsigned spins = 0;
          while ((unsigned)__builtin_amdgcn_readfirstlane(__hip_atomic_load(pc, __ATOMIC_RELAXED, __HIP_MEMORY_SCOPE_AGENT)) < 32u) { __builtin_amdgcn_s_sleep(2); if (++spins > (1u << 22)) break; } }
        asm volatile("" ::: "memory");
        f32x4 gv[2][2];
#pragma unroll
        for (int bj = 0; bj < 2; ++bj)
#pragma unroll
            for (int n = 0; n < 2; ++n) gv[bj][n] = *(const f32x4*)(gfin + col0 + bj * HALF + 4 * n);
#pragma unroll
        for (int ai = 0; ai < 2; ++ai)
#pragma unroll
            for (int m = 0; m < 4; ++m) { const size_t r = (size_t)(row0 + ai * HALF + m * 16);
                const float* pp = ssq + r * 16 + 4 * fq;
                const float q0 = __hip_atomic_load(pp + 0, __ATOMIC_RELAXED, __HIP_MEMORY_SCOPE_AGENT), q1 = __hip_atomic_load(pp + 1, __ATOMIC_RELAXED, __HIP_MEMORY_SCOPE_AGENT),
                            q2 = __hip_atomic_load(pp + 2, __ATOMIC_RELAXED, __HIP_MEMORY_SCOPE_AGENT), q3 = __hip_atomic_load(pp + 3, __ATOMIC_RELAXED, __HIP_MEMORY_SCOPE_AGENT);
                float tot = (q0 + q1) + (q2 + q3); tot += __shfl_xor(tot, 16); tot += __shfl_xor(tot, 32);
                const float rs = __builtin_amdgcn_rsqf(tot * (1.f / DM) + RMS_EPS);
#pragma unroll
                for (int bj = 0; bj < 2; ++bj) { const size_t off = r * DM + col0 + bj * HALF;
                    *(f32x4*)(out + off) = acc[ai][bj][m][0] * rs * gv[bj][0]; *(f32x4*)(out + off + 4) = acc[ai][bj][m][1] * rs * gv[bj][1]; } }
    }
};
}

__device__ __forceinline__ float wave_sum(float v) {
#pragma unroll
    for (int o = 1; o < 64; o <<= 1) v += __shfl_xor(v, o);
    return v;
}
__device__ __forceinline__ void p0_transpose_item(const float* W, int K, int N, bf16* WT, const float* kscale, LAS float* scr, int item, int lane, float sscale = 1.f, int ld = 0, int koff = 0) {
    if (ld == 0) ld = K;
    const int nblk = N / 32, kb = item / nblk, nb = item % nblk, k0 = 64 * kb, n0 = 32 * nb;
#pragma unroll 8
    for (int i = 0; i < 32; ++i) { const int kk = 2 * i + (lane >> 5); float v = W[(size_t)(k0 + kk) * N + n0 + (lane & 31)] * sscale; if (kscale) v *= kscale[k0 + kk]; scr[kk * 33 + (lane & 31)] = v; }
    asm volatile("s_waitcnt lgkmcnt(0)" ::: "memory");
    const int c = lane & 7;
#pragma unroll
    for (int j = 0; j < 4; ++j) { const int n = (lane >> 3) + 8 * j; const LAS float* s = scr + (8 * c) * 33 + n;
        v4u o; o.x = cvtpk(s[0 * 33], s[1 * 33]); o.y = cvtpk(s[2 * 33], s[3 * 33]); o.z = cvtpk(s[4 * 33], s[5 * 33]); o.w = cvtpk(s[6 * 33], s[7 * 33]);
        *(v4u*)(WT + (size_t)(n0 + n) * ld + koff + k0 + 8 * c) = o; }
    asm volatile("s_waitcnt lgkmcnt(0)" ::: "memory");
}

namespace att {
constexpr int KRS = 144, VRS = 160, NKS_MAX = 384, TBL = 640;
constexpr int L_K = 0, L_V = NKS_MAX * KRS, L_T = L_V + NKS_MAX * VRS, L_PM = L_T + 4 * TBL * 4, L_END = L_PM + 2 * NKS_MAX * 4;
static_assert(L_END <= RING_BYTES, "attention LDS");
constexpr int NITEM_A = (TT / 128) * 2, NITEM_B = (TT / 256) * 12;

__device__ __forceinline__ int rel_bucket(int rel) {
    const int n = rel < 0 ? -rel : rel; int b;
    if (n < 8) b = n; else if (n < 15) b = 8; else if (n < 27) b = 9; else if (n < 50) b = 10; else if (n < 91) b = 11; else if (n < 166) b = 12; else if (n < 305) b = 13; else if (n < 559) b = 14; else b = 15;
    return b + (rel > 0 ? 16 : 0);
}
__device__ __forceinline__ s16x4 vtr(LAS const unsigned char* p) { return __builtin_bit_cast(s16x4, __builtin_amdgcn_ds_read_tr16_b64_v4i16((LAS s16x4*)p)); }

template <int NCH, bool IS_A>
__device__ __forceinline__ void attn_task(LAS const unsigned char* ldsK, LAS const unsigned char* ldsV, LAS const float* tbl, LAS const float* pm, int kstart,
                                          bf16x8& qf0, bf16x8& qf1, const bf16* nq, bool has_nq, int qrel, float sink2, bf16* orow, float* lsep, int qi, int g, int abl = 0) {
    constexpr int NT = 2 * NCH;
    f32x4 s[NT];
    LAS const unsigned char* kp = ldsK + (kstart + qi) * KRS + g * 16;
    LAS const float* pmb = pm + (kstart + 4 * g);
    {
        bf16x8 ka[2][2][2]; f32x4 pz[2][2];
#pragma unroll
        for (int j = 0; j < 2; ++j) { ka[0][j][0] = *(LAS const bf16x8*)(kp + j * 16 * KRS); ka[0][j][1] = *(LAS const bf16x8*)(kp + j * 16 * KRS + 64); pz[0][j] = *(LAS const f32x4*)(pmb + 16 * j); }
#pragma unroll
        for (int tp = 0; tp < NT / 2; ++tp) { const int b = tp & 1;
            if (tp + 1 < NT / 2) {
#pragma unroll
                for (int j = 0; j < 2; ++j) { const int t = 2 * (tp + 1) + j; ka[b ^ 1][j][0] = *(LAS const bf16x8*)(kp + t * 16 * KRS); ka[b ^ 1][j][1] = *(LAS const bf16x8*)(kp + t * 16 * KRS + 64); pz[b ^ 1][j] = *(LAS const f32x4*)(pmb + 16 * t); } }
            __builtin_amdgcn_sched_barrier(0);
#pragma unroll
            for (int j = 0; j < 2; ++j) { f32x4 z = __builtin_amdgcn_mfma_f32_16x16x32_bf16(ka[b][j][0], qf0, pz[b][j], 0, 0, 0); s[2 * tp + j] = __builtin_amdgcn_mfma_f32_16x16x32_bf16(ka[b][j][1], qf1, z, 0, 0, 0); }
            __builtin_amdgcn_sched_barrier(0);
        }
    }
    if (has_nq) { qf0 = *(const bf16x8*)(nq + g * 8); qf1 = *(const bf16x8*)(nq + 32 + g * 8); }
    constexpr float C = 0.125f * LOG2E; const float NEG = -__builtin_inff();
    LAS const float* tb = tbl + (kstart + 4 * g - qrel + TBL / 2);
    float m = NEG;
    {
        float tv[2][8];
#pragma unroll
        for (int i = 0; i < 8; ++i) tv[0][i] = tb[16 * (i >> 2) + (i & 3)];
#pragma unroll
        for (int tp = 0; tp < NT / 2; ++tp) { const int b = tp & 1;
            if (tp + 1 < NT / 2) {
#pragma unroll
                for (int i = 0; i < 8; ++i) tv[b ^ 1][i] = tb[16 * (2 * (tp + 1) + (i >> 2)) + (i & 3)]; }
            __builtin_amdgcn_sched_barrier(0);
#pragma unroll
            for (int i = 0; i < 8; ++i) { const int t = 2 * tp + (i >> 2), r = i & 3; const float v = s[t][r] * C + tv[b][i]; s[t][r] = v; m = fmaxf(m, v); }
            __builtin_amdgcn_sched_barrier(0);
        }
    }
    m = fmaxf(m, __shfl_xor(m, 16)); m = fmaxf(m, __shfl_xor(m, 32));
    if (IS_A) m = fmaxf(m, sink2);
    float sum = 0.f;
#pragma unroll
    for (int t = 0; t < NT; ++t)
#pragma unroll
        for (int r = 0; r < 4; ++r) { const float p = __builtin_amdgcn_exp2f(s[t][r] - m); s[t][r] = p; sum += p; }
    sum += __shfl_xor(sum, 16); sum += __shfl_xor(sum, 32);
    if (IS_A) sum += __builtin_amdgcn_exp2f(sink2 - m);
    const float inv = __builtin_amdgcn_rcpf(sum);
    f32x4 o[4];
#pragma unroll
    for (int d = 0; d < 4; ++d) o[d] = (f32x4){0.f, 0.f, 0.f, 0.f};
    LAS const unsigned char* vp = ldsV + (kstart + 4 * g + (qi >> 2)) * VRS + (qi & 3) * 8;
    {
        s16x4 vl[2][4], vh[2][4];
#pragma unroll
        for (int d = 0; d < 4; ++d) { vl[0][d] = vtr(vp + d * 32); vh[0][d] = vtr(vp + 16 * VRS + d * 32); }
#pragma unroll
        for (int c = 0; c < NCH; ++c) { const int b = c & 1;
            if (c + 1 < NCH) {
#pragma unroll
                for (int d = 0; d < 4; ++d) { vl[b ^ 1][d] = vtr(vp + (32 * (c + 1)) * VRS + d * 32); vh[b ^ 1][d] = vtr(vp + (32 * (c + 1) + 16) * VRS + d * 32); } }
            v4u pw; pw.x = cvtpk(s[2 * c][0], s[2 * c][1]); pw.y = cvtpk(s[2 * c][2], s[2 * c][3]); pw.z = cvtpk(s[2 * c + 1][0], s[2 * c + 1][1]); pw.w = cvtpk(s[2 * c + 1][2], s[2 * c + 1][3]);
            const bf16x8 pb = __builtin_bit_cast(bf16x8, pw);
            __builtin_amdgcn_sched_barrier(0);
#pragma unroll
            for (int d = 0; d < 4; ++d) { const s16x4 lo = vl[b][d], hi = vh[b][d];
                const bf16x8 va = (bf16x8){lo[0], lo[1], lo[2], lo[3], hi[0], hi[1], hi[2], hi[3]};
                o[d] = __builtin_amdgcn_mfma_f32_16x16x32_bf16(va, pb, o[d], 0, 0, 0); }
            __builtin_amdgcn_sched_barrier(0);
        }
    }
#pragma unroll
    for (int d = 0; d < 4; ++d) { v2u w; w.x = cvtpk(o[d][0] * inv, o[d][1] * inv); w.y = cvtpk(o[d][2] * inv, o[d][3] * inv); if (!(abl & 1) || w.x == 0x12345678u) *(v2u*)(orow + 16 * d + 4 * g) = w; }
    if (!IS_A) { if (g == 0 && !(abl & 1)) *lsep = m + __builtin_log2f(sum); }
}

struct Item { int isA, seq0, j0, Lr, Lre, dil, res, hs, pair;
    __device__ __forceinline__ int n() const { return isA ? 128 : 64; }
    __device__ __forceinline__ int nh() const { return isA ? 4 : 1; }
    __device__ __forceinline__ int kslot() const { return isA ? 8 + hs : 24 + hs; }
    __device__ __forceinline__ int vslot() const { return isA ? 10 + hs : 36 + hs; }
    __device__ __forceinline__ int qslot0() const { return isA ? hs * 4 : 12 + hs; }
    __device__ __forceinline__ int bcol0() const { return isA ? hs * 4 : 8 + hs; }
    __device__ __forceinline__ int key() const { return isA ? hs : 2 + hs; }
};
__device__ __forceinline__ Item decode(int k, int na0, int nA, int nb0) {
    Item I; int tok0;
    if (k < nA) { const int ia = na0 + k; I.isA = 1; I.hs = ia / (TT / 128); tok0 = (ia % (TT / 128)) * 128; I.dil = 1; }
    else { const int ib = nb0 + (k - nA); I.hs = ib / (TT / 256); I.isA = 0; const int gi = I.hs >> 2; tok0 = (ib % (TT / 256)) * 256; I.dil = gi == 0 ? 1 : (gi == 1 ? 4 : 16); }
    int L;
    if (tok0 < TP) { L = 2048; I.seq0 = (tok0 / 2048) * 2048; } else { L = 8192; I.seq0 = TP + ((tok0 - TP) / 8192) * 8192; }
    I.res = 0; I.j0 = tok0 - I.seq0; I.Lr = L; I.Lre = L; I.pair = 0;
    if (!I.isA) { I.Lr = L / I.dil; const int blk = (tok0 - I.seq0) / 256;
        if (I.Lr >= 256) { const int bpr = I.Lr / 256; I.res = blk / bpr; I.j0 = (blk % bpr) * 256; I.Lre = I.Lr; }
        else { I.res = 2 * blk; I.j0 = 0; I.Lre = 2 * I.Lr; I.pair = 1; } }
    return I;
}

__device__ __forceinline__ void attn_phase(LAS unsigned char* lds, const bf16* Z, const float* rel_bias, const float* sink, bf16* OA, bf16* OBG, float* LSE, int abl = 0) {
    int tid_l = threadIdx.x; asm volatile("" : "+v"(tid_l));
    const int tid = tid_l, lane = tid & 63, wave = __builtin_amdgcn_readfirstlane(tid >> 6), qi = lane & 15, g = lane >> 4;
    LAS unsigned char* ldsK = lds + L_K; LAS unsigned char* ldsV = lds + L_V; LAS float* tbl = (LAS float*)(lds + L_T); LAS float* pmt = (LAS float*)(lds + L_PM);
    const int G = gridDim.x, bx = blockIdx.x;
    const int na0 = (int)((long)bx * NITEM_A / G), nA = (int)((long)(bx + 1) * NITEM_A / G) - na0;
    const int nb0 = (int)((long)bx * NITEM_B / G), nB = (int)((long)(bx + 1) * NITEM_B / G) - nb0;
    const int nloc = nA + nB, r0 = tid >> 3, ch = tid & 7;
    v4u pk[6], pv[6];
#define ATT_ISSUE(I) do { _Pragma("unroll") for (int i_ = 0; i_ < 6; ++i_) { const int row_ = r0 + 64 * i_, kpos_ = (I).j0 - (I).n() + row_; pk[i_] = (v4u){0u, 0u, 0u, 0u}; pv[i_] = (v4u){0u, 0u, 0u, 0u}; \
        if ((unsigned)kpos_ < (unsigned)(I).Lre && !(abl & 2)) { const size_t ro_ = (size_t)((I).seq0 + (I).res * (I).Lr + kpos_) * 64 + ch * 8; pk[i_] = *(const v4u*)(Z + (size_t)(I).kslot() * TT * 64 + ro_); pv[i_] = *(const v4u*)(Z + (size_t)(I).vslot() * TT * 64 + ro_); } } } while (0)
    if (nloc <= 0) return;
    Item cur = decode(0, na0, nA, nb0), nxt = cur;
#define ATT_QT(I, i_) ((I).isA ? ((wave * 4 + (i_)) & 7) : (wave * 2 + (i_)))
#define ATT_QPTR(I, i_) (Z + ((size_t)((I).qslot0() + ((I).isA ? ((wave * 4 + (i_)) >> 3) : 0)) * TT + (I).seq0 + (I).res * (I).Lr + (I).j0 + 16 * ATT_QT(I, i_) + qi) * 64)
    bf16x8 q0, q1;
    { const bf16* qp = ATT_QPTR(cur, 0); q0 = *(const bf16x8*)(qp + g * 8); q1 = *(const bf16x8*)(qp + 32 + g * 8); }
    asm volatile("" ::: "memory");
    ATT_ISSUE(cur);
    int tkey = -1;
    for (int k = 0; k < nloc; ++k) {
        __syncthreads();
#pragma unroll
        for (int i = 0; i < 6; ++i) { const int row = r0 + 64 * i; *(LAS v4u*)(ldsK + row * KRS + ch * 16) = pk[i]; *(LAS v4u*)(ldsV + row * VRS + ch * 16) = pv[i];
            if (ch == 0) { const unsigned kp = (unsigned)(cur.j0 - cur.n() + row); const float ninf = -__builtin_inff();
                pmt[row] = (kp < (unsigned)(cur.pair ? cur.Lr : cur.Lre)) ? 0.f : ninf;
                pmt[NKS_MAX + row] = (cur.pair ? (kp - (unsigned)cur.Lr < (unsigned)cur.Lr) : (kp < (unsigned)cur.Lre)) ? 0.f : ninf; } }
        if (cur.key() != tkey) { tkey = cur.key();
            for (int i = tid; i < cur.nh() * TBL; i += 512) { const int h = i / TBL, rel = i % TBL - TBL / 2; const int ar = rel < 0 ? -rel : rel;
                tbl[i] = (ar <= cur.n()) ? rel_bias[rel_bucket(rel * cur.dil) * 20 + cur.bcol0() + h] * LOG2E : -__builtin_inff(); } }
        __syncthreads();
        const bool more = (k + 1 < nloc);
        if (more) { nxt = decode(k + 1, na0, nA, nb0); ATT_ISSUE(nxt); }
        asm volatile("" ::: "memory");
        const int ntask = cur.isA ? 4 : 2;
#ifdef ATT_DEPHASE
        if (wave >= 4) { if (cur.isA) __builtin_amdgcn_s_sleep(ATT_DEPHASE); else __builtin_amdgcn_s_sleep((ATT_DEPHASE * 5) / 8); }
#endif
#pragma unroll 1
        for (int i = 0; i < ntask; ++i) {
            const int qt = ATT_QT(cur, i); const bool lastt = (i + 1 == ntask);
            const bf16* nq = lastt ? ATT_QPTR(nxt, 0) : ATT_QPTR(cur, i + 1);
            const bool has_nq = !lastt || more;
            if (cur.isA) { const int h = (wave * 4 + i) >> 3, habs = cur.hs * 4 + h; const int qtok = cur.seq0 + cur.j0 + 16 * qt + qi; const int ks = qt < 6 ? 16 * qt : 96;
                attn_task<9, true>(ldsK, ldsV, tbl + h * TBL, pmt, ks, q0, q1, nq, has_nq, cur.n() + 16 * qt + qi, sink[habs] * LOG2E, OA + (size_t)qtok * 768 + habs * 64, nullptr, qi, g, abl);
            } else { const int jj = cur.j0 + 16 * qt + qi; const int jr = cur.pair ? (jj & (cur.Lr - 1)) : jj, rs = cur.res + (cur.pair ? (jj / cur.Lr) : 0);
                const int qtok = cur.seq0 + jr * cur.dil + rs; const int ks = qt < 14 ? 16 * qt : 224;
                attn_task<5, false>(ldsK, ldsV, tbl, pmt + (qt >> 3) * NKS_MAX, ks, q0, q1, nq, has_nq, cur.n() + 16 * qt + qi, 0.f, OBG + ((size_t)(cur.hs >> 2) * TT + qtok) * 256 + (cur.hs & 3) * 64, LSE + ((size_t)(cur.hs >> 2) * TT + qtok) * 4 + (cur.hs & 3), qi, g, abl);
            }
        }
        cur = nxt;
    }
    __syncthreads();
#undef ATT_ISSUE
#undef ATT_QPTR
#undef ATT_QT
}
}

#ifndef ABL_P2
#define ABL_P2 0
#endif
#ifndef REP_P0
#define REP_P0 1
#endif
#ifndef REP_P2B
#define REP_P2B 1
#endif
#ifndef REP_P3
#define REP_P3 1
#endif
#ifndef REP_P1
#define REP_P1 1
#endif
#ifndef REP_P2
#define REP_P2 1
#endif
#ifndef REP_P4
#define REP_P4 1
#endif
#ifndef REP_P5
#define REP_P5 1
#endif
__device__ __forceinline__ void grid_barrier(unsigned* ctr, unsigned target) {
    asm volatile("s_waitcnt vmcnt(0)" ::: "memory");
    __syncthreads();
    if (threadIdx.x == 0) {
        __builtin_amdgcn_fence(__ATOMIC_RELEASE, "agent");
        asm volatile("s_waitcnt vmcnt(0)" ::: "memory");
        __hip_atomic_fetch_add(ctr, 1u, __ATOMIC_RELAXED, __HIP_MEMORY_SCOPE_AGENT);
        unsigned spins = 0;
        while (__hip_atomic_load(ctr, __ATOMIC_RELAXED, __HIP_MEMORY_SCOPE_AGENT) < target) { __builtin_amdgcn_s_sleep(2); if (++spins > (1u << 24)) break; }
        __builtin_amdgcn_fence(__ATOMIC_ACQUIRE, "agent");
        asm volatile("s_waitcnt vmcnt(0)" ::: "memory");
    }
    __syncthreads();
}
#define GSYNC() do { ++bar_n; grid_barrier(bar_ctr, bar_n * (unsigned)G); } while (0)
struct Args { const float* in[14]; float* out; unsigned char* ws; };

__global__ void __launch_bounds__(512, 2) mk_fwd(Args a) {
    extern __shared__ __attribute__((aligned(16))) unsigned char lds_raw[];
    LAS unsigned char* lds = (LAS unsigned char*)lds_raw;
    cg::grid_group grid = cg::this_grid();
    const int tid = threadIdx.x, lane = tid & 63, wave = __builtin_amdgcn_readfirstlane(tid >> 6);
    const int G = gridDim.x, bx = blockIdx.x;
    const float* x_p = a.in[0]; const float* x_s = a.in[1]; const float* rel_bias = a.in[2]; const float* g_mix = a.in[3]; const float* w_in = a.in[4]; const float* b_gate = a.in[5];
    const float* w_a = a.in[6]; const float* w_b = a.in[7]; const float* w_out = a.in[8]; const float* sink = a.in[9]; const float* g_mlp = a.in[10]; const float* w_up = a.in[11]; const float* w_dn = a.in[12]; const float* g_fin = a.in[13];
    unsigned char* ws = a.ws; float* out = a.out;
    bf16* Win_t = (bf16*)(ws + WS_WIN); bf16* Wa_t = (bf16*)(ws + WS_WA); bf16* Wb_t = (bf16*)(ws + WS_WB); bf16* Wout_t = (bf16*)(ws + WS_WOUT); bf16* Wup_t = (bf16*)(ws + WS_WUP); bf16* Wdn_t = (bf16*)(ws + WS_WDN);
    float* SSQ1 = (float*)(ws + WS_SSQ1); float* SSQ2 = (float*)(ws + WS_SSQ2);
    bf16* XN = (bf16*)(ws + WS_XN); bf16* OA = (bf16*)(ws + WS_OA); bf16* OB = (bf16*)(ws + WS_OB); bf16* X1B = (bf16*)(ws + WS_X1B);
    bf16* Zb = (bf16*)(ws + WS_Z); bf16* MRG = (bf16*)(ws + WS_MRG); bf16* Hb = (bf16*)(ws + WS_H); bf16* Gt = (bf16*)(ws + WS_G);
    bf16* OBG = (bf16*)((unsigned char*)out + DO_OBG); float* LSE = (float*)((unsigned char*)out + DO_LSE);
    const int gw = bx * 8 + wave, NGW = G * 8;
    unsigned* bar_ctr = (unsigned*)ws; unsigned bar_n = 0;
    const unsigned my_xcc = (unsigned)__builtin_amdgcn_s_getreg((3 << 11) | 20) & 0xFu;
    unsigned my_rank = 0;
    if (tid == 0) my_rank = __hip_atomic_fetch_add(bar_ctr + 512 + 64 * (my_xcc & 7u), 1u, __ATOMIC_RELAXED, __HIP_MEMORY_SCOPE_AGENT);

    for (int rep0 = 0; rep0 < REP_P0; ++rep0) {
        LAS float* scr = (LAS float*)(lds + wave * 16384);
        constexpr int I_IN = (DM / 64) * (NIN / 32), I_A = (512 / 64) * (DM / 32), I_B = (256 / 64) * (DM / 32), I_O = (DM / 64) * (DM / 32), I_U = (DM / 64) * (DFF / 32), I_D = (DFF / 64) * (DM / 32);
        constexpr int NIT = I_IN + I_A + I_B + I_O + I_U + I_D;
        for (int it = gw; it < NIT; it += NGW) {
            int r = it;
            if (r < I_IN) { p0_transpose_item(w_in, DM, NIN, Win_t, nullptr, scr, r, lane); continue; } r -= I_IN;
            if (r < I_A) { p0_transpose_item(w_a, 512, DM, Wa_t, nullptr, scr, r, lane, 1.f / 255.f, 768, 0); continue; }     r -= I_A;
            if (r < I_B) { p0_transpose_item(w_b, 256, DM, Wa_t, nullptr, scr, r, lane, 1.f / 255.f, 768, 512); continue; }     r -= I_B;
            if (r < I_O) { p0_transpose_item(w_out, DM, DM, Wout_t, nullptr, scr, r, lane); continue; } r -= I_O;
            if (r < I_U) { p0_transpose_item(w_up, DM, DFF, Wup_t, g_mlp, scr, r, lane); continue; } r -= I_U;
            p0_transpose_item(w_dn, DFF, DM, Wdn_t, nullptr, scr, r, lane);
        }
        f32x4 gv[4];
#pragma unroll
        for (int j = 0; j < 4; ++j) gv[j] = ((const f32x4*)g_mix)[lane + 64 * j];
        for (int m = gw; m < TT; m += 2 * NGW) {
            const int m2 = m + NGW; const bool has2 = m2 < TT;
            const float* xrow = (m < TP) ? x_p + (size_t)m * DM : x_s + (size_t)(m - TP) * DM;
            const float* xrow2 = has2 ? ((m2 < TP) ? x_p + (size_t)m2 * DM : x_s + (size_t)(m2 - TP) * DM) : xrow;
            const f32x4* xr = (const f32x4*)xrow + lane; const f32x4* xr2 = (const f32x4*)xrow2 + lane; f32x4 v[4], w2[4]; float s2 = 0.f, t2 = 0.f;
#pragma unroll
            for (int j = 0; j < 4; ++j) { v[j] = xr[64 * j]; w2[j] = xr2[64 * j]; }
#pragma unroll
            for (int j = 0; j < 4; ++j) { s2 += (v[j].x * v[j].x + v[j].y * v[j].y) + (v[j].z * v[j].z + v[j].w * v[j].w); t2 += (w2[j].x * w2[j].x + w2[j].y * w2[j].y) + (w2[j].z * w2[j].z + w2[j].w * w2[j].w); }
            const float rs = __builtin_amdgcn_rsqf(wave_sum(s2) * (1.f / DM) + RMS_EPS), rt = __builtin_amdgcn_rsqf(wave_sum(t2) * (1.f / DM) + RMS_EPS);
            v2u* o8 = (v2u*)(XN + (size_t)m * DM) + lane;
#pragma unroll
            for (int j = 0; j < 4; ++j) { v2u w; w.x = cvtpk(v[j].x * rs * gv[j].x, v[j].y * rs * gv[j].y); w.y = cvtpk(v[j].z * rs * gv[j].z, v[j].w * rs * gv[j].w); o8[64 * j] = w; }
            if (has2) { v2u* p8 = (v2u*)(XN + (size_t)m2 * DM) + lane;
#pragma unroll
                for (int j = 0; j < 4; ++j) { v2u w; w.x = cvtpk(w2[j].x * rt * gv[j].x, w2[j].y * rt * gv[j].y); w.y = cvtpk(w2[j].z * rt * gv[j].z, w2[j].w * rt * gv[j].w); p8[64 * j] = w; } }
        }
    }
    GSYNC();
    int vbx = bx;
    { LAS int* vslot = (LAS int*)(lds + RING_BYTES);
      if (tid == 0) { bool ok = (G % 8 == 0) && (my_xcc < 8u);
          for (int j = 0; j < 8; ++j) ok = ok && (__hip_atomic_load(bar_ctr + 512 + 64 * j, __ATOMIC_RELAXED, __HIP_MEMORY_SCOPE_AGENT) == (unsigned)(G / 8));
          *vslot = ok ? (int)(my_rank * 8u + my_xcc) : bx; }
      __syncthreads(); vbx = __builtin_amdgcn_readfirstlane(*vslot); }
#ifndef NO_P1
#ifdef STAGGER
    if ((bx & 7) >= 4) { for (int z_ = 0; z_ < STAGGER; ++z_) __builtin_amdgcn_s_sleep(127); }
#endif
    for (int rep = 0; rep < REP_P1; ++rep) { pg8::Gemm g{XN, Win_t, TT, NIN, DM}; pg8::StaticOrder S; S.init(TT, NIN, G, vbx); pg8::EpiIn E{Zb, Gt, b_gate};
      pg8::gemm_phase<pg8::EpiIn, pg8::StaticOrder, true, true>(lds, g, S, E); }
#endif
    GSYNC();
#ifndef NO_P2
    for (int rep = 0; rep < REP_P2; ++rep) att::attn_phase(lds, Zb, rel_bias, sink, OA, OBG, LSE, rep ? ABL_P2 : 0);
#endif
    GSYNC();
#ifndef NO_P2B
#ifdef EXTRA_BAR
    for (int e_ = 0; e_ < EXTRA_BAR; ++e_) GSYNC();
#endif
    for (int repb = 0; repb < REP_P2B; ++repb)
    for (unsigned idx = (unsigned)bx * 512u + (unsigned)tid; idx < (unsigned)TT * 32u; idx += (unsigned)G * 512u) {
        const size_t tok = idx >> 5; const int part = (int)(idx & 31u), hh = part >> 3;
        const float l0 = LSE[tok * 4 + hh], l1 = LSE[((size_t)TT + tok) * 4 + hh], l2 = LSE[((size_t)2 * TT + tok) * 4 + hh];
        const float mx = fmaxf(l0, fmaxf(l1, l2)); float w0 = __builtin_amdgcn_exp2f(l0 - mx), w1 = __builtin_amdgcn_exp2f(l1 - mx), w2 = __builtin_amdgcn_exp2f(l2 - mx);
        const float inv = 1.f / (w0 + w1 + w2); w0 *= inv; w1 *= inv; w2 *= inv;
        const v4u a0 = *(const v4u*)(OBG + tok * 256 + part * 8), a1 = *(const v4u*)(OBG + ((size_t)TT + tok) * 256 + part * 8), a2 = *(const v4u*)(OBG + ((size_t)2 * TT + tok) * 256 + part * 8);
        v4u o;
        o.x = cvtpk(w0 * bf_lo(a0.x) + w1 * bf_lo(a1.x) + w2 * bf_lo(a2.x), w0 * bf_hi(a0.x) + w1 * bf_hi(a1.x) + w2 * bf_hi(a2.x));
        o.y = cvtpk(w0 * bf_lo(a0.y) + w1 * bf_lo(a1.y) + w2 * bf_lo(a2.y), w0 * bf_hi(a0.y) + w1 * bf_hi(a1.y) + w2 * bf_hi(a2.y));
        o.z = cvtpk(w0 * bf_lo(a0.z) + w1 * bf_lo(a1.z) + w2 * bf_lo(a2.z), w0 * bf_hi(a0.z) + w1 * bf_hi(a1.z) + w2 * bf_hi(a2.z));
        o.w = cvtpk(w0 * bf_lo(a0.w) + w1 * bf_lo(a1.w) + w2 * bf_lo(a2.w), w0 * bf_hi(a0.w) + w1 * bf_hi(a1.w) + w2 * bf_hi(a2.w));
        *(v4u*)(OA + tok * 768 + 512 + part * 8) = o;
    }
#endif
    GSYNC();
#ifndef NO_P3
    { pg8::Gemm g{OA, Wa_t, TT, DM, 768}; pg8::StaticOrder S; S.init(TT, DM, G, vbx); pg8::EpiGate2 E{MRG, (const unsigned char*)Gt};
      pg8::gemm_phase<pg8::EpiGate2, pg8::StaticOrder, true, true>(lds, g, S, E); }
#endif
    GSYNC();
#ifndef NO_P4
    for (int rep = 0; rep < REP_P4; ++rep) { pg8::Gemm g{MRG, Wout_t, TT, DM, DM}; pg8::StaticOrder S; S.init(TT, DM, G, vbx); pg8::EpiRes<true> E{x_p, x_s, out, X1B, SSQ1};
      pg8::gemm_phase<pg8::EpiRes<true>, pg8::StaticOrder, true, true>(lds, g, S, E); }
#endif
    GSYNC();
#ifndef NO_P5
#ifdef STAGGER
    if ((bx & 7) >= 4) { for (int z_ = 0; z_ < STAGGER; ++z_) __builtin_amdgcn_s_sleep(127); }
#endif
    for (int rep = 0; rep < REP_P5; ++rep) { pg8::Gemm g{X1B, Wup_t, TT, DFF, DM}; pg8::StaticOrder S; S.init(TT, DFF, G, vbx); pg8::EpiUp E{Hb, SSQ1};
      pg8::gemm_phase<pg8::EpiUp, pg8::StaticOrder, true, true>(lds, g, S, E); }
#endif
    GSYNC();
#ifndef NO_P6
    { pg8::Gemm g{Hb, Wdn_t, TT, DM, DFF}; pg8::StaticOrder S; S.init(TT, DM, G, vbx); pg8::EpiFinal E{out, X1B, SSQ2, bar_ctr + 1024, g_fin};
      pg8::gemm_phase<pg8::EpiFinal, pg8::StaticOrder, true, true>(lds, g, S, E); }
#endif
    grid.sync();
}

extern "C" void kernel_launch(void* const* d_in, const int* in_sizes, int n_in, void* d_out, int out_size, void* d_ws, size_t ws_size, hipStream_t stream) {
    static int grid = 0;
    if (grid == 0) {
        if (n_in != 14 || ws_size < WS_END || out_size != TT * DM) { fprintf(stderr, "kernel_launch: unexpected shapes (n_in %d, ws %zu, out %d)\n", n_in, ws_size, out_size); grid = -1; return; }
        int dev = 0, cus = 0, per_cu = 0;
        hipGetDevice(&dev); hipDeviceGetAttribute(&cus, hipDeviceAttributeMultiprocessorCount, dev);
        if (hipFuncSetAttribute((const void*)mk_fwd, hipFuncAttributeMaxDynamicSharedMemorySize, LDS_BYTES) != hipSuccess) { fprintf(stderr, "kernel_launch: hipFuncSetAttribute failed\n"); grid = -1; return; }
        if (hipOccupancyMaxActiveBlocksPerMultiprocessor(&per_cu, (const void*)mk_fwd, 512, LDS_BYTES) != hipSuccess || per_cu < 1) { fprintf(stderr, "kernel_launch: occupancy query failed (%d)\n", per_cu); (void)hipGetLastError(); per_cu = 1; }
        grid = cus * per_cu;
        if (grid != 256) fprintf(stderr, "kernel_launch: grid %d != 256: the fused final-norm exchange assumes 256 workgroups (waits are bounded, results would be wrong)\n", grid);
    }
    if (grid < 0) return;
    if (hipMemsetAsync(d_ws, 0, 131072, stream) != hipSuccess) { fprintf(stderr, "kernel_launch: memset of the barrier words failed\n"); return; }
    Args a{};
    for (int i = 0; i < 14; ++i) a.in[i] = (const float*)d_in[i];
    a.out = (float*)d_out; a.ws = (unsigned char*)d_ws;
    void* args[] = {&a};
    hipError_t e = hipLaunchCooperativeKernel((const void*)mk_fwd, dim3(grid), dim3(512), args, LDS_BYTES, stream);
    if (e != hipSuccess) fprintf(stderr, "cooperative launch failed: %s (grid %d)\n", hipGetErrorString(e), grid);
}
```

```cpp
#include <hip/hip_runtime.h>
#include <hip/hip_cooperative_groups.h>
#include <cstdio>
#include <cstdint>
namespace cg = cooperative_groups;
namespace pg8 {
#define PG8_LAS __attribute__((address_space(3)))
typedef unsigned short bf16_t;
typedef short bf16x8 __attribute__((ext_vector_type(8)));
typedef float f32x4 __attribute__((ext_vector_type(4)));
typedef unsigned u32x4 __attribute__((ext_vector_type(4)));
constexpr int BM = 256, BK = 64, HALF = 128, HTB = HALF * BK * 2  , STAGE_BYTES = 8 * HTB, NXCD = 8, WGM = 8;

__host__ __device__ __forceinline__ int lds_byte(int r, int c) { const int st = (r >> 4) * 2 + (c >> 5), rr = r & 15, cc = c & 31, ob = rr * 64 + cc * 2; return st * 1024 + (ob ^ (((ob >> 9) & 1) << 5)); }
__host__ __device__ __forceinline__ void stage_rc(int b, int& R, int& C) { const int st = b / 1024, sb = b % 1024, swz = sb ^ (((sb >> 9) & 1) << 5); R = (st >> 1) * 16 + swz / 64; C = (st & 1) * 32 + (swz % 64) / 2; }
__host__ __device__ __forceinline__ int perm32(int rho) { const int n = rho >> 4, i = rho & 15; return 8 * (i >> 2) + 4 * n + (i & 3); }

struct Unit { int pm, pn; };
struct Gemm { const bf16_t* A; const bf16_t* Bt; int M, N, K; };

struct StaticOrder {
    int nM, nN, nwg, G, c;
    __host__ __device__ void init(int M, int N, int G_, int c_) { nM = M / BM; nN = N / BM; nwg = nM * nN; G = G_; c = c_; }
    __host__ __device__ bool next(int i, Unit& u) const {
        const long L = (long)i * G + c; if (L >= nwg) return false;
        int wgid = (int)L; { const int q = nwg / NXCD, r = nwg % NXCD, xcd = wgid % NXCD, off = wgid / NXCD; wgid = (xcd < r ? xcd * (q + 1) : r * (q + 1) + (xcd - r) * q) + off; }
        const int nig = WGM * nN, gid = wgid / nig, fm = gid * WGM, gsz = (nM - fm) < WGM ? (nM - fm) : WGM;
        u.pm = fm + ((wgid % nig) % gsz); u.pn = (wgid % nig) / gsz; return true;
    }
    __device__ __forceinline__ void a_ready(const Unit&) const {}
    __device__ __forceinline__ void done(const Unit&) const {}
};

typedef float f32x2c_t __attribute__((ext_vector_type(2))); typedef __bf16 bf16x2c_t __attribute__((ext_vector_type(2)));
__device__ __forceinline__ unsigned cvt_pk_bf16(float lo, float hi) { const f32x2c_t v = {lo, hi}; const bf16x2c_t b = __builtin_convertvector(v, bf16x2c_t); return __builtin_bit_cast(unsigned, b); }
typedef float f32x2 __attribute__((ext_vector_type(2)));
__device__ __forceinline__ f32x2 gelu_pk(f32x2 v) {
    const f32x2 av = __builtin_elementwise_abs(v), d = av * 0.2316418882f + 1.0f;
    f32x2 t; t.x = __builtin_amdgcn_rcpf(d.x); t.y = __builtin_amdgcn_rcpf(d.y);
    f32x2 q = t * 0.5307027145f + (-0.7265760135f); q = q * t + 0.7107068705f; q = q * t + (-0.142248368f); q = q * t + 0.127414796f; q = q * t;
    const f32x2 s = (v * v) * (-0.72134752044f);
    f32x2 e; e.x = __builtin_amdgcn_exp2f(s.x); e.y = __builtin_amdgcn_exp2f(s.y);
    const f32x2 m = v * (q * e), r = v - m;
    f32x2 o; o.x = v.x < 0.f ? m.x : r.x; o.y = v.y < 0.f ? m.y : r.y; return o;
}

template <int ACT  > struct EpiBf16 {
    static constexpr bool PERM = true, AFTER_DRAIN = false; static_assert(ACT == 0 || ACT == 1, "EpiBf16: ACT is 0 (none) or 1 (gelu_pk)");
    bf16_t* O; int ldc; const float* bias; int split_cols; size_t split_stride; float scale0;
    __device__ __forceinline__ void operator()(const f32x4 (&acc)[2][2][4][2], const Unit& u, int wr, int wc, int fr, int fq) const {
        const int row0 = u.pm * BM + wr * 64 + fr; int colt = u.pn * BM; bf16_t* base = O;
        float sc = 1.f; if (split_cols) { const int t = colt / split_cols; base += (size_t)t * split_stride; colt -= t * split_cols; if (t == 0) sc = scale0; }
        const int col0 = colt + wc * 32 + 8 * fq, bcol0 = u.pn * BM + wc * 32 + 8 * fq;
        f32x4 bv[2][2];
#pragma unroll
        for (int bj = 0; bj < 2; ++bj)
#pragma unroll
            for (int n = 0; n < 2; ++n) bv[bj][n] = bias ? *(const f32x4*)(bias + bcol0 + bj * HALF + 4 * n) : (f32x4){0.f, 0.f, 0.f, 0.f};
#pragma unroll
        for (int ai = 0; ai < 2; ++ai)
#pragma unroll
            for (int m = 0; m < 4; ++m) { bf16_t* rowp = base + (size_t)(row0 + ai * HALF + m * 16) * ldc + col0;
#pragma unroll
                for (int bj = 0; bj < 2; ++bj) { f32x4 v0 = acc[ai][bj][m][0] + bv[bj][0], v1 = acc[ai][bj][m][1] + bv[bj][1];
                    if (ACT == 1) { f32x2 a = gelu_pk((f32x2){v0[0], v0[1]}), b = gelu_pk((f32x2){v0[2], v0[3]}), c = gelu_pk((f32x2){v1[0], v1[1]}), d = gelu_pk((f32x2){v1[2], v1[3]});
                        v0 = (f32x4){a.x, a.y, b.x, b.y}; v1 = (f32x4){c.x, c.y, d.x, d.y}; }
                    v0 = v0 * sc; v1 = v1 * sc; u32x4 w; w.x = cvt_pk_bf16(v0[0], v0[1]); w.y = cvt_pk_bf16(v0[2], v0[3]); w.z = cvt_pk_bf16(v1[0], v1[1]); w.w = cvt_pk_bf16(v1[2], v1[3]);
                    *(u32x4*)(rowp + bj * HALF) = w; } }
    }
};
template <class Epi, class Sched, bool ALIGN_EPI = false, bool SP2 = false>
__device__ __forceinline__ void gemm_phase(PG8_LAS unsigned char* lds, const Gemm g, const Sched& S, const Epi& E) {
    int tid_l = threadIdx.x; asm volatile("" : "+v"(tid_l));
    const int tid = tid_l, wid = __builtin_amdgcn_readfirstlane(tid >> 6), lane = tid & 63, wr = wid >> 2, wc = wid & 3, fr = lane & 15, fq = lane >> 4;
    const int K = g.K, nt = K / BK;
    unsigned voffA[2], voffB[2];
#pragma unroll
    for (int i = 0; i < 2; ++i) { int R, C; stage_rc(tid * 16 + i * 8192, R, C); const int Rb = Epi::PERM ? ((R & ~31) + perm32(R & 31)) : R;
        voffA[i] = (unsigned)(R * K + C) * 2u; voffB[i] = (unsigned)(Rb * K + C) * 2u; }
    const size_t kstep = (size_t)(BK * 2);
    const size_t hstep = (size_t)HALF * K * 2;
    const size_t tstep = 2 * hstep;
    const unsigned ldsw = (unsigned)wid * 1024u;
    const int aoff = lds_byte(wr * 64 + fr, fq * 8), boff = lds_byte(wc * 32 + fr, fq * 8);
#define PG8_SA(b, h) (((b) * 2 + (h)) * HTB)
#define PG8_SB(b, h) ((4 + (b) * 2 + (h)) * HTB)
#define PG8_STAGE(bufoff, gbase, voff) do { _Pragma("unroll") for (int _i = 0; _i < 2; ++_i) \
        __builtin_amdgcn_global_load_lds((const unsigned*)((const char*)(gbase) + (voff)[_i]), (PG8_LAS unsigned*)(lds + (bufoff) + ldsw + _i * 8192), 16, 0, 0); } while (0)
#define PG8_LDA(dst, b, h) do { _Pragma("unroll") for (int m = 0; m < 4; ++m) _Pragma("unroll") for (int k = 0; k < 2; ++k) dst[m][k] = *(const PG8_LAS bf16x8*)(lds + PG8_SA(b, h) + aoff + m * 2048 + k * 1024); } while (0)
#define PG8_LDB(dst, b, h) do { _Pragma("unroll") for (int n = 0; n < 2; ++n) _Pragma("unroll") for (int k = 0; k < 2; ++k) dst[n][k] = *(const PG8_LAS bf16x8*)(lds + PG8_SB(b, h) + boff + n * 2048 + k * 1024); } while (0)
#define PG8_MMA(ai, bj, At, Bt) do { __builtin_amdgcn_s_setprio(1); _Pragma("unroll") for (int m = 0; m < 4; ++m) _Pragma("unroll") for (int n = 0; n < 2; ++n) _Pragma("unroll") for (int k = 0; k < 2; ++k) \
        acc[ai][bj][m][n] = __builtin_amdgcn_mfma_f32_16x16x32_bf16(Bt[n][k], At[m][k], acc[ai][bj][m][n], 0, 0, 0); __builtin_amdgcn_s_setprio(0); } while (0)
#define PG8_WAIT_V(n) asm volatile("s_waitcnt vmcnt(" #n ")" ::: "memory")
#define PG8_WAIT_L(n) asm volatile("s_waitcnt lgkmcnt(" #n ")" ::: "memory")
#define PG8_BAR __builtin_amdgcn_s_barrier()
#define PG8_SCHED __builtin_amdgcn_sched_barrier(0)
    Unit cur, nxt; int ui = 0;
    if (!S.next(0, cur)) return;
    f32x4 acc[2][2][4][2];
#pragma unroll
    for (int a = 0; a < 2; ++a)
#pragma unroll
        for (int b = 0; b < 2; ++b)
#pragma unroll
            for (int m = 0; m < 4; ++m)
#pragma unroll
                for (int n = 0; n < 2; ++n) acc[a][b][m][n] = (f32x4){0.f, 0.f, 0.f, 0.f};
    bf16x8 At[4][2], B0[2][2], B1[2][2];
    const char* cA = (const char*)g.A + (size_t)cur.pm * tstep; const char* cB = (const char*)g.Bt + (size_t)cur.pn * tstep;
    S.a_ready(cur);
    if constexpr (SP2) {
        PG8_STAGE(PG8_SB(0, 0), cB, voffB); PG8_STAGE(PG8_SB(0, 1), cB + hstep, voffB); PG8_STAGE(PG8_SA(0, 0), cA, voffA); PG8_STAGE(PG8_SA(0, 1), cA + hstep, voffA);
        if (wr == 1) PG8_BAR;
        PG8_WAIT_V(2); PG8_BAR;
        PG8_STAGE(PG8_SB(1, 0), cB + kstep, voffB); PG8_STAGE(PG8_SA(1, 0), cA + kstep, voffA); PG8_STAGE(PG8_SB(1, 1), cB + hstep + kstep, voffB);
        PG8_WAIT_V(6); PG8_BAR;
    } else {
        PG8_STAGE(PG8_SB(0, 0), cB, voffB); PG8_STAGE(PG8_SA(0, 0), cA, voffA); PG8_STAGE(PG8_SB(0, 1), cB + hstep, voffB); PG8_STAGE(PG8_SA(0, 1), cA + hstep, voffA);
        if (wr == 1) PG8_BAR;
        PG8_WAIT_V(4); PG8_BAR;
        PG8_STAGE(PG8_SB(1, 0), cB + kstep, voffB); PG8_STAGE(PG8_SA(1, 0), cA + kstep, voffA); PG8_STAGE(PG8_SB(1, 1), cB + hstep + kstep, voffB);
        PG8_WAIT_V(6); PG8_BAR;
    }
    for (;;) {
        const bool has_next = S.next(ui + 1, nxt);
        const char* nA = has_next ? (const char*)g.A + (size_t)nxt.pm * tstep : cA; const char* nB = has_next ? (const char*)g.Bt + (size_t)nxt.pn * tstep : cB;
        for (int t = 0; t < nt; t += 2) {
            if constexpr (Epi::MID_T > 0) { if (t == Epi::MID_T) E.mid(acc, cur, wr, wc, fr, fq); }
            const bool last = (t == nt - 2);
            const char* a1 = cA + (size_t)(t + 1) * kstep;
            const char* a2 = last ? nA : cA + (size_t)(t + 2) * kstep; const char* b2 = last ? nB : cB + (size_t)(t + 2) * kstep;
            const char* a3 = a2 + kstep; const char* b3 = b2 + kstep;
            if (last && has_next) S.a_ready(nxt);
            if constexpr (SP2) {
            PG8_LDB(B0, 0, 0); PG8_LDB(B1, 0, 1); PG8_SCHED; PG8_LDA(At, 0, 0); PG8_STAGE(PG8_SA(1, 1), a1 + hstep, voffA);
            PG8_WAIT_V(8); PG8_WAIT_L(0); PG8_BAR; PG8_MMA(0, 0, At, B0); PG8_MMA(0, 1, At, B1); PG8_BAR; PG8_SCHED;
            PG8_LDA(At, 0, 1); PG8_STAGE(PG8_SB(0, 0), b2, voffB); PG8_STAGE(PG8_SB(0, 1), b2 + hstep, voffB); PG8_STAGE(PG8_SA(0, 0), a2, voffA);
            PG8_WAIT_V(8); PG8_WAIT_L(0); PG8_BAR; PG8_MMA(1, 0, At, B0); PG8_MMA(1, 1, At, B1); PG8_BAR; PG8_SCHED;
            PG8_LDB(B0, 1, 0); PG8_LDB(B1, 1, 1); PG8_SCHED; PG8_LDA(At, 1, 0); PG8_STAGE(PG8_SA(0, 1), a2 + hstep, voffA);
            PG8_WAIT_V(8); PG8_WAIT_L(0); PG8_BAR; PG8_MMA(0, 0, At, B0); PG8_MMA(0, 1, At, B1); PG8_BAR; PG8_SCHED;
            PG8_LDA(At, 1, 1); PG8_STAGE(PG8_SB(1, 0), b3, voffB); PG8_STAGE(PG8_SB(1, 1), b3 + hstep, voffB); PG8_STAGE(PG8_SA(1, 0), a3, voffA);
            PG8_WAIT_V(8); PG8_WAIT_L(0); PG8_BAR; PG8_MMA(1, 0, At, B0); PG8_MMA(1, 1, At, B1); PG8_BAR; PG8_SCHED;
            } else {
            PG8_LDB(B0, 0, 0); PG8_SCHED; PG8_LDA(At, 0, 0); PG8_STAGE(PG8_SA(1, 1), a1 + hstep, voffA);
            PG8_WAIT_L(8); PG8_BAR; PG8_WAIT_L(0); PG8_MMA(0, 0, At, B0); PG8_BAR; PG8_SCHED;
            PG8_LDB(B1, 0, 1); PG8_STAGE(PG8_SB(0, 0), b2, voffB);
            PG8_BAR; PG8_WAIT_L(0); PG8_MMA(0, 1, At, B1); PG8_BAR;
            PG8_LDA(At, 0, 1); PG8_STAGE(PG8_SA(0, 0), a2, voffA);
            PG8_BAR; PG8_WAIT_L(0); PG8_MMA(1, 0, At, B0); PG8_BAR; PG8_SCHED;
            PG8_STAGE(PG8_SB(0, 1), b2 + hstep, voffB);
            PG8_WAIT_V(6); PG8_BAR; PG8_MMA(1, 1, At, B1); PG8_BAR;
            PG8_LDB(B0, 1, 0); PG8_SCHED; PG8_LDA(At, 1, 0); PG8_STAGE(PG8_SA(0, 1), a2 + hstep, voffA);
            PG8_WAIT_L(8); PG8_BAR; PG8_WAIT_L(0); PG8_MMA(0, 0, At, B0); PG8_BAR; PG8_SCHED;
            PG8_LDB(B1, 1, 1); PG8_STAGE(PG8_SB(1, 0), b3, voffB);
            PG8_BAR; PG8_WAIT_L(0); PG8_MMA(0, 1, At, B1); PG8_BAR;
            PG8_LDA(At, 1, 1); PG8_STAGE(PG8_SA(1, 0), a3, voffA);
            PG8_BAR; PG8_WAIT_L(0); PG8_MMA(1, 0, At, B0); PG8_BAR; PG8_SCHED;
            PG8_STAGE(PG8_SB(1, 1), b3 + hstep, voffB);
            PG8_WAIT_V(6); PG8_BAR; PG8_MMA(1, 1, At, B1); PG8_BAR;
            }
        }
        if constexpr (ALIGN_EPI) { if (wr == 0) PG8_BAR; }
        if constexpr (!Epi::AFTER_DRAIN) { E(acc, cur, wr, wc, fr, fq); S.done(cur); }
        if (!has_next) break;
#pragma unroll
        for (int a = 0; a < 2; ++a)
#pragma unroll
            for (int b = 0; b < 2; ++b)
#pragma unroll
                for (int m = 0; m < 4; ++m)
#pragma unroll
                    for (int n = 0; n < 2; ++n) acc[a][b][m][n] = (f32x4){0.f, 0.f, 0.f, 0.f};
        cur = nxt; cA = nA; cB = nB; ++ui;
        if constexpr (ALIGN_EPI) { if (wr == 1) PG8_BAR; }
    }
    PG8_WAIT_V(0);
    if constexpr (!ALIGN_EPI) { if (wr == 0) PG8_BAR; }
    PG8_BAR;
    if constexpr (Epi::AFTER_DRAIN) { E.fused(acc, cur, wr, wc, fr, fq, lds, wid, lane); S.done(cur); }
#undef PG8_SA
#undef PG8_SB
#undef PG8_STAGE
#undef PG8_LDA
#undef PG8_LDB
#undef PG8_MMA
#undef PG8_WAIT_V
#undef PG8_WAIT_L
#undef PG8_BAR
#undef PG8_SCHED
}
}

constexpr int DM = 1024, TP = 8 * 2048, TSM = 8 * 8192, TT = TP + TSM;
constexpr int NIN = 5120, DFF = 4096, ZC = 3072, GC = 2048;
constexpr float RMS_EPS = 1e-6f, LOG2E = 1.4426950408889634f;
constexpr size_t MiB = 1u << 20;
constexpr size_t WS_WIN = 1 * MiB, WS_WA = 11 * MiB, WS_WB = 12 * MiB, WS_WOUT = 13 * MiB, WS_WUP = 15 * MiB, WS_WDN = 23 * MiB;
constexpr size_t WS_SSQ1 = 32 * MiB, WS_SSQ2 = 37 * MiB;
constexpr size_t WS_XN = 48 * MiB;
constexpr size_t WS_OA = WS_XN, WS_OB = WS_XN + 80 * MiB, WS_X1B = WS_XN;
constexpr size_t WS_Z = 208 * MiB;
constexpr size_t WS_MRG = WS_Z, WS_H = WS_Z;
constexpr size_t WS_G = 688 * MiB;
constexpr size_t WS_END = 1008 * MiB;
constexpr size_t DO_OBG = 0, DO_LSE = 120 * MiB;

constexpr int RING_BYTES = 131072, LDS_BYTES = 147456;

#define LAS __attribute__((address_space(3)))
typedef unsigned short bf16;
typedef unsigned v4u __attribute__((ext_vector_type(4)));
typedef unsigned v2u __attribute__((ext_vector_type(2)));
typedef float f32x4 __attribute__((ext_vector_type(4)));
typedef short bf16x8 __attribute__((ext_vector_type(8)));
typedef short s16x4 __attribute__((ext_vector_type(4)));

__device__ __forceinline__ unsigned cvtpk(float lo, float hi) { return pg8::cvt_pk_bf16(lo, hi); }
__device__ __forceinline__ float bf_lo(unsigned u) { return __builtin_bit_cast(float, u << 16); }
__device__ __forceinline__ float bf_hi(unsigned u) { return __builtin_bit_cast(float, u & 0xffff0000u); }

namespace pg8 {
typedef unsigned u32x2g __attribute__((ext_vector_type(2)));
struct EpiIn {
    static constexpr bool PERM = true, AFTER_DRAIN = false; static constexpr int MID_T = 0;
    bf16_t* Z; bf16_t* Gt; const float* bgate;
    __device__ __forceinline__ void operator()(const f32x4 (&acc)[2][2][4][2], const Unit& u, int wr, int wc, int fr, int fq) const {
        const int row0 = u.pm * BM + wr * 64 + fr;
        const bool isg = u.pn >= 12;
        if (isg) {
            const int col0 = (u.pn - 12) * BM + wc * 32 + 8 * fq;
            f32x4 bv[2][2];
#pragma unroll
            for (int bj = 0; bj < 2; ++bj)
#pragma unroll
                for (int n = 0; n < 2; ++n) bv[bj][n] = *(const f32x4*)(bgate + col0 + bj * HALF + 4 * n);
#pragma unroll
            for (int ai = 0; ai < 2; ++ai)
#pragma unroll
                for (int m = 0; m < 4; ++m) { unsigned char* rowp = (unsigned char*)Gt + (size_t)(row0 + ai * HALF + m * 16) * GC + col0;
#pragma unroll
                    for (int bj = 0; bj < 2; ++bj) { f32x4 v0 = acc[ai][bj][m][0] + bv[bj][0], v1 = acc[ai][bj][m][1] + bv[bj][1];
                        unsigned q[8];
#pragma unroll
                        for (int e = 0; e < 4; ++e) { q[e] = (unsigned)__builtin_rintf(255.f * __builtin_amdgcn_rcpf(1.f + __builtin_amdgcn_exp2f(-LOG2E * v0[e]))); q[4 + e] = (unsigned)__builtin_rintf(255.f * __builtin_amdgcn_rcpf(1.f + __builtin_amdgcn_exp2f(-LOG2E * v1[e]))); }
                        u32x2g w; w.x = q[0] | (q[1] << 8) | (q[2] << 16) | (q[3] << 24); w.y = q[4] | (q[5] << 8) | (q[6] << 16) | (q[7] << 24);
                        *(u32x2g*)(rowp + bj * HALF) = w; } }
        } else {
            const int seqL = (u.pm * BM < TP) ? 2048 : 8192, lsh = (u.pm * BM < TP) ? 11 : 13;
#pragma unroll
            for (int bj = 0; bj < 2; ++bj) {
                const int hslot = (u.pn * BM + bj * HALF + wc * 32) >> 6; const int within = (wc & 1) * 32 + 8 * fq;
                int dsh = 0; if (hslot >= 12) { const int gi = ((hslot - 12) % 12) >> 2; dsh = gi == 0 ? 0 : (gi == 1 ? 2 : 4); }
                bf16_t* hb = Z + (size_t)hslot * TT * 64 + within;
#pragma unroll
                for (int ai = 0; ai < 2; ++ai)
#pragma unroll
                    for (int m = 0; m < 4; ++m) { const int r = row0 + ai * HALF + m * 16; const int rr = r - TP * (r >= TP ? 1 : 0); const int seq0 = r - (rr & (seqL - 1)); const int t = rr & (seqL - 1);
                        const int pos = seq0 + ((t & ((1 << dsh) - 1)) << (lsh - dsh)) + (t >> dsh);
                        const f32x4 v0 = acc[ai][bj][m][0], v1 = acc[ai][bj][m][1];
                        u32x4 w; w.x = cvt_pk_bf16(v0[0], v0[1]); w.y = cvt_pk_bf16(v0[2], v0[3]); w.z = cvt_pk_bf16(v1[0], v1[1]); w.w = cvt_pk_bf16(v1[2], v1[3]);
                        *(u32x4*)(hb + (size_t)pos * 64) = w; } }
        }
    }
};
struct EpiGate2 {
    static constexpr bool PERM = true, AFTER_DRAIN = false; static constexpr int MID_T = 8;
    bf16_t* O; const unsigned char* Gt;
    __device__ __forceinline__ void mid(f32x4 (&acc)[2][2][4][2], const Unit& u, int wr, int wc, int fr, int fq) const {
        asm volatile("" : "+v"(fr), "+v"(fq));
        const int row0 = u.pm * BM + wr * 64 + fr, col0 = u.pn * BM + wc * 32 + 8 * fq;
#pragma unroll
        for (int ai = 0; ai < 2; ++ai)
#pragma unroll
            for (int m = 0; m < 4; ++m) { const size_t r = (size_t)(row0 + ai * HALF + m * 16);
#pragma unroll
                for (int bj = 0; bj < 2; ++bj) {
                    const u32x2g a = *(const u32x2g*)(Gt + r * GC + col0 + bj * HALF), b = *(const u32x2g*)(Gt + r * GC + DM + col0 + bj * HALF);
                    f32x4 v0 = acc[ai][bj][m][0], v1 = acc[ai][bj][m][1];
#define G2R(aw, bw, sh) ((float)(((aw) >> (sh)) & 0xffu) * __builtin_amdgcn_rcpf(fmaxf((float)(((bw) >> (sh)) & 0xffu), 0.5f)))
                    v0[0] *= G2R(a.x, b.x, 0); v0[1] *= G2R(a.x, b.x, 8); v0[2] *= G2R(a.x, b.x, 16); v0[3] *= G2R(a.x, b.x, 24);
                    v1[0] *= G2R(a.y, b.y, 0); v1[1] *= G2R(a.y, b.y, 8); v1[2] *= G2R(a.y, b.y, 16); v1[3] *= G2R(a.y, b.y, 24);
#undef G2R
                    acc[ai][bj][m][0] = v0; acc[ai][bj][m][1] = v1; }
                asm volatile("" ::: "memory"); }
    }
    __device__ __forceinline__ void operator()(const f32x4 (&acc)[2][2][4][2], const Unit& u, int wr, int wc, int fr, int fq) const {
        asm volatile("" : "+v"(fr), "+v"(fq));
        const int row0 = u.pm * BM + wr * 64 + fr, col0 = u.pn * BM + wc * 32 + 8 * fq;
#pragma unroll
        for (int ai = 0; ai < 2; ++ai)
#pragma unroll
            for (int m = 0; m < 4; ++m) { const size_t r = (size_t)(row0 + ai * HALF + m * 16);
#pragma unroll
                for (int bj = 0; bj < 2; ++bj) {
                    const u32x2g b = *(const u32x2g*)(Gt + r * GC + DM + col0 + bj * HALF);
                    f32x4 v0 = acc[ai][bj][m][0], v1 = acc[ai][bj][m][1];
#define G2B(bw, sh) fmaxf((float)(((bw) >> (sh)) & 0xffu), 0.5f)
                    v0[0] *= G2B(b.x, 0); v0[1] *= G2B(b.x, 8); v0[2] *= G2B(b.x, 16); v0[3] *= G2B(b.x, 24);
                    v1[0] *= G2B(b.y, 0); v1[1] *= G2B(b.y, 8); v1[2] *= G2B(b.y, 16); v1[3] *= G2B(b.y, 24);
#undef G2B
                    u32x4 w; w.x = cvt_pk_bf16(v0[0], v0[1]); w.y = cvt_pk_bf16(v0[2], v0[3]); w.z = cvt_pk_bf16(v1[0], v1[1]); w.w = cvt_pk_bf16(v1[2], v1[3]);
                    *(u32x4*)(O + r * DM + col0 + bj * HALF) = w; }
                asm volatile("" ::: "memory"); }
    }
};
template <bool WB> struct EpiRes {
    static constexpr bool PERM = true, AFTER_DRAIN = false; static constexpr int MID_T = 0;
    const float* xp; const float* xs;
    float* out; bf16_t* xb; float* ssq;
    __device__ __forceinline__ void operator()(const f32x4 (&acc)[2][2][4][2], const Unit& u, int wr, int wc, int fr, int fq) const {
        const int row0 = u.pm * BM + wr * 64 + fr, col0 = u.pn * BM + wc * 32 + 8 * fq;
        const float* xbase = (u.pm * BM < TP) ? xp : (xs - (size_t)TP * DM);
#pragma unroll
        for (int ai = 0; ai < 2; ++ai) {
            f32x4 xv[4][2][2];
#pragma unroll
            for (int m = 0; m < 4; ++m)
#pragma unroll
                for (int bj = 0; bj < 2; ++bj) { const size_t off = (size_t)(row0 + ai * HALF + m * 16) * DM + col0 + bj * HALF; xv[m][bj][0] = *(const f32x4*)(xbase + off); xv[m][bj][1] = *(const f32x4*)(xbase + off + 4); }
#pragma unroll
            for (int m = 0; m < 4; ++m) { const size_t r = (size_t)(row0 + ai * HALF + m * 16); float ss = 0.f;
#pragma unroll
                for (int bj = 0; bj < 2; ++bj) { const size_t off = r * DM + col0 + bj * HALF;
                    const f32x4 v0 = acc[ai][bj][m][0] + xv[m][bj][0], v1 = acc[ai][bj][m][1] + xv[m][bj][1];
                    if (!WB) { *(f32x4*)(out + off) = v0; *(f32x4*)(out + off + 4) = v1; }
                    if (WB) { u32x4 w; w.x = cvt_pk_bf16(v0[0], v0[1]); w.y = cvt_pk_bf16(v0[2], v0[3]); w.z = cvt_pk_bf16(v1[0], v1[1]); w.w = cvt_pk_bf16(v1[2], v1[3]); *(u32x4*)(xb + off) = w; }
                    ss += (v0[0] * v0[0] + v0[1] * v0[1]) + (v0[2] * v0[2] + v0[3] * v0[3]) + (v1[0] * v1[0] + v1[1] * v1[1]) + (v1[2] * v1[2] + v1[3] * v1[3]); }
                ss += __shfl_xor(ss, 16); ss += __shfl_xor(ss, 32);
                if (fq == 0) ssq[r * 16 + u.pn * 4 + wc] = ss; }
            asm volatile("" ::: "memory"); }
    }
};
struct EpiUp {
    static constexpr bool PERM = true, AFTER_DRAIN = false; static constexpr int MID_T = 0;
    bf16_t* O; const float* ssq;
    __device__ __forceinline__ void operator()(const f32x4 (&acc)[2][2][4][2], const Unit& u, int wr, int wc, int fr, int fq) const {
        const int row0 = u.pm * BM + wr * 64 + fr, col0 = u.pn * BM + wc * 32 + 8 * fq;
#pragma unroll
        for (int ai = 0; ai < 2; ++ai)
#pragma unroll
            for (int m = 0; m < 4; ++m) { const size_t r = (size_t)(row0 + ai * HALF + m * 16);
                const f32x4 pq = *(const f32x4*)(ssq + r * 16 + 4 * fq);
                float ss = (pq[0] + pq[1]) + (pq[2] + pq[3]); ss += __shfl_xor(ss, 16); ss += __shfl_xor(ss, 32);
                const float rs = __builtin_amdgcn_rsqf(ss * (1.f / DM) + RMS_EPS);
#pragma unroll
                for (int bj = 0; bj < 2; ++bj) { f32x4 v0 = acc[ai][bj][m][0] * rs, v1 = acc[ai][bj][m][1] * rs;
#pragma unroll
                    for (int e = 0; e < 4; ++e) { const float a = fmaxf(v0[e], 0.f), b = fmaxf(v1[e], 0.f); v0[e] = a * a; v1[e] = b * b; }
                    u32x4 w; w.x = cvt_pk_bf16(v0[0], v0[1]); w.y = cvt_pk_bf16(v0[2], v0[3]); w.z = cvt_pk_bf16(v1[0], v1[1]); w.w = cvt_pk_bf16(v1[2], v1[3]);
                    *(u32x4*)(O + r * DFF + col0 + bj * HALF) = w; } }
    }
};
struct EpiFinal {
    static constexpr bool PERM = true, AFTER_DRAIN = false; static constexpr int MID_T = 0;
    float* out; const bf16_t* xb; float* ssq; unsigned* cnt; const float* gfin;
    __device__ __forceinline__ void operator()(f32x4 (&acc)[2][2][4][2], const Unit& u, int wr, int wc, int fr, int fq) const {
        const int row0 = u.pm * BM + wr * 64 + fr, col0 = u.pn * BM + wc * 32 + 8 * fq;
#pragma unroll
        for (int ai = 0; ai < 2; ++ai) {
            u32x4 xv[4][2];
#pragma unroll
            for (int m = 0; m < 4; ++m)
#pragma unroll
                for (int bj = 0; bj < 2; ++bj) { const size_t off = (size_t)(row0 + ai * HALF + m * 16) * DM + col0 + bj * HALF; xv[m][bj] = *(const u32x4*)(xb + off); }
#pragma unroll
            for (int m = 0; m < 4; ++m) { const size_t r = (size_t)(row0 + ai * HALF + m * 16); float ss = 0.f;
#pragma unroll
                for (int bj = 0; bj < 2; ++bj) { const u32x4 xw = xv[m][bj];
                    const f32x4 x0 = {bf_lo(xw.x), bf_hi(xw.x), bf_lo(xw.y), bf_hi(xw.y)}, x1 = {bf_lo(xw.z), bf_hi(xw.z), bf_lo(xw.w), bf_hi(xw.w)};
                    const f32x4 v0 = acc[ai][bj][m][0] + x0, v1 = acc[ai][bj][m][1] + x1; acc[ai][bj][m][0] = v0; acc[ai][bj][m][1] = v1;
                    ss += (v0[0] * v0[0] + v0[1] * v0[1]) + (v0[2] * v0[2] + v0[3] * v0[3]) + (v1[0] * v1[0] + v1[1] * v1[1]) + (v1[2] * v1[2] + v1[3] * v1[3]); }
                ss += __shfl_xor(ss, 16); ss += __shfl_xor(ss, 32);
                if (fq == 0) __hip_atomic_store(ssq + r * 16 + u.pn * 4 + wc, ss, __ATOMIC_RELAXED, __HIP_MEMORY_SCOPE_AGENT); }
            asm volatile("" ::: "memory"); }
        asm volatile("s_waitcnt vmcnt(0)" ::: "memory");
        unsigned* pc = cnt + 64 * u.pm;
        if (fr == 0 && fq == 0) __hip_atomic_fetch_add(pc, 1u, __ATOMIC_RELAXED, __HIP_MEMORY_SCOPE_AGENT);
        unsigned seen;
        { unsigned spins = 0;
          while ((seen = (unsigned)__builtin_amdgcn_readfirstlane(__hip_atomic_load(pc, __ATOMIC_RELAXED, __HIP_MEMORY_SCOPE_AGENT))) < 32u) { __builtin_amdgcn_s_sleep(2); if (++spins > (1u << 22)) break; } }
        const unsigned dep0 = seen >> 31;
        f32x4 gv[2][2];
#pragma unroll
        for (int bj = 0; bj < 2; ++bj)
#pragma unroll
            for (int n = 0; n < 2; ++n) gv[bj][n] = *(const f32x4*)(gfin + col0 + bj * HALF + 4 * n);
#pragma unroll
        for (int ai = 0; ai < 2; ++ai)
#pragma unroll
            for (int m = 0; m < 4; ++m) { const size_t r = (size_t)(row0 + ai * HALF + m * 16);
                const float* pp = ssq + r * 16 + 4 * fq + dep0;
                const float q0 = __hip_atomic_load(pp + 0, __ATOMIC_RELAXED, __HIP_MEMORY_SCOPE_AGENT), q1 = __hip_atomic_load(pp + 1, __ATOMIC_RELAXED, __HIP_MEMORY_SCOPE_AGENT),
                            q2 = __hip_atomic_load(pp + 2, __ATOMIC_RELAXED, __HIP_MEMORY_SCOPE_AGENT), q3 = __hip_atomic_load(pp + 3, __ATOMIC_RELAXED, __HIP_MEMORY_SCOPE_AGENT);
                float tot = (q0 + q1) + (q2 + q3); tot += __shfl_xor(tot, 16); tot += __shfl_xor(tot, 32);
                const float rs = __builtin_amdgcn_rsqf(tot * (1.f / DM) + RMS_EPS);
#pragma unroll
                for (int bj = 0; bj < 2; ++bj) { const size_t off = r * DM + col0 + bj * HALF;
                    *(f32x4*)(out + off) = acc[ai][bj][m][0] * rs * gv[bj][0]; *(f32x4*)(out + off + 4) = acc[ai][bj][m][1] * rs * gv[bj][1]; } }
    }
};
}

__device__ __forceinline__ float wave_sum(float v) {
#pragma unroll
    for (int o = 1; o < 64; o <<= 1) v += __shfl_xor(v, o);
    return v;
}
__device__ __forceinline__ void p0_transpose_item(const float* W, int K, int N, bf16* WT, const float* kscale, LAS float* scr, int item, int lane, float sscale = 1.f, int ld = 0, int koff = 0) {
    if (ld == 0) ld = K;
    const int nblk = N / 32, kb = item / nblk, nb = item % nblk, k0 = 64 * kb, n0 = 32 * nb;
#pragma unroll 8
    for (int i = 0; i < 32; ++i) { const int kk = 2 * i + (lane >> 5); float v = W[(size_t)(k0 + kk) * N + n0 + (lane & 31)] * sscale; if (kscale) v *= kscale[k0 + kk]; scr[kk * 33 + (lane & 31)] = v; }
    asm volatile("s_waitcnt lgkmcnt(0)" ::: "memory");
    const int c = lane & 7;
#pragma unroll
    for (int j = 0; j < 4; ++j) { const int n = (lane >> 3) + 8 * j; const LAS float* s = scr + (8 * c) * 33 + n;
        v4u o; o.x = cvtpk(s[0 * 33], s[1 * 33]); o.y = cvtpk(s[2 * 33], s[3 * 33]); o.z = cvtpk(s[4 * 33], s[5 * 33]); o.w = cvtpk(s[6 * 33], s[7 * 33]);
        *(v4u*)(WT + (size_t)(n0 + n) * ld + koff + k0 + 8 * c) = o; }
    asm volatile("s_waitcnt lgkmcnt(0)" ::: "memory");
}

namespace att {
constexpr int KRS = 144, VRS = 160, NKS_MAX = 384, TBL = 640;
constexpr int L_K = 0, L_V = NKS_MAX * KRS, L_T = L_V + NKS_MAX * VRS, L_PM = L_T + 4 * TBL * 4, L_END = L_PM + 2 * NKS_MAX * 4;
static_assert(L_END <= RING_BYTES, "attention LDS");
constexpr int NITEM_A = (TT / 128) * 2, NITEM_B = (TT / 256) * 12;

__device__ __forceinline__ int rel_bucket(int rel) {
    const int n = rel < 0 ? -rel : rel; int b;
    if (n < 8) b = n; else if (n < 15) b = 8; else if (n < 27) b = 9; else if (n < 50) b = 10; else if (n < 91) b = 11; else if (n < 166) b = 12; else if (n < 305) b = 13; else if (n < 559) b = 14; else b = 15;
    return b + (rel > 0 ? 16 : 0);
}
__device__ __forceinline__ s16x4 vtr(LAS const unsigned char* p) { return __builtin_bit_cast(s16x4, __builtin_amdgcn_ds_read_tr16_b64_v4i16((LAS s16x4*)p)); }

template <int NCH, bool IS_A>
__device__ __forceinline__ void attn_task(LAS const unsigned char* ldsK, LAS const unsigned char* ldsV, LAS const float* tbl, LAS const float* pm, int kstart,
                                          bf16x8& qf0, bf16x8& qf1, const bf16* nq, bool has_nq, int qrel, float sink2, bf16* orow, float* lsep, int qi, int g, int abl = 0) {
    constexpr int NT = 2 * NCH;
    f32x4 s[NT];
    LAS const unsigned char* kp = ldsK + (kstart + qi) * KRS + g * 16;
    LAS const float* pmb = pm + (kstart + 4 * g);
    {
        bf16x8 ka[2][2][2]; f32x4 pz[2][2];
#pragma unroll
        for (int j = 0; j < 2; ++j) { ka[0][j][0] = *(LAS const bf16x8*)(kp + j * 16 * KRS); ka[0][j][1] = *(LAS const bf16x8*)(kp + j * 16 * KRS + 64); pz[0][j] = *(LAS const f32x4*)(pmb + 16 * j); }
#pragma unroll
        for (int tp = 0; tp < NT / 2; ++tp) { const int b = tp & 1;
            if (tp + 1 < NT / 2) {
#pragma unroll
                for (int j = 0; j < 2; ++j) { const int t = 2 * (tp + 1) + j; ka[b ^ 1][j][0] = *(LAS const bf16x8*)(kp + t * 16 * KRS); ka[b ^ 1][j][1] = *(LAS const bf16x8*)(kp + t * 16 * KRS + 64); pz[b ^ 1][j] = *(LAS const f32x4*)(pmb + 16 * t); } }
            __builtin_amdgcn_sched_barrier(0);
#pragma unroll
            for (int j = 0; j < 2; ++j) { f32x4 z = __builtin_amdgcn_mfma_f32_16x16x32_bf16(ka[b][j][0], qf0, pz[b][j], 0, 0, 0); s[2 * tp + j] = __builtin_amdgcn_mfma_f32_16x16x32_bf16(ka[b][j][1], qf1, z, 0, 0, 0); }
            __builtin_amdgcn_sched_barrier(0);
        }
    }
    if (has_nq) { qf0 = *(const bf16x8*)(nq + g * 8); qf1 = *(const bf16x8*)(nq + 32 + g * 8); }
    constexpr float C = 0.125f * LOG2E; const float NEG = -__builtin_inff();
    LAS const float* tb = tbl + (kstart + 4 * g - qrel + TBL / 2);
    float m = NEG;
    {
        float tv[2][8];
#pragma unroll
        for (int i = 0; i < 8; ++i) tv[0][i] = tb[16 * (i >> 2) + (i & 3)];
#pragma unroll
        for (int tp = 0; tp < NT / 2; ++tp) { const int b = tp & 1;
            if (tp + 1 < NT / 2) {
#pragma unroll
                for (int i = 0; i < 8; ++i) tv[b ^ 1][i] = tb[16 * (2 * (tp + 1) + (i >> 2)) + (i & 3)]; }
            __builtin_amdgcn_sched_barrier(0);
#pragma unroll
            for (int i = 0; i < 8; ++i) { const int t = 2 * tp + (i >> 2), r = i & 3; const float v = s[t][r] * C + tv[b][i]; s[t][r] = v; m = fmaxf(m, v); }
            __builtin_amdgcn_sched_barrier(0);
        }
    }
    m = fmaxf(m, __shfl_xor(m, 16)); m = fmaxf(m, __shfl_xor(m, 32));
    if (IS_A) m = fmaxf(m, sink2);
    float sum = 0.f;
#pragma unroll
    for (int t = 0; t < NT; ++t)
#pragma unroll
        for (int r = 0; r < 4; ++r) { const float p = __builtin_amdgcn_exp2f(s[t][r] - m); s[t][r] = p; sum += p; }
    sum += __shfl_xor(sum, 16); sum += __shfl_xor(sum, 32);
    if (IS_A) sum += __builtin_amdgcn_exp2f(sink2 - m);
    const float inv = __builtin_amdgcn_rcpf(sum);
    f32x4 o[4];
#pragma unroll
    for (int d = 0; d < 4; ++d) o[d] = (f32x4){0.f, 0.f, 0.f, 0.f};
    LAS const unsigned char* vp = ldsV + (kstart + 4 * g + (qi >> 2)) * VRS + (qi & 3) * 8;
    {
        s16x4 vl[2][4], vh[2][4];
#pragma unroll
        for (int d = 0; d < 4; ++d) { vl[0][d] = vtr(vp + d * 32); vh[0][d] = vtr(vp + 16 * VRS + d * 32); }
#pragma unroll
        for (int c = 0; c < NCH; ++c) { const int b = c & 1;
            if (c + 1 < NCH) {
#pragma unroll
                for (int d = 0; d < 4; ++d) { vl[b ^ 1][d] = vtr(vp + (32 * (c + 1)) * VRS + d * 32); vh[b ^ 1][d] = vtr(vp + (32 * (c + 1) + 16) * VRS + d * 32); } }
            v4u pw; pw.x = cvtpk(s[2 * c][0], s[2 * c][1]); pw.y = cvtpk(s[2 * c][2], s[2 * c][3]); pw.z = cvtpk(s[2 * c + 1][0], s[2 * c + 1][1]); pw.w = cvtpk(s[2 * c + 1][2], s[2 * c + 1][3]);
            const bf16x8 pb = __builtin_bit_cast(bf16x8, pw);
            __builtin_amdgcn_sched_barrier(0);
#pragma unroll
            for (int d = 0; d < 4; ++d) { const s16x4 lo = vl[b][d], hi = vh[b][d];
                const bf16x8 va = (bf16x8){lo[0], lo[1], lo[2], lo[3], hi[0], hi[1], hi[2], hi[3]};
                o[d] = __builtin_amdgcn_mfma_f32_16x16x32_bf16(va, pb, o[d], 0, 0, 0); }
            __builtin_amdgcn_sched_barrier(0);
        }
    }
#pragma unroll
    for (int d = 0; d < 4; ++d) { v2u w; w.x = cvtpk(o[d][0] * inv, o[d][1] * inv); w.y = cvtpk(o[d][2] * inv, o[d][3] * inv); if (!(abl & 1) || w.x == 0x12345678u) *(v2u*)(orow + 16 * d + 4 * g) = w; }
    if (!IS_A) { if (g == 0 && !(abl & 1)) *lsep = m + __builtin_log2f(sum); }
}

struct Item { int isA, seq0, j0, Lr, Lre, dil, res, hs, pair;
    __device__ __forceinline__ int n() const { return isA ? 128 : 64; }
    __device__ __forceinline__ int nh() const { return isA ? 4 : 1; }
    __device__ __forceinline__ int kslot() const { return isA ? 8 + hs : 24 + hs; }
    __device__ __forceinline__ int vslot() const { return isA ? 10 + hs : 36 + hs; }
    __device__ __forceinline__ int qslot0() const { return isA ? hs * 4 : 12 + hs; }
    __device__ __forceinline__ int bcol0() const { return isA ? hs * 4 : 8 + hs; }
    __device__ __forceinline__ int key() const { return isA ? hs : 2 + hs; }
};
__device__ __forceinline__ Item decode(int k, int na0, int nA, int nb0) {
    Item I; int tok0;
    if (k < nA) { const int ia = na0 + k; I.isA = 1; I.hs = ia / (TT / 128); tok0 = (ia % (TT / 128)) * 128; I.dil = 1; }
    else { const int ib = nb0 + (k - nA); I.hs = ib / (TT / 256); I.isA = 0; const int gi = I.hs >> 2; tok0 = (ib % (TT / 256)) * 256; I.dil = gi == 0 ? 1 : (gi == 1 ? 4 : 16); }
    int L;
    if (tok0 < TP) { L = 2048; I.seq0 = (tok0 / 2048) * 2048; } else { L = 8192; I.seq0 = TP + ((tok0 - TP) / 8192) * 8192; }
    I.res = 0; I.j0 = tok0 - I.seq0; I.Lr = L; I.Lre = L; I.pair = 0;
    if (!I.isA) { I.Lr = L / I.dil; const int blk = (tok0 - I.seq0) / 256;
        if (I.Lr >= 256) { const int bpr = I.Lr / 256; I.res = blk / bpr; I.j0 = (blk % bpr) * 256; I.Lre = I.Lr; }
        else { I.res = 2 * blk; I.j0 = 0; I.Lre = 2 * I.Lr; I.pair = 1; } }
    return I;
}

__device__ __forceinline__ void attn_phase(LAS unsigned char* lds, const bf16* Z, const float* rel_bias, const float* sink, bf16* OA, bf16* OBG, float* LSE, int abl = 0) {
    int tid_l = threadIdx.x; asm volatile("" : "+v"(tid_l));
    const int tid = tid_l, lane = tid & 63, wave = __builtin_amdgcn_readfirstlane(tid >> 6), qi = lane & 15, g = lane >> 4;
    LAS unsigned char* ldsK = lds + L_K; LAS unsigned char* ldsV = lds + L_V; LAS float* tbl = (LAS float*)(lds + L_T); LAS float* pmt = (LAS float*)(lds + L_PM);
    const int G = gridDim.x, bx = blockIdx.x;
    const int na0 = (int)((long)bx * NITEM_A / G), nA = (int)((long)(bx + 1) * NITEM_A / G) - na0;
    const int nb0 = (int)((long)bx * NITEM_B / G), nB = (int)((long)(bx + 1) * NITEM_B / G) - nb0;
    const int nloc = nA + nB, r0 = tid >> 3, ch = tid & 7;
    v4u pk[6], pv[6];
#define ATT_ISSUE(I) do { _Pragma("unroll") for (int i_ = 0; i_ < 6; ++i_) { const int row_ = r0 + 64 * i_, kpos_ = (I).j0 - (I).n() + row_; pk[i_] = (v4u){0u, 0u, 0u, 0u}; pv[i_] = (v4u){0u, 0u, 0u, 0u}; \
        if ((unsigned)kpos_ < (unsigned)(I).Lre && !(abl & 2)) { const size_t ro_ = (size_t)((I).seq0 + (I).res * (I).Lr + kpos_) * 64 + ch * 8; pk[i_] = *(const v4u*)(Z + (size_t)(I).kslot() * TT * 64 + ro_); pv[i_] = *(const v4u*)(Z + (size_t)(I).vslot() * TT * 64 + ro_); } } } while (0)
    if (nloc <= 0) return;
    Item cur = decode(0, na0, nA, nb0), nxt = cur;
#define ATT_QT(I, i_) ((I).isA ? ((wave * 4 + (i_)) & 7) : (wave * 2 + (i_)))
#define ATT_QPTR(I, i_) (Z + ((size_t)((I).qslot0() + ((I).isA ? ((wave * 4 + (i_)) >> 3) : 0)) * TT + (I).seq0 + (I).res * (I).Lr + (I).j0 + 16 * ATT_QT(I, i_) + qi) * 64)
    bf16x8 q0, q1;
    { const bf16* qp = ATT_QPTR(cur, 0); q0 = *(const bf16x8*)(qp + g * 8); q1 = *(const bf16x8*)(qp + 32 + g * 8); }
    asm volatile("" ::: "memory");
    ATT_ISSUE(cur);
    int tkey = -1;
    for (int k = 0; k < nloc; ++k) {
        __syncthreads();
#pragma unroll
        for (int i = 0; i < 6; ++i) { const int row = r0 + 64 * i; *(LAS v4u*)(ldsK + row * KRS + ch * 16) = pk[i]; *(LAS v4u*)(ldsV + row * VRS + ch * 16) = pv[i];
            if (ch == 0) { const unsigned kp = (unsigned)(cur.j0 - cur.n() + row); const float ninf = -__builtin_inff();
                pmt[row] = (kp < (unsigned)(cur.pair ? cur.Lr : cur.Lre)) ? 0.f : ninf;
                pmt[NKS_MAX + row] = (cur.pair ? (kp - (unsigned)cur.Lr < (unsigned)cur.Lr) : (kp < (unsigned)cur.Lre)) ? 0.f : ninf; } }
        if (cur.key() != tkey) { tkey = cur.key();
            for (int i = tid; i < cur.nh() * TBL; i += 512) { const int h = i / TBL, rel = i % TBL - TBL / 2; const int ar = rel < 0 ? -rel : rel;
                tbl[i] = (ar <= cur.n()) ? rel_bias[rel_bucket(rel * cur.dil) * 20 + cur.bcol0() + h] * LOG2E : -__builtin_inff(); } }
        __syncthreads();
        const bool more = (k + 1 < nloc);
        if (more) { nxt = decode(k + 1, na0, nA, nb0); ATT_ISSUE(nxt); }
        asm volatile("" ::: "memory");
        const int ntask = cur.isA ? 4 : 2;
#ifdef ATT_DEPHASE
        if (wave >= 4) { if (cur.isA) __builtin_amdgcn_s_sleep(ATT_DEPHASE); else __builtin_amdgcn_s_sleep((ATT_DEPHASE * 5) / 8); }
#endif
#pragma unroll 1
        for (int i = 0; i < ntask; ++i) {
            const int qt = ATT_QT(cur, i); const bool lastt = (i + 1 == ntask);
            const bf16* nq = lastt ? ATT_QPTR(nxt, 0) : ATT_QPTR(cur, i + 1);
            const bool has_nq = !lastt || more;
            if (cur.isA) { const int h = (wave * 4 + i) >> 3, habs = cur.hs * 4 + h; const int qtok = cur.seq0 + cur.j0 + 16 * qt + qi; const int ks = qt < 6 ? 16 * qt : 96;
                attn_task<9, true>(ldsK, ldsV, tbl + h * TBL, pmt, ks, q0, q1, nq, has_nq, cur.n() + 16 * qt + qi, sink[habs] * LOG2E, OA + (size_t)qtok * 768 + habs * 64, nullptr, qi, g, abl);
            } else { const int jj = cur.j0 + 16 * qt + qi; const int jr = cur.pair ? (jj & (cur.Lr - 1)) : jj, rs = cur.res + (cur.pair ? (jj / cur.Lr) : 0);
                const int qtok = cur.seq0 + jr * cur.dil + rs; const int ks = qt < 14 ? 16 * qt : 224;
                attn_task<5, false>(ldsK, ldsV, tbl, pmt + (qt >> 3) * NKS_MAX, ks, q0, q1, nq, has_nq, cur.n() + 16 * qt + qi, 0.f, OBG + ((size_t)(cur.hs >> 2) * TT + qtok) * 256 + (cur.hs & 3) * 64, LSE + ((size_t)(cur.hs >> 2) * TT + qtok) * 4 + (cur.hs & 3), qi, g, abl);
            }
        }
        cur = nxt;
    }
    __syncthreads();
#undef ATT_ISSUE
#undef ATT_QPTR
#undef ATT_QT
}
}

#ifndef ABL_P2
#define ABL_P2 0
#endif
#ifndef REP_P0
#define REP_P0 1
#endif
#ifndef REP_P2B
#define REP_P2B 1
#endif
#ifndef REP_P3
#define REP_P3 1
#endif
#ifndef REP_P1
#define REP_P1 1
#endif
#ifndef REP_P2
#define REP_P2 1
#endif
#ifndef REP_P4
#define REP_P4 1
#endif
#ifndef REP_P5
#define REP_P5 1
#endif
__device__ __forceinline__ void grid_barrier(unsigned* ctr, unsigned target) {
    asm volatile("s_waitcnt vmcnt(0)" ::: "memory");
    __syncthreads();
    if (threadIdx.x == 0) {
        __builtin_amdgcn_fence(__ATOMIC_RELEASE, "agent");
        asm volatile("s_waitcnt vmcnt(0)" ::: "memory");
        __hip_atomic_fetch_add(ctr, 1u, __ATOMIC_RELAXED, __HIP_MEMORY_SCOPE_AGENT);
        unsigned spins = 0;
        while (__hip_atomic_load(ctr, __ATOMIC_RELAXED, __HIP_MEMORY_SCOPE_AGENT) < target) { __builtin_amdgcn_s_sleep(2); if (++spins > (1u << 24)) break; }
        __builtin_amdgcn_fence(__ATOMIC_ACQUIRE, "agent");
        asm volatile("s_waitcnt vmcnt(0)" ::: "memory");
    }
    __syncthreads();
}
#define GSYNC() do { ++bar_n; grid_barrier(bar_ctr, bar_n * (unsigned)G); } while (0)
struct Args { const float* in[14]; float* out; unsigned char* ws; };

__global__ void __launch_bounds__(512, 2) mk_fwd(Args a) {
    extern __shared__ __attribute__((aligned(16))) unsigned char lds_raw[];
    LAS unsigned char* lds = (LAS unsigned char*)lds_raw;
    cg::grid_group grid = cg::this_grid();
    const int tid = threadIdx.x, lane = tid & 63, wave = __builtin_amdgcn_readfirstlane(tid >> 6);
    const int G = gridDim.x, bx = blockIdx.x;
    const float* x_p = a.in[0]; const float* x_s = a.in[1]; const float* rel_bias = a.in[2]; const float* g_mix = a.in[3]; const float* w_in = a.in[4]; const float* b_gate = a.in[5];
    const float* w_a = a.in[6]; const float* w_b = a.in[7]; const float* w_out = a.in[8]; const float* sink = a.in[9]; const float* g_mlp = a.in[10]; const float* w_up = a.in[11]; const float* w_dn = a.in[12]; const float* g_fin = a.in[13];
    unsigned char* ws = a.ws; float* out = a.out;
    bf16* Win_t = (bf16*)(ws + WS_WIN); bf16* Wa_t = (bf16*)(ws + WS_WA); bf16* Wb_t = (bf16*)(ws + WS_WB); bf16* Wout_t = (bf16*)(ws + WS_WOUT); bf16* Wup_t = (bf16*)(ws + WS_WUP); bf16* Wdn_t = (bf16*)(ws + WS_WDN);
    float* SSQ1 = (float*)(ws + WS_SSQ1); float* SSQ2 = (float*)(ws + WS_SSQ2);
    bf16* XN = (bf16*)(ws + WS_XN); bf16* OA = (bf16*)(ws + WS_OA); bf16* OB = (bf16*)(ws + WS_OB); bf16* X1B = (bf16*)(ws + WS_X1B);
    bf16* Zb = (bf16*)(ws + WS_Z); bf16* MRG = (bf16*)(ws + WS_MRG); bf16* Hb = (bf16*)(ws + WS_H); bf16* Gt = (bf16*)(ws + WS_G);
    bf16* OBG = (bf16*)((unsigned char*)out + DO_OBG); float* LSE = (float*)((unsigned char*)out + DO_LSE);
    const int gw = bx * 8 + wave, NGW = G * 8;
    unsigned* bar_ctr = (unsigned*)ws; unsigned bar_n = 0;
    const unsigned my_xcc = (unsigned)__builtin_amdgcn_s_getreg((3 << 11) | 20) & 0xFu;
    unsigned my_rank = 0;
    if (tid == 0) my_rank = __hip_atomic_fetch_add(bar_ctr + 512 + 64 * (my_xcc & 7u), 1u, __ATOMIC_RELAXED, __HIP_MEMORY_SCOPE_AGENT);

    for (int rep0 = 0; rep0 < REP_P0; ++rep0) {
        LAS float* scr = (LAS float*)(lds + wave * 16384);
        constexpr int I_IN = (DM / 64) * (NIN / 32), I_A = (512 / 64) * (DM / 32), I_B = (256 / 64) * (DM / 32), I_O = (DM / 64) * (DM / 32), I_U = (DM / 64) * (DFF / 32), I_D = (DFF / 64) * (DM / 32);
        constexpr int NIT = I_IN + I_A + I_B + I_O + I_U + I_D;
        for (int it = gw; it < NIT; it += NGW) {
            int r = it;
            if (r < I_IN) { p0_transpose_item(w_in, DM, NIN, Win_t, nullptr, scr, r, lane); continue; } r -= I_IN;
            if (r < I_A) { p0_transpose_item(w_a, 512, DM, Wa_t, nullptr, scr, r, lane, 1.f / 255.f, 768, 0); continue; }     r -= I_A;
            if (r < I_B) { p0_transpose_item(w_b, 256, DM, Wa_t, nullptr, scr, r, lane, 1.f / 255.f, 768, 512); continue; }     r -= I_B;
            if (r < I_O) { p0_transpose_item(w_out, DM, DM, Wout_t, nullptr, scr, r, lane); continue; } r -= I_O;
            if (r < I_U) { p0_transpose_item(w_up, DM, DFF, Wup_t, g_mlp, scr, r, lane); continue; } r -= I_U;
            p0_transpose_item(w_dn, DFF, DM, Wdn_t, nullptr, scr, r, lane);
        }
        f32x4 gv[4];
#pragma unroll
        for (int j = 0; j < 4; ++j) gv[j] = ((const f32x4*)g_mix)[lane + 64 * j];
        for (int m = gw; m < TT; m += 2 * NGW) {
            const int m2 = m + NGW; const bool has2 = m2 < TT;
            const float* xrow = (m < TP) ? x_p + (size_t)m * DM : x_s + (size_t)(m - TP) * DM;
            const float* xrow2 = has2 ? ((m2 < TP) ? x_p + (size_t)m2 * DM : x_s + (size_t)(m2 - TP) * DM) : xrow;
            const f32x4* xr = (const f32x4*)xrow + lane; const f32x4* xr2 = (const f32x4*)xrow2 + lane; f32x4 v[4], w2[4]; float s2 = 0.f, t2 = 0.f;
#pragma unroll
            for (int j = 0; j < 4; ++j) { v[j] = xr[64 * j]; w2[j] = xr2[64 * j]; }
#pragma unroll
            for (int j = 0; j < 4; ++j) { s2 += (v[j].x * v[j].x + v[j].y * v[j].y) + (v[j].z * v[j].z + v[j].w * v[j].w); t2 += (w2[j].x * w2[j].x + w2[j].y * w2[j].y) + (w2[j].z * w2[j].z + w2[j].w * w2[j].w); }
            const float rs = __builtin_amdgcn_rsqf(wave_sum(s2) * (1.f / DM) + RMS_EPS), rt = __builtin_amdgcn_rsqf(wave_sum(t2) * (1.f / DM) + RMS_EPS);
            v2u* o8 = (v2u*)(XN + (size_t)m * DM) + lane;
#pragma unroll
            for (int j = 0; j < 4; ++j) { v2u w; w.x = cvtpk(v[j].x * rs * gv[j].x, v[j].y * rs * gv[j].y); w.y = cvtpk(v[j].z * rs * gv[j].z, v[j].w * rs * gv[j].w); o8[64 * j] = w; }
            if (has2) { v2u* p8 = (v2u*)(XN + (size_t)m2 * DM) + lane;
#pragma unroll
                for (int j = 0; j < 4; ++j) { v2u w; w.x = cvtpk(w2[j].x * rt * gv[j].x, w2[j].y * rt * gv[j].y); w.y = cvtpk(w2[j].z * rt * gv[j].z, w2[j].w * rt * gv[j].w); p8[64 * j] = w; } }
        }
    }
    GSYNC();
    int vbx = bx;
    { LAS int* vslot = (LAS int*)(lds + RING_BYTES);
      if (tid == 0) { bool ok = (G % 8 == 0) && (my_xcc < 8u);
          for (int j = 0; j < 8; ++j) ok = ok && (__hip_atomic_load(bar_ctr + 512 + 64 * j, __ATOMIC_RELAXED, __HIP_MEMORY_SCOPE_AGENT) == (unsigned)(G / 8));
          *vslot = ok ? (int)(my_rank * 8u + my_xcc) : bx; }
      __syncthreads(); vbx = __builtin_amdgcn_readfirstlane(*vslot); }
#ifndef NO_P1
#ifdef STAGGER
    if ((bx & 7) >= 4) { for (int z_ = 0; z_ < STAGGER; ++z_) __builtin_amdgcn_s_sleep(127); }
#endif
    for (int rep = 0; rep < REP_P1; ++rep) { pg8::Gemm g{XN, Win_t, TT, NIN, DM}; pg8::StaticOrder S; S.init(TT, NIN, G, vbx); pg8::EpiIn E{Zb, Gt, b_gate};
      pg8::gemm_phase<pg8::EpiIn, pg8::StaticOrder, true, true>(lds, g, S, E); }
#endif
    GSYNC();
#ifndef NO_P2
    for (int rep = 0; rep < REP_P2; ++rep) att::attn_phase(lds, Zb, rel_bias, sink, OA, OBG, LSE, rep ? ABL_P2 : 0);
#endif
    GSYNC();
#ifndef NO_P2B
#ifdef EXTRA_BAR
    for (int e_ = 0; e_ < EXTRA_BAR; ++e_) GSYNC();
#endif
    for (int repb = 0; repb < REP_P2B; ++repb)
    for (unsigned idx = (unsigned)bx * 512u + (unsigned)tid; idx < (unsigned)TT * 32u; idx += (unsigned)G * 512u) {
        const size_t tok = idx >> 5; const int part = (int)(idx & 31u), hh = part >> 3;
        const float l0 = LSE[tok * 4 + hh], l1 = LSE[((size_t)TT + tok) * 4 + hh], l2 = LSE[((size_t)2 * TT + tok) * 4 + hh];
        const float mx = fmaxf(l0, fmaxf(l1, l2)); float w0 = __builtin_amdgcn_exp2f(l0 - mx), w1 = __builtin_amdgcn_exp2f(l1 - mx), w2 = __builtin_amdgcn_exp2f(l2 - mx);
        const float inv = 1.f / (w0 + w1 + w2); w0 *= inv; w1 *= inv; w2 *= inv;
        const v4u a0 = *(const v4u*)(OBG + tok * 256 + part * 8), a1 = *(const v4u*)(OBG + ((size_t)TT + tok) * 256 + part * 8), a2 = *(const v4u*)(OBG + ((size_t)2 * TT + tok) * 256 + part * 8);
        v4u o;
        o.x = cvtpk(w0 * bf_lo(a0.x) + w1 * bf_lo(a1.x) + w2 * bf_lo(a2.x), w0 * bf_hi(a0.x) + w1 * bf_hi(a1.x) + w2 * bf_hi(a2.x));
        o.y = cvtpk(w0 * bf_lo(a0.y) + w1 * bf_lo(a1.y) + w2 * bf_lo(a2.y), w0 * bf_hi(a0.y) + w1 * bf_hi(a1.y) + w2 * bf_hi(a2.y));
        o.z = cvtpk(w0 * bf_lo(a0.z) + w1 * bf_lo(a1.z) + w2 * bf_lo(a2.z), w0 * bf_hi(a0.z) + w1 * bf_hi(a1.z) + w2 * bf_hi(a2.z));
        o.w = cvtpk(w0 * bf_lo(a0.w) + w1 * bf_lo(a1.w) + w2 * bf_lo(a2.w), w0 * bf_hi(a0.w) + w1 * bf_hi(a1.w) + w2 * bf_hi(a2.w));
        *(v4u*)(OA + tok * 768 + 512 + part * 8) = o;
    }
#endif
    GSYNC();
#ifndef NO_P3
    { pg8::Gemm g{OA, Wa_t, TT, DM, 768}; pg8::StaticOrder S; S.init(TT, DM, G, vbx); pg8::EpiGate2 E{MRG, (const unsigned char*)Gt};
      pg8::gemm_phase<pg8::EpiGate2, pg8::StaticOrder, true, true>(lds, g, S, E); }
#endif
    GSYNC();
#ifndef NO_P4
    for (int rep = 0; rep < REP_P4; ++rep) { pg8::Gemm g{MRG, Wout_t, TT, DM, DM}; pg8::StaticOrder S; S.init(TT, DM, G, vbx); pg8::EpiRes<true> E{x_p, x_s, out, X1B, SSQ1};
      pg8::gemm_phase<pg8::EpiRes<true>, pg8::StaticOrder, true, true>(lds, g, S, E); }
#endif
    GSYNC();
#ifndef NO_P5
#ifdef STAGGER
    if ((bx & 7) >= 4) { for (int z_ = 0; z_ < STAGGER; ++z_) __builtin_amdgcn_s_sleep(127); }
#endif
    for (int rep = 0; rep < REP_P5; ++rep) { pg8::Gemm g{X1B, Wup_t, TT, DFF, DM}; pg8::StaticOrder S; S.init(TT, DFF, G, vbx); pg8::EpiUp E{Hb, SSQ1};
      pg8::gemm_phase<pg8::EpiUp, pg8::StaticOrder, true, true>(lds, g, S, E); }
#endif
    GSYNC();
#ifndef NO_P6
    { pg8::Gemm g{Hb, Wdn_t, TT, DM, DFF}; pg8::StaticOrder S; S.init(TT, DM, G, vbx); pg8::EpiFinal E{out, X1B, SSQ2, bar_ctr + 1024, g_fin};
      pg8::gemm_phase<pg8::EpiFinal, pg8::StaticOrder, true, true>(lds, g, S, E); }
#endif
    grid.sync();
}

extern "C" void kernel_launch(void* const* d_in, const int* in_sizes, int n_in, void* d_out, int out_size, void* d_ws, size_t ws_size, hipStream_t stream) {
    static int grid = 0;
    if (grid == 0) {
        if (n_in != 14 || ws_size < WS_END || out_size != TT * DM) { fprintf(stderr, "kernel_launch: unexpected shapes (n_in %d, ws %zu, out %d)\n", n_in, ws_size, out_size); grid = -1; return; }
        int dev = 0, cus = 0, per_cu = 0;
        hipGetDevice(&dev); hipDeviceGetAttribute(&cus, hipDeviceAttributeMultiprocessorCount, dev);
        if (hipFuncSetAttribute((const void*)mk_fwd, hipFuncAttributeMaxDynamicSharedMemorySize, LDS_BYTES) != hipSuccess) { fprintf(stderr, "kernel_launch: hipFuncSetAttribute failed\n"); grid = -1; return; }
        if (hipOccupancyMaxActiveBlocksPerMultiprocessor(&per_cu, (const void*)mk_fwd, 512, LDS_BYTES) != hipSuccess || per_cu < 1) { fprintf(stderr, "kernel_launch: occupancy query failed (%d)\n", per_cu); (void)hipGetLastError(); per_cu = 1; }
        grid = cus * per_cu;
        if (grid != 256) fprintf(stderr, "kernel_launch: grid %d != 256: the fused final-norm exchange assumes 256 workgroups (waits are bounded, results would be wrong)\n", grid);
    }
    if (grid < 0) return;
    if (hipMemsetAsync(d_ws, 0, 131072, stream) != hipSuccess) { fprintf(stderr, "kernel_launch: memset of the barrier words failed\n"); return; }
    Args a{};
    for (int i = 0; i < 14; ++i) a.in[i] = (const float*)d_in[i];
    a.out = (float*)d_out; a.ws = (unsigned char*)d_ws;
    void* args[] = {&a};
    hipError_t e = hipLaunchCooperativeKernel((const void*)mk_fwd, dim3(grid), dim3(512), args, LDS_BYTES, stream);
    if (e != hipSuccess) fprintf(stderr, "cooperative launch failed: %s (grid %d)\n", hipGetErrorString(e), grid);
}
```

```cpp
#include <hip/hip_runtime.h>
#include <hip/hip_cooperative_groups.h>
#include <cstdio>
#include <cstdint>
namespace cg = cooperative_groups;
namespace pg8 {
#define PG8_LAS __attribute__((address_space(3)))
typedef unsigned short bf16_t;
typedef short bf16x8 __attribute__((ext_vector_type(8)));
typedef float f32x4 __attribute__((ext_vector_type(4)));
typedef unsigned u32x4 __attribute__((ext_vector_type(4)));
constexpr int BM = 256, BK = 64, HALF = 128, HTB = HALF * BK * 2  , STAGE_BYTES = 8 * HTB, NXCD = 8, WGM = 8;

__host__ __device__ __forceinline__ int lds_byte(int r, int c) { const int st = (r >> 4) * 2 + (c >> 5), rr = r & 15, cc = c & 31, ob = rr * 64 + cc * 2; return st * 1024 + (ob ^ (((ob >> 9) & 1) << 5)); }
__host__ __device__ __forceinline__ void stage_rc(int b, int& R, int& C) { const int st = b / 1024, sb = b % 1024, swz = sb ^ (((sb >> 9) & 1) << 5); R = (st >> 1) * 16 + swz / 64; C = (st & 1) * 32 + (swz % 64) / 2; }
__host__ __device__ __forceinline__ int perm32(int rho) { const int n = rho >> 4, i = rho & 15; return 8 * (i >> 2) + 4 * n + (i & 3); }

struct Unit { int pm, pn; };
struct Gemm { const bf16_t* A; const bf16_t* Bt; int M, N, K; int scale_b = 0x7F7F7F7F; };

struct StaticOrder {
    int nM, nN, nwg, G, c;
    __host__ __device__ void init(int M, int N, int G_, int c_) { nM = M / BM; nN = N / BM; nwg = nM * nN; G = G_; c = c_; }
    __host__ __device__ bool next(int i, Unit& u) const {
        const long L = (long)i * G + c; if (L >= nwg) return false;
        int wgid = (int)L; { const int q = nwg / NXCD, r = nwg % NXCD, xcd = wgid % NXCD, off = wgid / NXCD; wgid = (xcd < r ? xcd * (q + 1) : r * (q + 1) + (xcd - r) * q) + off; }
        const int nig = WGM * nN, gid = wgid / nig, fm = gid * WGM, gsz = (nM - fm) < WGM ? (nM - fm) : WGM;
        u.pm = fm + ((wgid % nig) % gsz); u.pn = (wgid % nig) / gsz; return true;
    }
    __device__ __forceinline__ void a_ready(const Unit&) const {}
    __device__ __forceinline__ void done(const Unit&) const {}
};

typedef float f32x2c_t __attribute__((ext_vector_type(2))); typedef __bf16 bf16x2c_t __attribute__((ext_vector_type(2)));
__device__ __forceinline__ unsigned cvt_pk_bf16(float lo, float hi) { const f32x2c_t v = {lo, hi}; const bf16x2c_t b = __builtin_convertvector(v, bf16x2c_t); return __builtin_bit_cast(unsigned, b); }
typedef float f32x2 __attribute__((ext_vector_type(2)));
__device__ __forceinline__ f32x2 gelu_pk(f32x2 v) {
    const f32x2 av = __builtin_elementwise_abs(v), d = av * 0.2316418882f + 1.0f;
    f32x2 t; t.x = __builtin_amdgcn_rcpf(d.x); t.y = __builtin_amdgcn_rcpf(d.y);
    f32x2 q = t * 0.5307027145f + (-0.7265760135f); q = q * t + 0.7107068705f; q = q * t + (-0.142248368f); q = q * t + 0.127414796f; q = q * t;
    const f32x2 s = (v * v) * (-0.72134752044f);
    f32x2 e; e.x = __builtin_amdgcn_exp2f(s.x); e.y = __builtin_amdgcn_exp2f(s.y);
    const f32x2 m = v * (q * e), r = v - m;
    f32x2 o; o.x = v.x < 0.f ? m.x : r.x; o.y = v.y < 0.f ? m.y : r.y; return o;
}

template <int ACT  > struct EpiBf16 {
    static constexpr bool PERM = true, AFTER_DRAIN = false; static_assert(ACT == 0 || ACT == 1, "EpiBf16: ACT is 0 (none) or 1 (gelu_pk)");
    bf16_t* O; int ldc; const float* bias; int split_cols; size_t split_stride; float scale0;
    __device__ __forceinline__ void operator()(const f32x4 (&acc)[2][2][4][2], const Unit& u, int wr, int wc, int fr, int fq) const {
        const int row0 = u.pm * BM + wr * 64 + fr; int colt = u.pn * BM; bf16_t* base = O;
        float sc = 1.f; if (split_cols) { const int t = colt / split_cols; base += (size_t)t * split_stride; colt -= t * split_cols; if (t == 0) sc = scale0; }
        const int col0 = colt + wc * 32 + 8 * fq, bcol0 = u.pn * BM + wc * 32 + 8 * fq;
        f32x4 bv[2][2];
#pragma unroll
        for (int bj = 0; bj < 2; ++bj)
#pragma unroll
            for (int n = 0; n < 2; ++n) bv[bj][n] = bias ? *(const f32x4*)(bias + bcol0 + bj * HALF + 4 * n) : (f32x4){0.f, 0.f, 0.f, 0.f};
#pragma unroll
        for (int ai = 0; ai < 2; ++ai)
#pragma unroll
            for (int m = 0; m < 4; ++m) { bf16_t* rowp = base + (size_t)(row0 + ai * HALF + m * 16) * ldc + col0;
#pragma unroll
                for (int bj = 0; bj < 2; ++bj) { f32x4 v0 = acc[ai][bj][m][0] + bv[bj][0], v1 = acc[ai][bj][m][1] + bv[bj][1];
                    if (ACT == 1) { f32x2 a = gelu_pk((f32x2){v0[0], v0[1]}), b = gelu_pk((f32x2){v0[2], v0[3]}), c = gelu_pk((f32x2){v1[0], v1[1]}), d = gelu_pk((f32x2){v1[2], v1[3]});
                        v0 = (f32x4){a.x, a.y, b.x, b.y}; v1 = (f32x4){c.x, c.y, d.x, d.y}; }
                    v0 = v0 * sc; v1 = v1 * sc; u32x4 w; w.x = cvt_pk_bf16(v0[0], v0[1]); w.y = cvt_pk_bf16(v0[2], v0[3]); w.z = cvt_pk_bf16(v1[0], v1[1]); w.w = cvt_pk_bf16(v1[2], v1[3]);
                    *(u32x4*)(rowp + bj * HALF) = w; } }
    }
};
template <class Epi, class Sched, bool ALIGN_EPI = false, bool SP2 = false, bool FP8 = false>
__device__ __forceinline__ void gemm_phase(PG8_LAS unsigned char* lds, const Gemm g, const Sched& S, const Epi& E) {
    int tid_l = threadIdx.x; asm volatile("" : "+v"(tid_l));
    const int tid = tid_l, wid = __builtin_amdgcn_readfirstlane(tid >> 6), lane = tid & 63, wr = wid >> 2, wc = wid & 3, fr = lane & 15, fq = lane >> 4;
    const int K = g.K, nt = K / BK;
    unsigned voffA[2], voffB[2];
#pragma unroll
    for (int i = 0; i < 2; ++i) { int R, C; stage_rc(tid * 16 + i * 8192, R, C); const int Rb = Epi::PERM ? ((R & ~31) + perm32(R & 31)) : R;
        voffA[i] = (unsigned)(R * K + C) * 2u; voffB[i] = (unsigned)(Rb * K + C) * 2u; }
    const size_t kstep = (size_t)(BK * 2);
    const size_t hstep = (size_t)HALF * K * 2;
    const size_t tstep = 2 * hstep;
    const unsigned ldsw = (unsigned)wid * 1024u;
    const int aoff = lds_byte(wr * 64 + fr, fq * 8), boff = lds_byte(wc * 32 + fr, fq * 8);
#define PG8_SA(b, h) (((b) * 2 + (h)) * HTB)
#define PG8_SB(b, h) ((4 + (b) * 2 + (h)) * HTB)
#define PG8_STAGE(bufoff, gbase, voff) do { _Pragma("unroll") for (int _i = 0; _i < 2; ++_i) { unsigned vo_ = (voff)[_i]; if constexpr (FP8) asm volatile("" : "+v"(vo_)); \
        __builtin_amdgcn_global_load_lds((const unsigned*)((const char*)(gbase) + vo_), (PG8_LAS unsigned*)(lds + (bufoff) + ldsw + _i * 8192), 16, 0, 0); } } while (0)
#define PG8_LDA(dst, b, h) do { _Pragma("unroll") for (int m = 0; m < 4; ++m) _Pragma("unroll") for (int k = 0; k < 2; ++k) dst[m][k] = *(const PG8_LAS bf16x8*)(lds + PG8_SA(b, h) + aoff + m * 2048 + k * 1024); } while (0)
#define PG8_LDB(dst, b, h) do { _Pragma("unroll") for (int n = 0; n < 2; ++n) _Pragma("unroll") for (int k = 0; k < 2; ++k) dst[n][k] = *(const PG8_LAS bf16x8*)(lds + PG8_SB(b, h) + boff + n * 2048 + k * 1024); } while (0)
#define PG8_MMA(ai, bj, At, Bt) do { if constexpr (FP8) __builtin_amdgcn_sched_barrier(0); __builtin_amdgcn_s_setprio(1); _Pragma("unroll") for (int m = 0; m < 4; ++m) _Pragma("unroll") for (int n = 0; n < 2; ++n) { \
        if constexpr (FP8) { \
            const v4i_t b0_ = __builtin_bit_cast(v4i_t, Bt[n][0]), b1_ = __builtin_bit_cast(v4i_t, Bt[n][1]), a0_ = __builtin_bit_cast(v4i_t, At[m][0]), a1_ = __builtin_bit_cast(v4i_t, At[m][1]); \
            acc[ai][bj][m][n] = __builtin_amdgcn_mfma_scale_f32_16x16x128_f8f6f4(__builtin_shufflevector(b0_, b1_, 0, 1, 2, 3, 4, 5, 6, 7), __builtin_shufflevector(a0_, a1_, 0, 1, 2, 3, 4, 5, 6, 7), acc[ai][bj][m][n], 0, 0, 0, g.scale_b, 0, 0x7F7F7F7F); \
        } else { _Pragma("unroll") for (int k = 0; k < 2; ++k) acc[ai][bj][m][n] = __builtin_amdgcn_mfma_f32_16x16x32_bf16(Bt[n][k], At[m][k], acc[ai][bj][m][n], 0, 0, 0); } } \
        __builtin_amdgcn_s_setprio(0); if constexpr (FP8) __builtin_amdgcn_sched_barrier(0); } while (0)
#define PG8_WAIT_V(n) asm volatile("s_waitcnt vmcnt(" #n ")" ::: "memory")
#define PG8_WAIT_L(n) asm volatile("s_waitcnt lgkmcnt(" #n ")" ::: "memory")
#define PG8_BAR __builtin_amdgcn_s_barrier()
#define PG8_SCHED __builtin_amdgcn_sched_barrier(0)
    Unit cur, nxt; int ui = 0;
    if (!S.next(0, cur)) return;
    f32x4 acc[2][2][4][2];
#pragma unroll
    for (int a = 0; a < 2; ++a)
#pragma unroll
        for (int b = 0; b < 2; ++b)
#pragma unroll
            for (int m = 0; m < 4; ++m)
#pragma unroll
                for (int n = 0; n < 2; ++n) { acc[a][b][m][n] = (f32x4){0.f, 0.f, 0.f, 0.f}; if constexpr (FP8) asm volatile("" : "+v"(acc[a][b][m][n])); }
    bf16x8 At[4][2], B0[2][2], B1[2][2];
    typedef int v4i_t __attribute__((ext_vector_type(4))); typedef int v8i_t __attribute__((ext_vector_type(8)));
    const char* cA = (const char*)g.A + (size_t)cur.pm * tstep; const char* cB = (const char*)g.Bt + (size_t)cur.pn * tstep;
    S.a_ready(cur);
    if constexpr (SP2) {
        PG8_STAGE(PG8_SB(0, 0), cB, voffB); PG8_STAGE(PG8_SB(0, 1), cB + hstep, voffB); PG8_STAGE(PG8_SA(0, 0), cA, voffA); PG8_STAGE(PG8_SA(0, 1), cA + hstep, voffA);
        if (wr == 1) PG8_BAR;
        PG8_WAIT_V(2); PG8_BAR;
        PG8_STAGE(PG8_SB(1, 0), cB + kstep, voffB); PG8_STAGE(PG8_SA(1, 0), cA + kstep, voffA); PG8_STAGE(PG8_SB(1, 1), cB + hstep + kstep, voffB);
        PG8_WAIT_V(6); PG8_BAR;
    } else {
        PG8_STAGE(PG8_SB(0, 0), cB, voffB); PG8_STAGE(PG8_SA(0, 0), cA, voffA); PG8_STAGE(PG8_SB(0, 1), cB + hstep, voffB); PG8_STAGE(PG8_SA(0, 1), cA + hstep, voffA);
        if (wr == 1) PG8_BAR;
        PG8_WAIT_V(4); PG8_BAR;
        PG8_STAGE(PG8_SB(1, 0), cB + kstep, voffB); PG8_STAGE(PG8_SA(1, 0), cA + kstep, voffA); PG8_STAGE(PG8_SB(1, 1), cB + hstep + kstep, voffB);
        PG8_WAIT_V(6); PG8_BAR;
    }
    for (;;) {
        const bool has_next = S.next(ui + 1, nxt);
        const char* nA = has_next ? (const char*)g.A + (size_t)nxt.pm * tstep : cA; const char* nB = has_next ? (const char*)g.Bt + (size_t)nxt.pn * tstep : cB;
#pragma unroll 1
        for (int t = 0; t < nt; t += 2) {
            if constexpr (Epi::MID_T > 0) { if (t == Epi::MID_T) E.mid(acc, cur, wr, wc, fr, fq); }
            const bool last = (t == nt - 2);
            const char* a1 = cA + (size_t)(t + 1) * kstep;
            const char* a2 = last ? nA : cA + (size_t)(t + 2) * kstep; const char* b2 = last ? nB : cB + (size_t)(t + 2) * kstep;
            const char* a3 = a2 + kstep; const char* b3 = b2 + kstep;
            if (last && has_next) S.a_ready(nxt);
            if constexpr (SP2) {
            PG8_LDB(B0, 0, 0); PG8_LDB(B1, 0, 1); PG8_SCHED; PG8_LDA(At, 0, 0); PG8_STAGE(PG8_SA(1, 1), a1 + hstep, voffA);
            PG8_WAIT_V(8); PG8_WAIT_L(0); PG8_BAR; PG8_MMA(0, 0, At, B0); PG8_MMA(0, 1, At, B1); PG8_BAR; PG8_SCHED;
            PG8_LDA(At, 0, 1); PG8_STAGE(PG8_SB(0, 0), b2, voffB); PG8_STAGE(PG8_SB(0, 1), b2 + hstep, voffB); PG8_STAGE(PG8_SA(0, 0), a2, voffA);
            PG8_WAIT_V(8); PG8_WAIT_L(0); PG8_BAR; PG8_MMA(1, 0, At, B0); PG8_MMA(1, 1, At, B1); PG8_BAR; PG8_SCHED;
            PG8_LDB(B0, 1, 0); PG8_LDB(B1, 1, 1); PG8_SCHED; PG8_LDA(At, 1, 0); PG8_STAGE(PG8_SA(0, 1), a2 + hstep, voffA);
            PG8_WAIT_V(8); PG8_WAIT_L(0); PG8_BAR; PG8_MMA(0, 0, At, B0); PG8_MMA(0, 1, At, B1); PG8_BAR; PG8_SCHED;
            PG8_LDA(At, 1, 1); PG8_STAGE(PG8_SB(1, 0), b3, voffB); PG8_STAGE(PG8_SB(1, 1), b3 + hstep, voffB); PG8_STAGE(PG8_SA(1, 0), a3, voffA);
            PG8_WAIT_V(8); PG8_WAIT_L(0); PG8_BAR; PG8_MMA(1, 0, At, B0); PG8_MMA(1, 1, At, B1); PG8_BAR; PG8_SCHED;
            } else {
            PG8_LDB(B0, 0, 0); PG8_SCHED; PG8_LDA(At, 0, 0); PG8_STAGE(PG8_SA(1, 1), a1 + hstep, voffA);
            PG8_WAIT_L(8); PG8_BAR; PG8_WAIT_L(0); PG8_MMA(0, 0, At, B0); PG8_BAR; PG8_SCHED;
            PG8_LDB(B1, 0, 1); PG8_STAGE(PG8_SB(0, 0), b2, voffB);
            PG8_BAR; PG8_WAIT_L(0); PG8_MMA(0, 1, At, B1); PG8_BAR;
            PG8_LDA(At, 0, 1); PG8_STAGE(PG8_SA(0, 0), a2, voffA);
            PG8_BAR; PG8_WAIT_L(0); PG8_MMA(1, 0, At, B0); PG8_BAR; PG8_SCHED;
            PG8_STAGE(PG8_SB(0, 1), b2 + hstep, voffB);
            PG8_WAIT_V(6); PG8_BAR; PG8_MMA(1, 1, At, B1); PG8_BAR;
            PG8_LDB(B0, 1, 0); PG8_SCHED; PG8_LDA(At, 1, 0); PG8_STAGE(PG8_SA(0, 1), a2 + hstep, voffA);
            PG8_WAIT_L(8); PG8_BAR; PG8_WAIT_L(0); PG8_MMA(0, 0, At, B0); PG8_BAR; PG8_SCHED;
            PG8_LDB(B1, 1, 1); PG8_STAGE(PG8_SB(1, 0), b3, voffB);
            PG8_BAR; PG8_WAIT_L(0); PG8_MMA(0, 1, At, B1); PG8_BAR;
            PG8_LDA(At, 1, 1); PG8_STAGE(PG8_SA(1, 0), a3, voffA);
            PG8_BAR; PG8_WAIT_L(0); PG8_MMA(1, 0, At, B0); PG8_BAR; PG8_SCHED;
            PG8_STAGE(PG8_SB(1, 1), b3 + hstep, voffB);
            PG8_WAIT_V(6); PG8_BAR; PG8_MMA(1, 1, At, B1); PG8_BAR;
            }
        }
        if constexpr (ALIGN_EPI) { if (wr == 0) PG8_BAR; }
        if constexpr (!Epi::AFTER_DRAIN) { E(acc, cur, wr, wc, fr, fq); S.done(cur); }
        if (!has_next) break;
#pragma unroll
        for (int a = 0; a < 2; ++a)
#pragma unroll
            for (int b = 0; b < 2; ++b)
#pragma unroll
                for (int m = 0; m < 4; ++m)
#pragma unroll
                    for (int n = 0; n < 2; ++n) { acc[a][b][m][n] = (f32x4){0.f, 0.f, 0.f, 0.f}; if constexpr (FP8) asm volatile("" : "+v"(acc[a][b][m][n])); }
        cur = nxt; cA = nA; cB = nB; ++ui;
        if constexpr (ALIGN_EPI) { if (wr == 1) PG8_BAR; }
    }
    PG8_WAIT_V(0);
    if constexpr (!ALIGN_EPI) { if (wr == 0) PG8_BAR; }
    PG8_BAR;
    if constexpr (Epi::AFTER_DRAIN) { E.fused(acc, cur, wr, wc, fr, fq, lds, wid, lane); S.done(cur); }
#undef PG8_SA
#undef PG8_SB
#undef PG8_STAGE
#undef PG8_LDA
#undef PG8_LDB
#undef PG8_MMA
#undef PG8_WAIT_V
#undef PG8_WAIT_L
#undef PG8_BAR
#undef PG8_SCHED
}
}

constexpr int DM = 1024, TP = 8 * 2048, TSM = 8 * 8192, TT = TP + TSM;
constexpr int NIN = 5120, DFF = 4096, ZC = 3072, GC = 2048;
constexpr float RMS_EPS = 1e-6f, LOG2E = 1.4426950408889634f;
constexpr size_t MiB = 1u << 20;
constexpr size_t WS_WIN = 1 * MiB, WS_WA = 11 * MiB, WS_WB = 12 * MiB, WS_WOUT = 13 * MiB, WS_WUP = 15 * MiB, WS_WDN = 23 * MiB;
constexpr size_t WS_SSQ1 = 32 * MiB, WS_SSQ2 = 37 * MiB;
constexpr size_t WS_XN = 48 * MiB;
constexpr size_t WS_OA = WS_XN, WS_OB = WS_XN + 80 * MiB, WS_X1B = WS_XN;
constexpr size_t WS_Z = 208 * MiB;
constexpr size_t WS_MRG = WS_Z, WS_H = WS_Z;
constexpr size_t WS_G = 688 * MiB;
constexpr size_t WS_END = 1008 * MiB;
constexpr size_t DO_OBG = 0, DO_LSE = 120 * MiB;

constexpr int RING_BYTES = 131072, LDS_BYTES = 147456;

#define LAS __attribute__((address_space(3)))
typedef unsigned short bf16;
typedef unsigned v4u __attribute__((ext_vector_type(4)));
typedef unsigned v2u __attribute__((ext_vector_type(2)));
typedef float f32x4 __attribute__((ext_vector_type(4)));
typedef short bf16x8 __attribute__((ext_vector_type(8)));
typedef short s16x4 __attribute__((ext_vector_type(4)));

__device__ __forceinline__ unsigned cvtpk(float lo, float hi) { return pg8::cvt_pk_bf16(lo, hi); }
__device__ __forceinline__ float bf_lo(unsigned u) { return __builtin_bit_cast(float, u << 16); }
__device__ __forceinline__ float bf_hi(unsigned u) { return __builtin_bit_cast(float, u & 0xffff0000u); }

namespace pg8 {
typedef unsigned u32x2g __attribute__((ext_vector_type(2)));
struct EpiIn {
    static constexpr bool PERM = true, AFTER_DRAIN = false; static constexpr int MID_T = 0;
    bf16_t* Z; bf16_t* Gt; const float* bgate;
    __device__ __forceinline__ void operator()(const f32x4 (&acc)[2][2][4][2], const Unit& u, int wr, int wc, int fr, int fq) const {
        { int l_ = (int)(threadIdx.x & 63u); asm volatile("" : "+v"(l_)); fr = l_ & 15; fq = l_ >> 4; }
        const int row0 = u.pm * BM + wr * 64 + fr;
        const bool isg = u.pn >= 12;
        if (isg) {
            const int col0 = (u.pn - 12) * BM + wc * 32 + 8 * fq;
            f32x4 bv[2][2];
#pragma unroll
            for (int bj = 0; bj < 2; ++bj)
#pragma unroll
                for (int n = 0; n < 2; ++n) bv[bj][n] = *(const f32x4*)(bgate + col0 + bj * HALF + 4 * n);
#pragma unroll
            for (int ai = 0; ai < 2; ++ai)
#pragma unroll
                for (int m = 0; m < 4; ++m) { unsigned char* rowp = (unsigned char*)Gt + (size_t)(row0 + ai * HALF + m * 16) * GC + col0;
#pragma unroll
                    for (int bj = 0; bj < 2; ++bj) { f32x4 v0 = acc[ai][bj][m][0] * 0.03125f + bv[bj][0], v1 = acc[ai][bj][m][1] * 0.03125f + bv[bj][1];
                        unsigned q[8];
#pragma unroll
                        for (int e = 0; e < 4; ++e) { q[e] = (unsigned)__builtin_rintf(255.f * __builtin_amdgcn_rcpf(1.f + __builtin_amdgcn_exp2f(-LOG2E * v0[e]))); q[4 + e] = (unsigned)__builtin_rintf(255.f * __builtin_amdgcn_rcpf(1.f + __builtin_amdgcn_exp2f(-LOG2E * v1[e]))); }
                        u32x2g w; w.x = q[0] | (q[1] << 8) | (q[2] << 16) | (q[3] << 24); w.y = q[4] | (q[5] << 8) | (q[6] << 16) | (q[7] << 24);
                        *(u32x2g*)(rowp + bj * HALF) = w; } }
        } else {
            const int seqL = (u.pm * BM < TP) ? 2048 : 8192, lsh = (u.pm * BM < TP) ? 11 : 13;
#pragma unroll
            for (int bj = 0; bj < 2; ++bj) {
                const int hslot = (u.pn * BM + bj * HALF + wc * 32) >> 6; const int within = (wc & 1) * 32 + 8 * fq;
                int dsh = 0; if (hslot >= 12) { const int gi = ((hslot - 12) % 12) >> 2; dsh = gi == 0 ? 0 : (gi == 1 ? 2 : 4); }
                bf16_t* hb = Z + (size_t)hslot * TT * 64 + within;
#pragma unroll
                for (int ai = 0; ai < 2; ++ai)
#pragma unroll
                    for (int m = 0; m < 4; ++m) { const int r = row0 + ai * HALF + m * 16; const int rr = r - TP * (r >= TP ? 1 : 0); const int seq0 = r - (rr & (seqL - 1)); const int t = rr & (seqL - 1);
                        const int pos = seq0 + ((t & ((1 << dsh) - 1)) << (lsh - dsh)) + (t >> dsh);
                        const f32x4 v0 = acc[ai][bj][m][0] * 0.03125f, v1 = acc[ai][bj][m][1] * 0.03125f;
                        u32x4 w; w.x = cvt_pk_bf16(v0[0], v0[1]); w.y = cvt_pk_bf16(v0[2], v0[3]); w.z = cvt_pk_bf16(v1[0], v1[1]); w.w = cvt_pk_bf16(v1[2], v1[3]);
                        *(u32x4*)(hb + (size_t)pos * 64) = w; } }
        }
    }
};
struct EpiGate2 {
    static constexpr bool PERM = true, AFTER_DRAIN = false; static constexpr int MID_T = 8;
    bf16_t* O; const unsigned char* Gt;
    __device__ __forceinline__ void mid(f32x4 (&acc)[2][2][4][2], const Unit& u, int wr, int wc, int fr, int fq) const {
        asm volatile("" : "+v"(fr), "+v"(fq));
        const int row0 = u.pm * BM + wr * 64 + fr, col0 = u.pn * BM + wc * 32 + 8 * fq;
#pragma unroll
        for (int ai = 0; ai < 2; ++ai)
#pragma unroll
            for (int m = 0; m < 4; ++m) { const size_t r = (size_t)(row0 + ai * HALF + m * 16);
#pragma unroll
                for (int bj = 0; bj < 2; ++bj) {
                    const u32x2g a = *(const u32x2g*)(Gt + r * GC + col0 + bj * HALF), b = *(const u32x2g*)(Gt + r * GC + DM + col0 + bj * HALF);
                    f32x4 v0 = acc[ai][bj][m][0], v1 = acc[ai][bj][m][1];
#define G2R(aw, bw, sh) ((float)(((aw) >> (sh)) & 0xffu) * __builtin_amdgcn_rcpf(fmaxf((float)(((bw) >> (sh)) & 0xffu), 0.5f)))
                    v0[0] *= G2R(a.x, b.x, 0); v0[1] *= G2R(a.x, b.x, 8); v0[2] *= G2R(a.x, b.x, 16); v0[3] *= G2R(a.x, b.x, 24);
                    v1[0] *= G2R(a.y, b.y, 0); v1[1] *= G2R(a.y, b.y, 8); v1[2] *= G2R(a.y, b.y, 16); v1[3] *= G2R(a.y, b.y, 24);
#undef G2R
                    acc[ai][bj][m][0] = v0; acc[ai][bj][m][1] = v1; }
                asm volatile("" ::: "memory"); }
    }
    __device__ __forceinline__ void operator()(const f32x4 (&acc)[2][2][4][2], const Unit& u, int wr, int wc, int fr, int fq) const {
        asm volatile("" : "+v"(fr), "+v"(fq));
        const int row0 = u.pm * BM + wr * 64 + fr, col0 = u.pn * BM + wc * 32 + 8 * fq;
#pragma unroll
        for (int ai = 0; ai < 2; ++ai)
#pragma unroll
            for (int m = 0; m < 4; ++m) { const size_t r = (size_t)(row0 + ai * HALF + m * 16);
#pragma unroll
                for (int bj = 0; bj < 2; ++bj) {
                    const u32x2g b = *(const u32x2g*)(Gt + r * GC + DM + col0 + bj * HALF);
                    f32x4 v0 = acc[ai][bj][m][0], v1 = acc[ai][bj][m][1];
#define G2B(bw, sh) fmaxf((float)(((bw) >> (sh)) & 0xffu), 0.5f)
                    v0[0] *= G2B(b.x, 0); v0[1] *= G2B(b.x, 8); v0[2] *= G2B(b.x, 16); v0[3] *= G2B(b.x, 24);
                    v1[0] *= G2B(b.y, 0); v1[1] *= G2B(b.y, 8); v1[2] *= G2B(b.y, 16); v1[3] *= G2B(b.y, 24);
#undef G2B
                    u32x4 w; w.x = cvt_pk_bf16(v0[0], v0[1]); w.y = cvt_pk_bf16(v0[2], v0[3]); w.z = cvt_pk_bf16(v1[0], v1[1]); w.w = cvt_pk_bf16(v1[2], v1[3]);
                    *(u32x4*)(O + r * DM + col0 + bj * HALF) = w; }
                asm volatile("" ::: "memory"); }
    }
};
template <bool WB> struct EpiRes {
    static constexpr bool PERM = true, AFTER_DRAIN = false; static constexpr int MID_T = 0;
    const float* xp; const float* xs;
    float* out; bf16_t* xb; float* ssq;
    __device__ __forceinline__ void operator()(const f32x4 (&acc)[2][2][4][2], const Unit& u, int wr, int wc, int fr, int fq) const {
        const int row0 = u.pm * BM + wr * 64 + fr, col0 = u.pn * BM + wc * 32 + 8 * fq;
        const float* xbase = (u.pm * BM < TP) ? xp : (xs - (size_t)TP * DM);
#pragma unroll
        for (int ai = 0; ai < 2; ++ai) {
            f32x4 xv[4][2][2];
#pragma unroll
            for (int m = 0; m < 4; ++m)
#pragma unroll
                for (int bj = 0; bj < 2; ++bj) { const size_t off = (size_t)(row0 + ai * HALF + m * 16) * DM + col0 + bj * HALF; xv[m][bj][0] = *(const f32x4*)(xbase + off); xv[m][bj][1] = *(const f32x4*)(xbase + off + 4); }
#pragma unroll
            for (int m = 0; m < 4; ++m) { const size_t r = (size_t)(row0 + ai * HALF + m * 16); float ss = 0.f;
#pragma unroll
                for (int bj = 0; bj < 2; ++bj) { const size_t off = r * DM + col0 + bj * HALF;
                    const f32x4 v0 = acc[ai][bj][m][0] + xv[m][bj][0], v1 = acc[ai][bj][m][1] + xv[m][bj][1];
                    if (!WB) { *(f32x4*)(out + off) = v0; *(f32x4*)(out + off + 4) = v1; }
                    if (WB) { u32x4 w; w.x = cvt_pk_bf16(v0[0], v0[1]); w.y = cvt_pk_bf16(v0[2], v0[3]); w.z = cvt_pk_bf16(v1[0], v1[1]); w.w = cvt_pk_bf16(v1[2], v1[3]); *(u32x4*)(xb + off) = w; }
                    ss += (v0[0] * v0[0] + v0[1] * v0[1]) + (v0[2] * v0[2] + v0[3] * v0[3]) + (v1[0] * v1[0] + v1[1] * v1[1]) + (v1[2] * v1[2] + v1[3] * v1[3]); }
                ss += __shfl_xor(ss, 16); ss += __shfl_xor(ss, 32);
                if (fq == 0) ssq[r * 16 + u.pn * 4 + wc] = ss; }
            asm volatile("" ::: "memory"); }
    }
};
struct EpiUp {
    static constexpr bool PERM = true, AFTER_DRAIN = false; static constexpr int MID_T = 0;
    bf16_t* O; const float* ssq;
    __device__ __forceinline__ void operator()(const f32x4 (&acc)[2][2][4][2], const Unit& u, int wr, int wc, int fr, int fq) const {
        const int row0 = u.pm * BM + wr * 64 + fr, col0 = u.pn * BM + wc * 32 + 8 * fq;
#pragma unroll
        for (int ai = 0; ai < 2; ++ai)
#pragma unroll
            for (int m = 0; m < 4; ++m) { const size_t r = (size_t)(row0 + ai * HALF + m * 16);
                const f32x4 pq = *(const f32x4*)(ssq + r * 16 + 4 * fq);
                float ss = (pq[0] + pq[1]) + (pq[2] + pq[3]); ss += __shfl_xor(ss, 16); ss += __shfl_xor(ss, 32);
                const float rs = __builtin_amdgcn_rsqf(ss * (1.f / DM) + RMS_EPS);
#pragma unroll
                for (int bj = 0; bj < 2; ++bj) { f32x4 v0 = acc[ai][bj][m][0] * rs, v1 = acc[ai][bj][m][1] * rs;
#pragma unroll
                    for (int e = 0; e < 4; ++e) { const float a = fmaxf(v0[e], 0.f), b = fmaxf(v1[e], 0.f); v0[e] = a * a; v1[e] = b * b; }
                    u32x4 w; w.x = cvt_pk_bf16(v0[0], v0[1]); w.y = cvt_pk_bf16(v0[2], v0[3]); w.z = cvt_pk_bf16(v1[0], v1[1]); w.w = cvt_pk_bf16(v1[2], v1[3]);
                    *(u32x4*)(O + r * DFF + col0 + bj * HALF) = w; } }
    }
};
struct EpiFinal {
    static constexpr bool PERM = true, AFTER_DRAIN = false; static constexpr int MID_T = 0;
    float* out; const bf16_t* xb; float* ssq; unsigned* cnt; const float* gfin;
    __device__ __forceinline__ void operator()(f32x4 (&acc)[2][2][4][2], const Unit& u, int wr, int wc, int fr, int fq) const {
        const int row0 = u.pm * BM + wr * 64 + fr, col0 = u.pn * BM + wc * 32 + 8 * fq;
#pragma unroll
        for (int ai = 0; ai < 2; ++ai) {
            u32x4 xv[4][2];
#pragma unroll
            for (int m = 0; m < 4; ++m)
#pragma unroll
                for (int bj = 0; bj < 2; ++bj) { const size_t off = (size_t)(row0 + ai * HALF + m * 16) * DM + col0 + bj * HALF; xv[m][bj] = *(const u32x4*)(xb + off); }
#pragma unroll
            for (int m = 0; m < 4; ++m) { const size_t r = (size_t)(row0 + ai * HALF + m * 16); float ss = 0.f;
#pragma unroll
                for (int bj = 0; bj < 2; ++bj) { const u32x4 xw = xv[m][bj];
                    const f32x4 x0 = {bf_lo(xw.x), bf_hi(xw.x), bf_lo(xw.y), bf_hi(xw.y)}, x1 = {bf_lo(xw.z), bf_hi(xw.z), bf_lo(xw.w), bf_hi(xw.w)};
                    const f32x4 v0 = acc[ai][bj][m][0] + x0, v1 = acc[ai][bj][m][1] + x1; acc[ai][bj][m][0] = v0; acc[ai][bj][m][1] = v1;
                    ss += (v0[0] * v0[0] + v0[1] * v0[1]) + (v0[2] * v0[2] + v0[3] * v0[3]) + (v1[0] * v1[0] + v1[1] * v1[1]) + (v1[2] * v1[2] + v1[3] * v1[3]); }
                ss += __shfl_xor(ss, 16); ss += __shfl_xor(ss, 32);
                if (fq == 0) __hip_atomic_store(ssq + r * 16 + u.pn * 4 + wc, ss, __ATOMIC_RELAXED, __HIP_MEMORY_SCOPE_AGENT); }
            asm volatile("" ::: "memory"); }
        asm volatile("s_waitcnt vmcnt(0)" ::: "memory");
        unsigned* pc = cnt + 64 * u.pm;
        if (fr == 0 && fq == 0) __hip_atomic_fetch_add(pc, 1u, __ATOMIC_RELAXED, __HIP_MEMORY_SCOPE_AGENT);
        unsigned seen;
        { unsigned spins = 0;
          while ((seen = (unsigned)__builtin_amdgcn_readfirstlane(__hip_atomic_load(pc, __ATOMIC_RELAXED, __HIP_MEMORY_SCOPE_AGENT))) < 32u) { __builtin_amdgcn_s_sleep(2); if (++spins > (1u << 22)) break; } }
        const unsigned dep0 = seen >> 31;
        f32x4 gv[2][2];
#pragma unroll
        for (int bj = 0; bj < 2; ++bj)
#pragma unroll
            for (int n = 0; n < 2; ++n) gv[bj][n] = *(const f32x4*)(gfin + col0 + bj * HALF + 4 * n);
#pragma unroll
        for (int ai = 0; ai < 2; ++ai)
#pragma unroll
            for (int m = 0; m < 4; ++m) { const size_t r = (size_t)(row0 + ai * HALF + m * 16);
                const float* pp = ssq + r * 16 + 4 * fq + dep0;
                const float q0 = __hip_atomic_load(pp + 0, __ATOMIC_RELAXED, __HIP_MEMORY_SCOPE_AGENT), q1 = __hip_atomic_load(pp + 1, __ATOMIC_RELAXED, __HIP_MEMORY_SCOPE_AGENT),
                            q2 = __hip_atomic_load(pp + 2, __ATOMIC_RELAXED, __HIP_MEMORY_SCOPE_AGENT), q3 = __hip_atomic_load(pp + 3, __ATOMIC_RELAXED, __HIP_MEMORY_SCOPE_AGENT);
                float tot = (q0 + q1) + (q2 + q3); tot += __shfl_xor(tot, 16); tot += __shfl_xor(tot, 32);
                const float rs = __builtin_amdgcn_rsqf(tot * (1.f / DM) + RMS_EPS);
#pragma unroll
                for (int bj = 0; bj < 2; ++bj) { const size_t off = r * DM + col0 + bj * HALF;
                    *(f32x4*)(out + off) = acc[ai][bj][m][0] * rs * gv[bj][0]; *(f32x4*)(out + off + 4) = acc[ai][bj][m][1] * rs * gv[bj][1]; } }
    }
};
}

__device__ __forceinline__ float wave_sum(float v) {
#pragma unroll
    for (int o = 1; o < 64; o <<= 1) v += __shfl_xor(v, o);
    return v;
}
__device__ __forceinline__ unsigned pk4_fp8(float a, float b, float c, float d) { int r = __builtin_amdgcn_cvt_pk_fp8_f32(a, b, 0, false); r = __builtin_amdgcn_cvt_pk_fp8_f32(c, d, r, true); return (unsigned)r; }
__device__ __forceinline__ void p0_transpose_item_fp8(const float* W, int K, int N, unsigned char* WT, LAS float* scr, int item, int lane, float sscale) {
    const int nblk = N / 32, kb = item / nblk, nb = item % nblk, k0 = 64 * kb, n0 = 32 * nb;
#pragma unroll 8
    for (int i = 0; i < 32; ++i) { const int kk = 2 * i + (lane >> 5); scr[kk * 33 + (lane & 31)] = W[(size_t)(k0 + kk) * N + n0 + (lane & 31)] * sscale; }
    asm volatile("s_waitcnt lgkmcnt(0)" ::: "memory");
    const int c = lane & 7;
#pragma unroll
    for (int j = 0; j < 4; ++j) { const int n = (lane >> 3) + 8 * j; const LAS float* s = scr + (8 * c) * 33 + n;
        v2u o; o.x = pk4_fp8(s[0 * 33], s[1 * 33], s[2 * 33], s[3 * 33]); o.y = pk4_fp8(s[4 * 33], s[5 * 33], s[6 * 33], s[7 * 33]);
        *(v2u*)(WT + (size_t)(n0 + n) * K + k0 + 8 * c) = o; }
    asm volatile("s_waitcnt lgkmcnt(0)" ::: "memory");
}
__device__ __forceinline__ void p0_transpose_item(const float* W, int K, int N, bf16* WT, const float* kscale, LAS float* scr, int item, int lane, float sscale = 1.f, int ld = 0, int koff = 0) {
    if (ld == 0) ld = K;
    const int nblk = N / 32, kb = item / nblk, nb = item % nblk, k0 = 64 * kb, n0 = 32 * nb;
#pragma unroll 8
    for (int i = 0; i < 32; ++i) { const int kk = 2 * i + (lane >> 5); float v = W[(size_t)(k0 + kk) * N + n0 + (lane & 31)] * sscale; if (kscale) v *= kscale[k0 + kk]; scr[kk * 33 + (lane & 31)] = v; }
    asm volatile("s_waitcnt lgkmcnt(0)" ::: "memory");
    const int c = lane & 7;
#pragma unroll
    for (int j = 0; j < 4; ++j) { const int n = (lane >> 3) + 8 * j; const LAS float* s = scr + (8 * c) * 33 + n;
        v4u o; o.x = cvtpk(s[0 * 33], s[1 * 33]); o.y = cvtpk(s[2 * 33], s[3 * 33]); o.z = cvtpk(s[4 * 33], s[5 * 33]); o.w = cvtpk(s[6 * 33], s[7 * 33]);
        *(v4u*)(WT + (size_t)(n0 + n) * ld + koff + k0 + 8 * c) = o; }
    asm volatile("s_waitcnt lgkmcnt(0)" ::: "memory");
}

namespace att {
constexpr int KRS = 144, VRS = 160, NKS_MAX = 384, TBL = 640;
constexpr int L_K = 0, L_V = NKS_MAX * KRS, L_T = L_V + NKS_MAX * VRS, L_PM = L_T + 4 * TBL * 4, L_END = L_PM + 2 * NKS_MAX * 4;
static_assert(L_END <= RING_BYTES, "attention LDS");
constexpr int NITEM_A = (TT / 128) * 2, NITEM_B = (TT / 256) * 12;

__device__ __forceinline__ int rel_bucket(int rel) {
    const int n = rel < 0 ? -rel : rel; int b;
    if (n < 8) b = n; else if (n < 15) b = 8; else if (n < 27) b = 9; else if (n < 50) b = 10; else if (n < 91) b = 11; else if (n < 166) b = 12; else if (n < 305) b = 13; else if (n < 559) b = 14; else b = 15;
    return b + (rel > 0 ? 16 : 0);
}
__device__ __forceinline__ s16x4 vtr(LAS const unsigned char* p) { return __builtin_bit_cast(s16x4, __builtin_amdgcn_ds_read_tr16_b64_v4i16((LAS s16x4*)p)); }

template <int NCH, bool IS_A>
__device__ __forceinline__ void attn_task(LAS const unsigned char* ldsK, LAS const unsigned char* ldsV, LAS const float* tbl, LAS const float* pm, int kstart,
                                          bf16x8& qf0, bf16x8& qf1, const bf16* nq, bool has_nq, int qrel, float sink2, bf16* orow, float* lsep, int qi, int g, int abl = 0) {
    constexpr int NT = 2 * NCH;
    f32x4 s[NT];
    LAS const unsigned char* kp = ldsK + (kstart + qi) * KRS + g * 16;
    LAS const float* pmb = pm + (kstart + 4 * g);
    {
        bf16x8 ka[2][2][2]; f32x4 pz[2][2];
#pragma unroll
        for (int j = 0; j < 2; ++j) { ka[0][j][0] = *(LAS const bf16x8*)(kp + j * 16 * KRS); ka[0][j][1] = *(LAS const bf16x8*)(kp + j * 16 * KRS + 64); pz[0][j] = *(LAS const f32x4*)(pmb + 16 * j); }
#pragma unroll
        for (int tp = 0; tp < NT / 2; ++tp) { const int b = tp & 1;
            if (tp + 1 < NT / 2) {
#pragma unroll
                for (int j = 0; j < 2; ++j) { const int t = 2 * (tp + 1) + j; ka[b ^ 1][j][0] = *(LAS const bf16x8*)(kp + t * 16 * KRS); ka[b ^ 1][j][1] = *(LAS const bf16x8*)(kp + t * 16 * KRS + 64); pz[b ^ 1][j] = *(LAS const f32x4*)(pmb + 16 * t); } }
            __builtin_amdgcn_sched_barrier(0);
#pragma unroll
            for (int j = 0; j < 2; ++j) { f32x4 z = __builtin_amdgcn_mfma_f32_16x16x32_bf16(ka[b][j][0], qf0, pz[b][j], 0, 0, 0); s[2 * tp + j] = __builtin_amdgcn_mfma_f32_16x16x32_bf16(ka[b][j][1], qf1, z, 0, 0, 0); }
            __builtin_amdgcn_sched_barrier(0);
        }
    }
    if (has_nq) { qf0 = *(const bf16x8*)(nq + g * 8); qf1 = *(const bf16x8*)(nq + 32 + g * 8); }
    constexpr float C = 0.125f * LOG2E; const float NEG = -__builtin_inff();
    LAS const float* tb = tbl + (kstart + 4 * g - qrel + TBL / 2);
    float m = NEG;
    {
        float tv[2][8];
#pragma unroll
        for (int i = 0; i < 8; ++i) tv[0][i] = tb[16 * (i >> 2) + (i & 3)];
#pragma unroll
        for (int tp = 0; tp < NT / 2; ++tp) { const int b = tp & 1;
            if (tp + 1 < NT / 2) {
#pragma unroll
                for (int i = 0; i < 8; ++i) tv[b ^ 1][i] = tb[16 * (2 * (tp + 1) + (i >> 2)) + (i & 3)]; }
            __builtin_amdgcn_sched_barrier(0);
#pragma unroll
            for (int i = 0; i < 8; ++i) { const int t = 2 * tp + (i >> 2), r = i & 3; const float v = s[t][r] * C + tv[b][i]; s[t][r] = v; m = fmaxf(m, v); }
            __builtin_amdgcn_sched_barrier(0);
        }
    }
    m = fmaxf(m, __shfl_xor(m, 16)); m = fmaxf(m, __shfl_xor(m, 32));
    if (IS_A) m = fmaxf(m, sink2);
    float sum = 0.f;
#pragma unroll
    for (int t = 0; t < NT; ++t)
#pragma unroll
        for (int r = 0; r < 4; ++r) { const float p = __builtin_amdgcn_exp2f(s[t][r] - m); s[t][r] = p; sum += p; }
    sum += __shfl_xor(sum, 16); sum += __shfl_xor(sum, 32);
    if (IS_A) sum += __builtin_amdgcn_exp2f(sink2 - m);
    const float inv = __builtin_amdgcn_rcpf(sum);
    f32x4 o[4];
#pragma unroll
    for (int d = 0; d < 4; ++d) o[d] = (f32x4){0.f, 0.f, 0.f, 0.f};
    LAS const unsigned char* vp = ldsV + (kstart + 4 * g + (qi >> 2)) * VRS + (qi & 3) * 8;
    {
        s16x4 vl[2][4], vh[2][4];
#pragma unroll
        for (int d = 0; d < 4; ++d) { vl[0][d] = vtr(vp + d * 32); vh[0][d] = vtr(vp + 16 * VRS + d * 32); }
#pragma unroll
        for (int c = 0; c < NCH; ++c) { const int b = c & 1;
            if (c + 1 < NCH) {
#pragma unroll
                for (int d = 0; d < 4; ++d) { vl[b ^ 1][d] = vtr(vp + (32 * (c + 1)) * VRS + d * 32); vh[b ^ 1][d] = vtr(vp + (32 * (c + 1) + 16) * VRS + d * 32); } }
            v4u pw; pw.x = cvtpk(s[2 * c][0], s[2 * c][1]); pw.y = cvtpk(s[2 * c][2], s[2 * c][3]); pw.z = cvtpk(s[2 * c + 1][0], s[2 * c + 1][1]); pw.w = cvtpk(s[2 * c + 1][2], s[2 * c + 1][3]);
            const bf16x8 pb = __builtin_bit_cast(bf16x8, pw);
            __builtin_amdgcn_sched_barrier(0);
#pragma unroll
            for (int d = 0; d < 4; ++d) { const s16x4 lo = vl[b][d], hi = vh[b][d];
                const bf16x8 va = (bf16x8){lo[0], lo[1], lo[2], lo[3], hi[0], hi[1], hi[2], hi[3]};
                o[d] = __builtin_amdgcn_mfma_f32_16x16x32_bf16(va, pb, o[d], 0, 0, 0); }
            __builtin_amdgcn_sched_barrier(0);
        }
    }
#pragma unroll
    for (int d = 0; d < 4; ++d) { v2u w; w.x = cvtpk(o[d][0] * inv, o[d][1] * inv); w.y = cvtpk(o[d][2] * inv, o[d][3] * inv); if (!(abl & 1) || w.x == 0x12345678u) *(v2u*)(orow + 16 * d + 4 * g) = w; }
    if (!IS_A) { if (g == 0 && !(abl & 1)) *lsep = m + __builtin_log2f(sum); }
}

struct Item { int isA, seq0, j0, Lr, Lre, dil, res, hs, pair;
    __device__ __forceinline__ int n() const { return isA ? 128 : 64; }
    __device__ __forceinline__ int nh() const { return isA ? 4 : 1; }
    __device__ __forceinline__ int kslot() const { return isA ? 8 + hs : 24 + hs; }
    __device__ __forceinline__ int vslot() const { return isA ? 10 + hs : 36 + hs; }
    __device__ __forceinline__ int qslot0() const { return isA ? hs * 4 : 12 + hs; }
    __device__ __forceinline__ int bcol0() const { return isA ? hs * 4 : 8 + hs; }
    __device__ __forceinline__ int key() const { return isA ? hs : 2 + hs; }
};
__device__ __forceinline__ Item decode(int k, int na0, int nA, int nb0) {
    Item I; int tok0;
    if (k < nA) { const int ia = na0 + k; I.isA = 1; I.hs = ia / (TT / 128); tok0 = (ia % (TT / 128)) * 128; I.dil = 1; }
    else { const int ib = nb0 + (k - nA); I.hs = ib / (TT / 256); I.isA = 0; const int gi = I.hs >> 2; tok0 = (ib % (TT / 256)) * 256; I.dil = gi == 0 ? 1 : (gi == 1 ? 4 : 16); }
    int L;
    if (tok0 < TP) { L = 2048; I.seq0 = (tok0 / 2048) * 2048; } else { L = 8192; I.seq0 = TP + ((tok0 - TP) / 8192) * 8192; }
    I.res = 0; I.j0 = tok0 - I.seq0; I.Lr = L; I.Lre = L; I.pair = 0;
    if (!I.isA) { I.Lr = L / I.dil; const int blk = (tok0 - I.seq0) / 256;
        if (I.Lr >= 256) { const int bpr = I.Lr / 256; I.res = blk / bpr; I.j0 = (blk % bpr) * 256; I.Lre = I.Lr; }
        else { I.res = 2 * blk; I.j0 = 0; I.Lre = 2 * I.Lr; I.pair = 1; } }
    return I;
}

__device__ __forceinline__ void attn_phase(LAS unsigned char* lds, const bf16* Z, const float* rel_bias, const float* sink, bf16* OA, bf16* OBG, float* LSE, int abl = 0) {
    int tid_l = threadIdx.x; asm volatile("" : "+v"(tid_l));
    const int tid = tid_l, lane = tid & 63, wave = __builtin_amdgcn_readfirstlane(tid >> 6), qi = lane & 15, g = lane >> 4;
    LAS unsigned char* ldsK = lds + L_K; LAS unsigned char* ldsV = lds + L_V; LAS float* tbl = (LAS float*)(lds + L_T); LAS float* pmt = (LAS float*)(lds + L_PM);
    const int G = gridDim.x, bx = blockIdx.x;
    const int na0 = (int)((long)bx * NITEM_A / G), nA = (int)((long)(bx + 1) * NITEM_A / G) - na0;
    const int nb0 = (int)((long)bx * NITEM_B / G), nB = (int)((long)(bx + 1) * NITEM_B / G) - nb0;
    const int nloc = nA + nB, r0 = tid >> 3, ch = tid & 7;
    v4u pk[6], pv[6];
#define ATT_ISSUE(I) do { _Pragma("unroll") for (int i_ = 0; i_ < 6; ++i_) { const int row_ = r0 + 64 * i_, kpos_ = (I).j0 - (I).n() + row_; pk[i_] = (v4u){0u, 0u, 0u, 0u}; pv[i_] = (v4u){0u, 0u, 0u, 0u}; \
        if ((unsigned)kpos_ < (unsigned)(I).Lre && !(abl & 2)) { const size_t ro_ = (size_t)((I).seq0 + (I).res * (I).Lr + kpos_) * 64 + ch * 8; pk[i_] = *(const v4u*)(Z + (size_t)(I).kslot() * TT * 64 + ro_); pv[i_] = *(const v4u*)(Z + (size_t)(I).vslot() * TT * 64 + ro_); } } } while (0)
    if (nloc <= 0) return;
    Item cur = decode(0, na0, nA, nb0), nxt = cur;
#define ATT_QT(I, i_) ((I).isA ? ((wave * 4 + (i_)) & 7) : (wave * 2 + (i_)))
#define ATT_QPTR(I, i_) (Z + ((size_t)((I).qslot0() + ((I).isA ? ((wave * 4 + (i_)) >> 3) : 0)) * TT + (I).seq0 + (I).res * (I).Lr + (I).j0 + 16 * ATT_QT(I, i_) + qi) * 64)
    bf16x8 q0, q1;
    { const bf16* qp = ATT_QPTR(cur, 0); q0 = *(const bf16x8*)(qp + g * 8); q1 = *(const bf16x8*)(qp + 32 + g * 8); }
    asm volatile("" ::: "memory");
    ATT_ISSUE(cur);
    int tkey = -1;
    for (int k = 0; k < nloc; ++k) {
        __syncthreads();
#pragma unroll
        for (int i = 0; i < 6; ++i) { const int row = r0 + 64 * i; *(LAS v4u*)(ldsK + row * KRS + ch * 16) = pk[i]; *(LAS v4u*)(ldsV + row * VRS + ch * 16) = pv[i];
            if (ch == 0) { const unsigned kp = (unsigned)(cur.j0 - cur.n() + row); const float ninf = -__builtin_inff();
                pmt[row] = (kp < (unsigned)(cur.pair ? cur.Lr : cur.Lre)) ? 0.f : ninf;
                pmt[NKS_MAX + row] = (cur.pair ? (kp - (unsigned)cur.Lr < (unsigned)cur.Lr) : (kp < (unsigned)cur.Lre)) ? 0.f : ninf; } }
        if (cur.key() != tkey) { tkey = cur.key();
            for (int i = tid; i < cur.nh() * TBL; i += 512) { const int h = i / TBL, rel = i % TBL - TBL / 2; const int ar = rel < 0 ? -rel : rel;
                tbl[i] = (ar <= cur.n()) ? rel_bias[rel_bucket(rel * cur.dil) * 20 + cur.bcol0() + h] * LOG2E : -__builtin_inff(); } }
        __syncthreads();
        const bool more = (k + 1 < nloc);
        if (more) { nxt = decode(k + 1, na0, nA, nb0); ATT_ISSUE(nxt); }
        asm volatile("" ::: "memory");
        const int ntask = cur.isA ? 4 : 2;
#ifdef ATT_DEPHASE
        if (wave >= 4) { if (cur.isA) __builtin_amdgcn_s_sleep(ATT_DEPHASE); else __builtin_amdgcn_s_sleep((ATT_DEPHASE * 5) / 8); }
#endif
#pragma unroll 1
        for (int i = 0; i < ntask; ++i) {
            const int qt = ATT_QT(cur, i); const bool lastt = (i + 1 == ntask);
            const bf16* nq = lastt ? ATT_QPTR(nxt, 0) : ATT_QPTR(cur, i + 1);
            const bool has_nq = !lastt || more;
            if (cur.isA) { const int h = (wave * 4 + i) >> 3, habs = cur.hs * 4 + h; const int qtok = cur.seq0 + cur.j0 + 16 * qt + qi; const int ks = qt < 6 ? 16 * qt : 96;
                attn_task<9, true>(ldsK, ldsV, tbl + h * TBL, pmt, ks, q0, q1, nq, has_nq, cur.n() + 16 * qt + qi, sink[habs] * LOG2E, OA + (size_t)qtok * 768 + habs * 64, nullptr, qi, g, abl);
            } else { const int jj = cur.j0 + 16 * qt + qi; const int jr = cur.pair ? (jj & (cur.Lr - 1)) : jj, rs = cur.res + (cur.pair ? (jj / cur.Lr) : 0);
                const int qtok = cur.seq0 + jr * cur.dil + rs; const int ks = qt < 14 ? 16 * qt : 224;
                attn_task<5, false>(ldsK, ldsV, tbl, pmt + (qt >> 3) * NKS_MAX, ks, q0, q1, nq, has_nq, cur.n() + 16 * qt + qi, 0.f, OBG + ((size_t)(cur.hs >> 2) * TT + qtok) * 256 + (cur.hs & 3) * 64, LSE + ((size_t)(cur.hs >> 2) * TT + qtok) * 4 + (cur.hs & 3), qi, g, abl);
            }
        }
        cur = nxt;
    }
    __syncthreads();
#undef ATT_ISSUE
#undef ATT_QPTR
#undef ATT_QT
}
}

#ifndef ABL_P2
#define ABL_P2 0
#endif
#ifndef REP_P0
#define REP_P0 1
#endif
#ifndef REP_P2B
#define REP_P2B 1
#endif
#ifndef REP_P3
#define REP_P3 1
#endif
#ifndef REP_P1
#define REP_P1 1
#endif
#ifndef REP_P2
#define REP_P2 1
#endif
#ifndef REP_P4
#define REP_P4 1
#endif
#ifndef REP_P5
#define REP_P5 1
#endif
__device__ __forceinline__ void grid_barrier(unsigned* ctr, unsigned target) {
    asm volatile("s_waitcnt vmcnt(0)" ::: "memory");
    __syncthreads();
    if (threadIdx.x == 0) {
        __builtin_amdgcn_fence(__ATOMIC_RELEASE, "agent");
        asm volatile("s_waitcnt vmcnt(0)" ::: "memory");
        __hip_atomic_fetch_add(ctr, 1u, __ATOMIC_RELAXED, __HIP_MEMORY_SCOPE_AGENT);
        unsigned spins = 0;
        while (__hip_atomic_load(ctr, __ATOMIC_RELAXED, __HIP_MEMORY_SCOPE_AGENT) < target) { __builtin_amdgcn_s_sleep(2); if (++spins > (1u << 24)) break; }
        __builtin_amdgcn_fence(__ATOMIC_ACQUIRE, "agent");
        asm volatile("s_waitcnt vmcnt(0)" ::: "memory");
    }
    __syncthreads();
}
#define GSYNC() do { ++bar_n; grid_barrier(bar_ctr, bar_n * (unsigned)G); } while (0)
struct Args { const float* in[14]; float* out; unsigned char* ws; };

__global__ void __launch_bounds__(512, 2) mk_fwd(Args a) {
    extern __shared__ __attribute__((aligned(16))) unsigned char lds_raw[];
    LAS unsigned char* lds = (LAS unsigned char*)lds_raw;
    cg::grid_group grid = cg::this_grid();
    const int tid = threadIdx.x, lane = tid & 63, wave = __builtin_amdgcn_readfirstlane(tid >> 6);
    const int G = gridDim.x, bx = blockIdx.x;
    const float* x_p = a.in[0]; const float* x_s = a.in[1]; const float* rel_bias = a.in[2]; const float* g_mix = a.in[3]; const float* w_in = a.in[4]; const float* b_gate = a.in[5];
    const float* w_a = a.in[6]; const float* w_b = a.in[7]; const float* w_out = a.in[8]; const float* sink = a.in[9]; const float* g_mlp = a.in[10]; const float* w_up = a.in[11]; const float* w_dn = a.in[12]; const float* g_fin = a.in[13];
    unsigned char* ws = a.ws; float* out = a.out;
    bf16* Win_t = (bf16*)(ws + WS_WIN); bf16* Wa_t = (bf16*)(ws + WS_WA); bf16* Wb_t = (bf16*)(ws + WS_WB); bf16* Wout_t = (bf16*)(ws + WS_WOUT); bf16* Wup_t = (bf16*)(ws + WS_WUP); bf16* Wdn_t = (bf16*)(ws + WS_WDN);
    float* SSQ1 = (float*)(ws + WS_SSQ1); float* SSQ2 = (float*)(ws + WS_SSQ2);
    bf16* XN = (bf16*)(ws + WS_XN); bf16* OA = (bf16*)(ws + WS_OA); bf16* OB = (bf16*)(ws + WS_OB); bf16* X1B = (bf16*)(ws + WS_X1B);
    bf16* Zb = (bf16*)(ws + WS_Z); bf16* MRG = (bf16*)(ws + WS_MRG); bf16* Hb = (bf16*)(ws + WS_H); bf16* Gt = (bf16*)(ws + WS_G);
    bf16* OBG = (bf16*)((unsigned char*)out + DO_OBG); float* LSE = (float*)((unsigned char*)out + DO_LSE);
    grid.sync();
    const int gw = bx * 8 + wave, NGW = G * 8;
    unsigned* bar_ctr = (unsigned*)ws; unsigned bar_n = 0;
    const unsigned my_xcc = (unsigned)__builtin_amdgcn_s_getreg((3 << 11) | 20) & 0xFu;
    if (tid == 0) *(LAS unsigned*)(lds + RING_BYTES + 64) = __hip_atomic_fetch_add(bar_ctr + 512 + 64 * (my_xcc & 7u), 1u, __ATOMIC_RELAXED, __HIP_MEMORY_SCOPE_AGENT);

    for (int rep0 = 0; rep0 < REP_P0; ++rep0) {
        LAS float* scr = (LAS float*)(lds + wave * 16384);
        constexpr int I_IN = (DM / 64) * (NIN / 32), I_A = (512 / 64) * (DM / 32), I_B = (256 / 64) * (DM / 32), I_O = (DM / 64) * (DM / 32), I_U = (DM / 64) * (DFF / 32), I_D = (DFF / 64) * (DM / 32);
        constexpr int NIT = I_IN + I_A + I_B + I_O + I_U + I_D;
        for (int it = gw; it < NIT; it += NGW) {
            int r = it;
            if (r < I_IN) { p0_transpose_item_fp8(w_in, DM, NIN, (unsigned char*)Win_t, scr, r, lane, 32.f); continue; } r -= I_IN;
            if (r < I_A) { p0_transpose_item(w_a, 512, DM, Wa_t, nullptr, scr, r, lane, 1.f / 255.f, 768, 0); continue; }     r -= I_A;
            if (r < I_B) { p0_transpose_item(w_b, 256, DM, Wa_t, nullptr, scr, r, lane, 1.f / 255.f, 768, 512); continue; }     r -= I_B;
            if (r < I_O) { p0_transpose_item(w_out, DM, DM, Wout_t, nullptr, scr, r, lane); continue; } r -= I_O;
            if (r < I_U) { p0_transpose_item(w_up, DM, DFF, Wup_t, g_mlp, scr, r, lane); continue; } r -= I_U;
            p0_transpose_item(w_dn, DFF, DM, Wdn_t, nullptr, scr, r, lane);
        }
        f32x4 gv[4];
#pragma unroll
        for (int j = 0; j < 4; ++j) gv[j] = ((const f32x4*)g_mix)[lane + 64 * j];
        for (int m = gw; m < TT; m += 2 * NGW) {
            const int m2 = m + NGW; const bool has2 = m2 < TT;
            const float* xrow = (m < TP) ? x_p + (size_t)m * DM : x_s + (size_t)(m - TP) * DM;
            const float* xrow2 = has2 ? ((m2 < TP) ? x_p + (size_t)m2 * DM : x_s + (size_t)(m2 - TP) * DM) : xrow;
            const f32x4* xr = (const f32x4*)xrow + lane; const f32x4* xr2 = (const f32x4*)xrow2 + lane; f32x4 v[4], w2[4]; float s2 = 0.f, t2 = 0.f;
#pragma unroll
            for (int j = 0; j < 4; ++j) { v[j] = xr[64 * j]; w2[j] = xr2[64 * j]; }
#pragma unroll
            for (int j = 0; j < 4; ++j) { s2 += (v[j].x * v[j].x + v[j].y * v[j].y) + (v[j].z * v[j].z + v[j].w * v[j].w); t2 += (w2[j].x * w2[j].x + w2[j].y * w2[j].y) + (w2[j].z * w2[j].z + w2[j].w * w2[j].w); }
            const float rs = __builtin_amdgcn_rsqf(wave_sum(s2) * (1.f / DM) + RMS_EPS), rt = __builtin_amdgcn_rsqf(wave_sum(t2) * (1.f / DM) + RMS_EPS);
            unsigned* o8 = (unsigned*)((unsigned char*)XN + (size_t)m * DM) + lane;
#pragma unroll
            for (int j = 0; j < 4; ++j) o8[64 * j] = pk4_fp8(v[j].x * rs * gv[j].x, v[j].y * rs * gv[j].y, v[j].z * rs * gv[j].z, v[j].w * rs * gv[j].w);
            if (has2) { unsigned* p8 = (unsigned*)((unsigned char*)XN + (size_t)m2 * DM) + lane;
#pragma unroll
                for (int j = 0; j < 4; ++j) p8[64 * j] = pk4_fp8(w2[j].x * rt * gv[j].x, w2[j].y * rt * gv[j].y, w2[j].z * rt * gv[j].z, w2[j].w * rt * gv[j].w); }
        }
    }
    GSYNC();
    int vbx = bx;
    { LAS int* vslot = (LAS int*)(lds + RING_BYTES);
      if (threadIdx.x == 0) { const unsigned my_rank = *(LAS unsigned*)(lds + RING_BYTES + 64); bool ok = (G % 8 == 0) && (my_xcc < 8u);
          for (int j = 0; j < 8; ++j) ok = ok && (__hip_atomic_load(bar_ctr + 512 + 64 * j, __ATOMIC_RELAXED, __HIP_MEMORY_SCOPE_AGENT) == (unsigned)(G / 8));
          *vslot = ok ? (int)(my_rank * 8u + my_xcc) : bx; }
      __syncthreads(); vbx = __builtin_amdgcn_readfirstlane(*vslot); }
#ifndef NO_P1
#ifdef STAGGER
    if ((bx & 7) >= 4) { for (int z_ = 0; z_ < STAGGER; ++z_) __builtin_amdgcn_s_sleep(127); }
#endif
    for (int rep = 0; rep < REP_P1; ++rep) { pg8::Gemm g{XN, Win_t, TT, NIN, DM / 2, 0x7F7F7F7F}; pg8::StaticOrder S; S.init(TT, NIN, G, vbx); pg8::EpiIn E{Zb, Gt, b_gate};
      pg8::gemm_phase<pg8::EpiIn, pg8::StaticOrder, true, true, true>(lds, g, S, E); }
#endif
    GSYNC();
#ifndef NO_P2
    for (int rep = 0; rep < REP_P2; ++rep) att::attn_phase(lds, Zb, rel_bias, sink, OA, OBG, LSE, rep ? ABL_P2 : 0);
#endif
    GSYNC();
#ifndef NO_P2B
#ifdef EXTRA_BAR
    for (int e_ = 0; e_ < EXTRA_BAR; ++e_) GSYNC();
#endif
    for (int repb = 0; repb < REP_P2B; ++repb)
    for (unsigned idx = (unsigned)bx * 512u + (unsigned)threadIdx.x; idx < (unsigned)TT * 32u; idx += (unsigned)G * 512u) {
        const size_t tok = idx >> 5; const int part = (int)(idx & 31u), hh = part >> 3;
        const float l0 = LSE[tok * 4 + hh], l1 = LSE[((size_t)TT + tok) * 4 + hh], l2 = LSE[((size_t)2 * TT + tok) * 4 + hh];
        const float mx = fmaxf(l0, fmaxf(l1, l2)); float w0 = __builtin_amdgcn_exp2f(l0 - mx), w1 = __builtin_amdgcn_exp2f(l1 - mx), w2 = __builtin_amdgcn_exp2f(l2 - mx);
        const float inv = 1.f / (w0 + w1 + w2); w0 *= inv; w1 *= inv; w2 *= inv;
        const v4u a0 = *(const v4u*)(OBG + tok * 256 + part * 8), a1 = *(const v4u*)(OBG + ((size_t)TT + tok) * 256 + part * 8), a2 = *(const v4u*)(OBG + ((size_t)2 * TT + tok) * 256 + part * 8);
        v4u o;
        o.x = cvtpk(w0 * bf_lo(a0.x) + w1 * bf_lo(a1.x) + w2 * bf_lo(a2.x), w0 * bf_hi(a0.x) + w1 * bf_hi(a1.x) + w2 * bf_hi(a2.x));
        o.y = cvtpk(w0 * bf_lo(a0.y) + w1 * bf_lo(a1.y) + w2 * bf_lo(a2.y), w0 * bf_hi(a0.y) + w1 * bf_hi(a1.y) + w2 * bf_hi(a2.y));
        o.z = cvtpk(w0 * bf_lo(a0.z) + w1 * bf_lo(a1.z) + w2 * bf_lo(a2.z), w0 * bf_hi(a0.z) + w1 * bf_hi(a1.z) + w2 * bf_hi(a2.z));
        o.w = cvtpk(w0 * bf_lo(a0.w) + w1 * bf_lo(a1.w) + w2 * bf_lo(a2.w), w0 * bf_hi(a0.w) + w1 * bf_hi(a1.w) + w2 * bf_hi(a2.w));
        *(v4u*)(OA + tok * 768 + 512 + part * 8) = o;
    }
#endif
    GSYNC();
#ifndef NO_P3
    { pg8::Gemm g{OA, Wa_t, TT, DM, 768}; pg8::StaticOrder S; S.init(TT, DM, G, vbx); pg8::EpiGate2 E{MRG, (const unsigned char*)Gt};
      pg8::gemm_phase<pg8::EpiGate2, pg8::StaticOrder, true, true>(lds, g, S, E); }
#endif
    GSYNC();
#ifndef NO_P4
    for (int rep = 0; rep < REP_P4; ++rep) { pg8::Gemm g{MRG, Wout_t, TT, DM, DM}; pg8::StaticOrder S; S.init(TT, DM, G, vbx); pg8::EpiRes<true> E{x_p, x_s, out, X1B, SSQ1};
      pg8::gemm_phase<pg8::EpiRes<true>, pg8::StaticOrder, true, true>(lds, g, S, E); }
#endif
    GSYNC();
#ifndef NO_P5
#ifdef STAGGER
    if ((bx & 7) >= 4) { for (int z_ = 0; z_ < STAGGER; ++z_) __builtin_amdgcn_s_sleep(127); }
#endif
    for (int rep = 0; rep < REP_P5; ++rep) { pg8::Gemm g{X1B, Wup_t, TT, DFF, DM}; pg8::StaticOrder S; S.init(TT, DFF, G, vbx); pg8::EpiUp E{Hb, SSQ1};
      pg8::gemm_phase<pg8::EpiUp, pg8::StaticOrder, true, true>(lds, g, S, E); }
#endif
    GSYNC();
#ifndef NO_P6
    { pg8::Gemm g{Hb, Wdn_t, TT, DM, DFF}; pg8::StaticOrder S; S.init(TT, DM, G, vbx); pg8::EpiFinal E{out, X1B, SSQ2, bar_ctr + 1024, g_fin};
      pg8::gemm_phase<pg8::EpiFinal, pg8::StaticOrder, true, true>(lds, g, S, E); }
#endif
}

extern "C" void kernel_launch(void* const* d_in, const int* in_sizes, int n_in, void* d_out, int out_size, void* d_ws, size_t ws_size, hipStream_t stream) {
    static int grid = 0;
    if (grid == 0) {
        if (n_in != 14 || ws_size < WS_END || out_size != TT * DM) { fprintf(stderr, "kernel_launch: unexpected shapes (n_in %d, ws %zu, out %d)\n", n_in, ws_size, out_size); grid = -1; return; }
        int dev = 0, cus = 0, per_cu = 0;
        hipGetDevice(&dev); hipDeviceGetAttribute(&cus, hipDeviceAttributeMultiprocessorCount, dev);
        if (hipFuncSetAttribute((const void*)mk_fwd, hipFuncAttributeMaxDynamicSharedMemorySize, LDS_BYTES) != hipSuccess) { fprintf(stderr, "kernel_launch: hipFuncSetAttribute failed\n"); grid = -1; return; }
        if (hipOccupancyMaxActiveBlocksPerMultiprocessor(&per_cu, (const void*)mk_fwd, 512, LDS_BYTES) != hipSuccess || per_cu < 1) { fprintf(stderr, "kernel_launch: occupancy query failed (%d)\n", per_cu); (void)hipGetLastError(); per_cu = 1; }
        grid = cus * per_cu;
        if (grid != 256) fprintf(stderr, "kernel_launch: grid %d != 256: the fused final-norm exchange assumes 256 workgroups (waits are bounded, results would be wrong)\n", grid);
    }
    if (grid < 0) return;
    if (hipMemsetAsync(d_ws, 0, 131072, stream) != hipSuccess) { fprintf(stderr, "kernel_launch: memset of the barrier words failed\n"); return; }
    Args a{};
    for (int i = 0; i < 14; ++i) a.in[i] = (const float*)d_in[i];
    a.out = (float*)d_out; a.ws = (unsigned char*)d_ws;
    void* args[] = {&a};
    hipError_t e = hipLaunchCooperativeKernel((const void*)mk_fwd, dim3(grid), dim3(512), args, LDS_BYTES, stream);
    if (e != hipSuccess) fprintf(stderr, "cooperative launch failed: %s (grid %d)\n", hipGetErrorString(e), grid);
}
```

```cpp
#include <hip/hip_runtime.h>
#include <hip/hip_cooperative_groups.h>
#include <cstdio>
#include <cstdint>
namespace cg = cooperative_groups;
namespace pg8 {
#define PG8_LAS __attribute__((address_space(3)))
typedef unsigned short bf16_t;
typedef short bf16x8 __attribute__((ext_vector_type(8)));
typedef float f32x4 __attribute__((ext_vector_type(4)));
typedef unsigned u32x4 __attribute__((ext_vector_type(4)));
constexpr int BM = 256, BK = 64, HALF = 128, HTB = HALF * BK * 2  , STAGE_BYTES = 8 * HTB, NXCD = 8, WGM = 8;

__host__ __device__ __forceinline__ int lds_byte(int r, int c) { const int st = (r >> 4) * 2 + (c >> 5), rr = r & 15, cc = c & 31, ob = rr * 64 + cc * 2; return st * 1024 + (ob ^ (((ob >> 9) & 1) << 5)); }
__host__ __device__ __forceinline__ void stage_rc(int b, int& R, int& C) { const int st = b / 1024, sb = b % 1024, swz = sb ^ (((sb >> 9) & 1) << 5); R = (st >> 1) * 16 + swz / 64; C = (st & 1) * 32 + (swz % 64) / 2; }
__host__ __device__ __forceinline__ int perm32(int rho) { const int n = rho >> 4, i = rho & 15; return 8 * (i >> 2) + 4 * n + (i & 3); }

struct Unit { int pm, pn; };
struct Gemm { const bf16_t* A; const bf16_t* Bt; int M, N, K; int scale_b = 0x7F7F7F7F; };

struct StaticOrder {
    int nM, nN, nwg, G, c;
    __host__ __device__ void init(int M, int N, int G_, int c_) { nM = M / BM; nN = N / BM; nwg = nM * nN; G = G_; c = c_; }
    __host__ __device__ bool next(int i, Unit& u) const {
        const long L = (long)i * G + c; if (L >= nwg) return false;
        int wgid = (int)L; { const int q = nwg / NXCD, r = nwg % NXCD, xcd = wgid % NXCD, off = wgid / NXCD; wgid = (xcd < r ? xcd * (q + 1) : r * (q + 1) + (xcd - r) * q) + off; }
        const int nig = WGM * nN, gid = wgid / nig, fm = gid * WGM, gsz = (nM - fm) < WGM ? (nM - fm) : WGM;
        u.pm = fm + ((wgid % nig) % gsz); u.pn = (wgid % nig) / gsz; return true;
    }
    __device__ __forceinline__ void a_ready(const Unit&) const {}
    __device__ __forceinline__ void done(const Unit&) const {}
};

typedef float f32x2c_t __attribute__((ext_vector_type(2))); typedef __bf16 bf16x2c_t __attribute__((ext_vector_type(2)));
__device__ __forceinline__ unsigned cvt_pk_bf16(float lo, float hi) { const f32x2c_t v = {lo, hi}; const bf16x2c_t b = __builtin_convertvector(v, bf16x2c_t); return __builtin_bit_cast(unsigned, b); }
typedef float f32x2 __attribute__((ext_vector_type(2)));
__device__ __forceinline__ f32x2 gelu_pk(f32x2 v) {
    const f32x2 av = __builtin_elementwise_abs(v), d = av * 0.2316418882f + 1.0f;
    f32x2 t; t.x = __builtin_amdgcn_rcpf(d.x); t.y = __builtin_amdgcn_rcpf(d.y);
    f32x2 q = t * 0.5307027145f + (-0.7265760135f); q = q * t + 0.7107068705f; q = q * t + (-0.142248368f); q = q * t + 0.127414796f; q = q * t;
    const f32x2 s = (v * v) * (-0.72134752044f);
    f32x2 e; e.x = __builtin_amdgcn_exp2f(s.x); e.y = __builtin_amdgcn_exp2f(s.y);
    const f32x2 m = v * (q * e), r = v - m;
    f32x2 o; o.x = v.x < 0.f ? m.x : r.x; o.y = v.y < 0.f ? m.y : r.y; return o;
}

template <int ACT  > struct EpiBf16 {
    static constexpr bool PERM = true, AFTER_DRAIN = false; static_assert(ACT == 0 || ACT == 1, "EpiBf16: ACT is 0 (none) or 1 (gelu_pk)");
    bf16_t* O; int ldc; const float* bias; int split_cols; size_t split_stride; float scale0;
    __device__ __forceinline__ void operator()(const f32x4 (&acc)[2][2][4][2], const Unit& u, int wr, int wc, int fr, int fq) const {
        const int row0 = u.pm * BM + wr * 64 + fr; int colt = u.pn * BM; bf16_t* base = O;
        float sc = 1.f; if (split_cols) { const int t = colt / split_cols; base += (size_t)t * split_stride; colt -= t * split_cols; if (t == 0) sc = scale0; }
        const int col0 = colt + wc * 32 + 8 * fq, bcol0 = u.pn * BM + wc * 32 + 8 * fq;
        f32x4 bv[2][2];
#pragma unroll
        for (int bj = 0; bj < 2; ++bj)
#pragma unroll
            for (int n = 0; n < 2; ++n) bv[bj][n] = bias ? *(const f32x4*)(bias + bcol0 + bj * HALF + 4 * n) : (f32x4){0.f, 0.f, 0.f, 0.f};
#pragma unroll
        for (int ai = 0; ai < 2; ++ai)
#pragma unroll
            for (int m = 0; m < 4; ++m) { bf16_t* rowp = base + (size_t)(row0 + ai * HALF + m * 16) * ldc + col0;
#pragma unroll
                for (int bj = 0; bj < 2; ++bj) { f32x4 v0 = acc[ai][bj][m][0] + bv[bj][0], v1 = acc[ai][bj][m][1] + bv[bj][1];
                    if (ACT == 1) { f32x2 a = gelu_pk((f32x2){v0[0], v0[1]}), b = gelu_pk((f32x2){v0[2], v0[3]}), c = gelu_pk((f32x2){v1[0], v1[1]}), d = gelu_pk((f32x2){v1[2], v1[3]});
                        v0 = (f32x4){a.x, a.y, b.x, b.y}; v1 = (f32x4){c.x, c.y, d.x, d.y}; }
                    v0 = v0 * sc; v1 = v1 * sc; u32x4 w; w.x = cvt_pk_bf16(v0[0], v0[1]); w.y = cvt_pk_bf16(v0[2], v0[3]); w.z = cvt_pk_bf16(v1[0], v1[1]); w.w = cvt_pk_bf16(v1[2], v1[3]);
                    *(u32x4*)(rowp + bj * HALF) = w; } }
    }
};
template <class Epi, class Sched, bool ALIGN_EPI = false, bool SP2 = false, bool FP8 = false>
__device__ __forceinline__ void gemm_phase(PG8_LAS unsigned char* lds, const Gemm g, const Sched& S, const Epi& E) {
    int tid_l = threadIdx.x; asm volatile("" : "+v"(tid_l));
    const int tid = tid_l, wid = __builtin_amdgcn_readfirstlane(tid >> 6), lane = tid & 63, wr = wid >> 2, wc = wid & 3, fr = lane & 15, fq = lane >> 4;
    const int K = g.K, nt = K / BK;
    unsigned voffA[2], voffB[2];
#pragma unroll
    for (int i = 0; i < 2; ++i) { int R, C; stage_rc(tid * 16 + i * 8192, R, C); const int Rb = Epi::PERM ? ((R & ~31) + perm32(R & 31)) : R;
        voffA[i] = (unsigned)(R * K + C) * 2u; voffB[i] = (unsigned)(Rb * K + C) * 2u; }
    const size_t kstep = (size_t)(BK * 2);
    const size_t hstep = (size_t)HALF * K * 2;
    const size_t tstep = 2 * hstep;
    const unsigned ldsw = (unsigned)wid * 1024u;
    const int aoff = lds_byte(wr * 64 + fr, fq * 8), boff = lds_byte(wc * 32 + fr, fq * 8);
#define PG8_SA(b, h) (((b) * 2 + (h)) * HTB)
#define PG8_SB(b, h) ((4 + (b) * 2 + (h)) * HTB)
#define PG8_STAGE(bufoff, gbase, voff) do { _Pragma("unroll") for (int _i = 0; _i < 2; ++_i) { unsigned vo_ = (voff)[_i]; if constexpr (FP8) asm volatile("" : "+v"(vo_)); \
        __builtin_amdgcn_global_load_lds((const unsigned*)((const char*)(gbase) + vo_), (PG8_LAS unsigned*)(lds + (bufoff) + ldsw + _i * 8192), 16, 0, 0); } } while (0)
#define PG8_LDA(dst, b, h) do { _Pragma("unroll") for (int m = 0; m < 4; ++m) _Pragma("unroll") for (int k = 0; k < 2; ++k) dst[m][k] = *(const PG8_LAS bf16x8*)(lds + PG8_SA(b, h) + aoff + m * 2048 + k * 1024); } while (0)
#define PG8_LDB(dst, b, h) do { _Pragma("unroll") for (int n = 0; n < 2; ++n) _Pragma("unroll") for (int k = 0; k < 2; ++k) dst[n][k] = *(const PG8_LAS bf16x8*)(lds + PG8_SB(b, h) + boff + n * 2048 + k * 1024); } while (0)
#define PG8_MMA(ai, bj, At, Bt) do { if constexpr (FP8) __builtin_amdgcn_sched_barrier(0); __builtin_amdgcn_s_setprio(1); _Pragma("unroll") for (int m = 0; m < 4; ++m) _Pragma("unroll") for (int n = 0; n < 2; ++n) { \
        if constexpr (FP8) { \
            const v4i_t b0_ = __builtin_bit_cast(v4i_t, Bt[n][0]), b1_ = __builtin_bit_cast(v4i_t, Bt[n][1]), a0_ = __builtin_bit_cast(v4i_t, At[m][0]), a1_ = __builtin_bit_cast(v4i_t, At[m][1]); \
            acc[ai][bj][m][n] = __builtin_amdgcn_mfma_scale_f32_16x16x128_f8f6f4(__builtin_shufflevector(b0_, b1_, 0, 1, 2, 3, 4, 5, 6, 7), __builtin_shufflevector(a0_, a1_, 0, 1, 2, 3, 4, 5, 6, 7), acc[ai][bj][m][n], 0, 0, 0, g.scale_b, 0, 0x7F7F7F7F); \
        } else { _Pragma("unroll") for (int k = 0; k < 2; ++k) acc[ai][bj][m][n] = __builtin_amdgcn_mfma_f32_16x16x32_bf16(Bt[n][k], At[m][k], acc[ai][bj][m][n], 0, 0, 0); } } \
        __builtin_amdgcn_s_setprio(0); if constexpr (FP8) __builtin_amdgcn_sched_barrier(0); } while (0)
#define PG8_WAIT_V(n) asm volatile("s_waitcnt vmcnt(" #n ")" ::: "memory")
#define PG8_WAIT_L(n) asm volatile("s_waitcnt lgkmcnt(" #n ")" ::: "memory")
#define PG8_BAR __builtin_amdgcn_s_barrier()
#define PG8_SCHED __builtin_amdgcn_sched_barrier(0)
    Unit cur, nxt; int ui = 0;
    if (!S.next(0, cur)) return;
    f32x4 acc[2][2][4][2];
#pragma unroll
    for (int a = 0; a < 2; ++a)
#pragma unroll
        for (int b = 0; b < 2; ++b)
#pragma unroll
            for (int m = 0; m < 4; ++m)
#pragma unroll
                for (int n = 0; n < 2; ++n) { acc[a][b][m][n] = (f32x4){0.f, 0.f, 0.f, 0.f}; if constexpr (FP8) asm volatile("" : "+v"(acc[a][b][m][n])); }
    bf16x8 At[4][2], B0[2][2], B1[2][2];
    typedef int v4i_t __attribute__((ext_vector_type(4))); typedef int v8i_t __attribute__((ext_vector_type(8)));
    const char* cA = (const char*)g.A + (size_t)cur.pm * tstep; const char* cB = (const char*)g.Bt + (size_t)cur.pn * tstep;
    S.a_ready(cur);
    if constexpr (SP2) {
        PG8_STAGE(PG8_SB(0, 0), cB, voffB); PG8_STAGE(PG8_SB(0, 1), cB + hstep, voffB); PG8_STAGE(PG8_SA(0, 0), cA, voffA); PG8_STAGE(PG8_SA(0, 1), cA + hstep, voffA);
        if (wr == 1) PG8_BAR;
        PG8_WAIT_V(2); PG8_BAR;
        PG8_STAGE(PG8_SB(1, 0), cB + kstep, voffB); PG8_STAGE(PG8_SA(1, 0), cA + kstep, voffA); PG8_STAGE(PG8_SB(1, 1), cB + hstep + kstep, voffB);
        PG8_WAIT_V(6); PG8_BAR;
    } else {
        PG8_STAGE(PG8_SB(0, 0), cB, voffB); PG8_STAGE(PG8_SA(0, 0), cA, voffA); PG8_STAGE(PG8_SB(0, 1), cB + hstep, voffB); PG8_STAGE(PG8_SA(0, 1), cA + hstep, voffA);
        if (wr == 1) PG8_BAR;
        PG8_WAIT_V(4); PG8_BAR;
        PG8_STAGE(PG8_SB(1, 0), cB + kstep, voffB); PG8_STAGE(PG8_SA(1, 0), cA + kstep, voffA); PG8_STAGE(PG8_SB(1, 1), cB + hstep + kstep, voffB);
        PG8_WAIT_V(6); PG8_BAR;
    }
    for (;;) {
        const bool has_next = S.next(ui + 1, nxt);
        const char* nA = has_next ? (const char*)g.A + (size_t)nxt.pm * tstep : cA; const char* nB = has_next ? (const char*)g.Bt + (size_t)nxt.pn * tstep : cB;
#pragma unroll 1
        for (int t = 0; t < nt; t += 2) {
            if constexpr (Epi::MID_T > 0) { if (t == Epi::MID_T) E.mid(acc, cur, wr, wc, fr, fq); }
            const bool last = (t == nt - 2);
            const char* a1 = cA + (size_t)(t + 1) * kstep;
            const char* a2 = last ? nA : cA + (size_t)(t + 2) * kstep; const char* b2 = last ? nB : cB + (size_t)(t + 2) * kstep;
            const char* a3 = a2 + kstep; const char* b3 = b2 + kstep;
            if (last && has_next) S.a_ready(nxt);
            if constexpr (SP2) {
            PG8_LDB(B0, 0, 0); PG8_LDB(B1, 0, 1); PG8_SCHED; PG8_LDA(At, 0, 0); PG8_STAGE(PG8_SA(1, 1), a1 + hstep, voffA);
            PG8_WAIT_V(8); PG8_WAIT_L(0); PG8_BAR; PG8_MMA(0, 0, At, B0); PG8_MMA(0, 1, At, B1); PG8_BAR; PG8_SCHED;
            PG8_LDA(At, 0, 1); PG8_STAGE(PG8_SB(0, 0), b2, voffB); PG8_STAGE(PG8_SB(0, 1), b2 + hstep, voffB); PG8_STAGE(PG8_SA(0, 0), a2, voffA);
            PG8_WAIT_V(8); PG8_WAIT_L(0); PG8_BAR; PG8_MMA(1, 0, At, B0); PG8_MMA(1, 1, At, B1); PG8_BAR; PG8_SCHED;
            PG8_LDB(B0, 1, 0); PG8_LDB(B1, 1, 1); PG8_SCHED; PG8_LDA(At, 1, 0); PG8_STAGE(PG8_SA(0, 1), a2 + hstep, voffA);
            PG8_WAIT_V(8); PG8_WAIT_L(0); PG8_BAR; PG8_MMA(0, 0, At, B0); PG8_MMA(0, 1, At, B1); PG8_BAR; PG8_SCHED;
            PG8_LDA(At, 1, 1); PG8_STAGE(PG8_SB(1, 0), b3, voffB); PG8_STAGE(PG8_SB(1, 1), b3 + hstep, voffB); PG8_STAGE(PG8_SA(1, 0), a3, voffA);
            PG8_WAIT_V(8); PG8_WAIT_L(0); PG8_BAR; PG8_MMA(1, 0, At, B0); PG8_MMA(1, 1, At, B1); PG8_BAR; PG8_SCHED;
            } else {
            PG8_LDB(B0, 0, 0); PG8_SCHED; PG8_LDA(At, 0, 0); PG8_STAGE(PG8_SA(1, 1), a1 + hstep, voffA);
            PG8_WAIT_L(8); PG8_BAR; PG8_WAIT_L(0); PG8_MMA(0, 0, At, B0); PG8_BAR; PG8_SCHED;
            PG8_LDB(B1, 0, 1); PG8_STAGE(PG8_SB(0, 0), b2, voffB);
            PG8_BAR; PG8_WAIT_L(0); PG8_MMA(0, 1, At, B1); PG8_BAR;
            PG8_LDA(At, 0, 1); PG8_STAGE(PG8_SA(0, 0), a2, voffA);
            PG8_BAR; PG8_WAIT_L(0); PG8_MMA(1, 0, At, B0); PG8_BAR; PG8_SCHED;
            PG8_STAGE(PG8_SB(0, 1), b2 + hstep, voffB);
            PG8_WAIT_V(6); PG8_BAR; PG8_MMA(1, 1, At, B1); PG8_BAR;
            PG8_LDB(B0, 1, 0); PG8_SCHED; PG8_LDA(At, 1, 0); PG8_STAGE(PG8_SA(0, 1), a2 + hstep, voffA);
            PG8_WAIT_L(8); PG8_BAR; PG8_WAIT_L(0); PG8_MMA(0, 0, At, B0); PG8_BAR; PG8_SCHED;
            PG8_LDB(B1, 1, 1); PG8_STAGE(PG8_SB(1, 0), b3, voffB);
            PG8_BAR; PG8_WAIT_L(0); PG8_MMA(0, 1, At, B1); PG8_BAR;
            PG8_LDA(At, 1, 1); PG8_STAGE(PG8_SA(1, 0), a3, voffA);
            PG8_BAR; PG8_WAIT_L(0); PG8_MMA(1, 0, At, B0); PG8_BAR; PG8_SCHED;
            PG8_STAGE(PG8_SB(1, 1), b3 + hstep, voffB);
            PG8_WAIT_V(6); PG8_BAR; PG8_MMA(1, 1, At, B1); PG8_BAR;
            }
        }
        if constexpr (ALIGN_EPI) { if (wr == 0) PG8_BAR; }
        if constexpr (!Epi::AFTER_DRAIN) { E(acc, cur, wr, wc, fr, fq); S.done(cur); }
        if (!has_next) break;
#pragma unroll
        for (int a = 0; a < 2; ++a)
#pragma unroll
            for (int b = 0; b < 2; ++b)
#pragma unroll
                for (int m = 0; m < 4; ++m)
#pragma unroll
                    for (int n = 0; n < 2; ++n) { acc[a][b][m][n] = (f32x4){0.f, 0.f, 0.f, 0.f}; if constexpr (FP8) asm volatile("" : "+v"(acc[a][b][m][n])); }
        cur = nxt; cA = nA; cB = nB; ++ui;
        if constexpr (ALIGN_EPI) { if (wr == 1) PG8_BAR; }
    }
    PG8_WAIT_V(0);
    if constexpr (!ALIGN_EPI) { if (wr == 0) PG8_BAR; }
    PG8_BAR;
    if constexpr (Epi::AFTER_DRAIN) { E.fused(acc, cur, wr, wc, fr, fq, lds, wid, lane); S.done(cur); }
#undef PG8_SA
#undef PG8_SB
#undef PG8_STAGE
#undef PG8_LDA
#undef PG8_LDB
#undef PG8_MMA
#undef PG8_WAIT_V
#undef PG8_WAIT_L
#undef PG8_BAR
#undef PG8_SCHED
}
}

constexpr int DM = 1024, TP = 8 * 2048, TSM = 8 * 8192, TT = TP + TSM;
constexpr int NIN = 5120, DFF = 4096, ZC = 3072, GC = 2048;
constexpr float RMS_EPS = 1e-6f, LOG2E = 1.4426950408889634f;
constexpr size_t MiB = 1u << 20;
constexpr size_t WS_WIN = 1 * MiB, WS_WA = 11 * MiB, WS_WB = 12 * MiB, WS_WOUT = 13 * MiB, WS_WUP = 15 * MiB, WS_WDN = 23 * MiB;
constexpr size_t WS_SSQ1 = 32 * MiB, WS_SSQ2 = 37 * MiB;
constexpr size_t WS_XN = 48 * MiB;
constexpr size_t WS_OA = WS_XN, WS_OB = WS_XN + 80 * MiB, WS_X1B = WS_XN;
constexpr size_t WS_Z = 208 * MiB;
constexpr size_t WS_MRG = WS_Z, WS_H = WS_Z;
constexpr size_t WS_G = 688 * MiB;
constexpr size_t WS_END = 1008 * MiB;
constexpr size_t DO_OBG = 0, DO_LSE = 120 * MiB;

constexpr int RING_BYTES = 131072, LDS_BYTES = 147456;

#define LAS __attribute__((address_space(3)))
typedef unsigned short bf16;
typedef unsigned v4u __attribute__((ext_vector_type(4)));
typedef unsigned v2u __attribute__((ext_vector_type(2)));
typedef float f32x4 __attribute__((ext_vector_type(4)));
typedef short bf16x8 __attribute__((ext_vector_type(8)));
typedef short s16x4 __attribute__((ext_vector_type(4)));

__device__ __forceinline__ unsigned cvtpk(float lo, float hi) { return pg8::cvt_pk_bf16(lo, hi); }
__device__ __forceinline__ float bf_lo(unsigned u) { return __builtin_bit_cast(float, u << 16); }
__device__ __forceinline__ float bf_hi(unsigned u) { return __builtin_bit_cast(float, u & 0xffff0000u); }

namespace pg8 {
typedef unsigned u32x2g __attribute__((ext_vector_type(2)));
__device__ __forceinline__ unsigned pk4_fp8g(float a, float b, float c, float d) { int r = __builtin_amdgcn_cvt_pk_fp8_f32(a, b, 0, false); r = __builtin_amdgcn_cvt_pk_fp8_f32(c, d, r, true); return (unsigned)r; }
struct EpiIn {
    static constexpr bool PERM = true, AFTER_DRAIN = false; static constexpr int MID_T = 0;
    bf16_t* Z; bf16_t* Gt; const float* bgate;
    __device__ __forceinline__ void operator()(const f32x4 (&acc)[2][2][4][2], const Unit& u, int wr, int wc, int fr, int fq) const {
        { int l_ = (int)(threadIdx.x & 63u); asm volatile("" : "+v"(l_)); fr = l_ & 15; fq = l_ >> 4; }
        const int row0 = u.pm * BM + wr * 64 + fr;
        const bool isg = u.pn >= 12;
        if (isg) {
            const int col0 = (u.pn - 12) * BM + wc * 32 + 8 * fq;
            f32x4 bv[2][2];
#pragma unroll
            for (int bj = 0; bj < 2; ++bj)
#pragma unroll
                for (int n = 0; n < 2; ++n) bv[bj][n] = *(const f32x4*)(bgate + col0 + bj * HALF + 4 * n);
#pragma unroll
            for (int ai = 0; ai < 2; ++ai)
#pragma unroll
                for (int m = 0; m < 4; ++m) { unsigned char* rowp = (unsigned char*)Gt + (size_t)(row0 + ai * HALF + m * 16) * GC + col0;
#pragma unroll
                    for (int bj = 0; bj < 2; ++bj) { f32x4 v0 = acc[ai][bj][m][0] * 0.03125f + bv[bj][0], v1 = acc[ai][bj][m][1] * 0.03125f + bv[bj][1];
                        unsigned q[8];
#pragma unroll
                        for (int e = 0; e < 4; ++e) { q[e] = (unsigned)__builtin_rintf(255.f * __builtin_amdgcn_rcpf(1.f + __builtin_amdgcn_exp2f(-LOG2E * v0[e]))); q[4 + e] = (unsigned)__builtin_rintf(255.f * __builtin_amdgcn_rcpf(1.f + __builtin_amdgcn_exp2f(-LOG2E * v1[e]))); }
                        u32x2g w; w.x = q[0] | (q[1] << 8) | (q[2] << 16) | (q[3] << 24); w.y = q[4] | (q[5] << 8) | (q[6] << 16) | (q[7] << 24);
                        *(u32x2g*)(rowp + bj * HALF) = w; } }
        } else {
            const int seqL = (u.pm * BM < TP) ? 2048 : 8192, lsh = (u.pm * BM < TP) ? 11 : 13;
#pragma unroll
            for (int bj = 0; bj < 2; ++bj) {
                const int hslot = (u.pn * BM + bj * HALF + wc * 32) >> 6; const int within = (wc & 1) * 32 + 8 * fq;
                int dsh = 0; if (hslot >= 12) { const int gi = ((hslot - 12) % 12) >> 2; dsh = gi == 0 ? 0 : (gi == 1 ? 2 : 4); }
                bf16_t* hb = Z + (size_t)hslot * TT * 64 + within;
#pragma unroll
                for (int ai = 0; ai < 2; ++ai)
#pragma unroll
                    for (int m = 0; m < 4; ++m) { const int r = row0 + ai * HALF + m * 16; const int rr = r - TP * (r >= TP ? 1 : 0); const int seq0 = r - (rr & (seqL - 1)); const int t = rr & (seqL - 1);
                        const int pos = seq0 + ((t & ((1 << dsh) - 1)) << (lsh - dsh)) + (t >> dsh);
                        const f32x4 v0 = acc[ai][bj][m][0] * 0.03125f, v1 = acc[ai][bj][m][1] * 0.03125f;
                        u32x4 w; w.x = cvt_pk_bf16(v0[0], v0[1]); w.y = cvt_pk_bf16(v0[2], v0[3]); w.z = cvt_pk_bf16(v1[0], v1[1]); w.w = cvt_pk_bf16(v1[2], v1[3]);
                        *(u32x4*)(hb + (size_t)pos * 64) = w; } }
        }
    }
};
struct EpiGate2 {
    static constexpr bool PERM = true, AFTER_DRAIN = false; static constexpr int MID_T = 8;
    bf16_t* O; const unsigned char* Gt;
    __device__ __forceinline__ void mid(f32x4 (&acc)[2][2][4][2], const Unit& u, int wr, int wc, int fr, int fq) const {
        asm volatile("" : "+v"(fr), "+v"(fq));
        const int row0 = u.pm * BM + wr * 64 + fr, col0 = u.pn * BM + wc * 32 + 8 * fq;
#pragma unroll
        for (int ai = 0; ai < 2; ++ai)
#pragma unroll
            for (int m = 0; m < 4; ++m) { const size_t r = (size_t)(row0 + ai * HALF + m * 16);
#pragma unroll
                for (int bj = 0; bj < 2; ++bj) {
                    const u32x2g a = *(const u32x2g*)(Gt + r * GC + col0 + bj * HALF), b = *(const u32x2g*)(Gt + r * GC + DM + col0 + bj * HALF);
                    f32x4 v0 = acc[ai][bj][m][0], v1 = acc[ai][bj][m][1];
#define G2R(aw, bw, sh) ((float)(((aw) >> (sh)) & 0xffu) * __builtin_amdgcn_rcpf(fmaxf((float)(((bw) >> (sh)) & 0xffu), 0.5f)))
                    v0[0] *= G2R(a.x, b.x, 0); v0[1] *= G2R(a.x, b.x, 8); v0[2] *= G2R(a.x, b.x, 16); v0[3] *= G2R(a.x, b.x, 24);
                    v1[0] *= G2R(a.y, b.y, 0); v1[1] *= G2R(a.y, b.y, 8); v1[2] *= G2R(a.y, b.y, 16); v1[3] *= G2R(a.y, b.y, 24);
#undef G2R
                    acc[ai][bj][m][0] = v0; acc[ai][bj][m][1] = v1; }
                asm volatile("" ::: "memory"); }
    }
    __device__ __forceinline__ void operator()(const f32x4 (&acc)[2][2][4][2], const Unit& u, int wr, int wc, int fr, int fq) const {
        asm volatile("" : "+v"(fr), "+v"(fq));
        const int row0 = u.pm * BM + wr * 64 + fr, col0 = u.pn * BM + wc * 32 + 8 * fq;
#pragma unroll
        for (int ai = 0; ai < 2; ++ai)
#pragma unroll
            for (int m = 0; m < 4; ++m) { const size_t r = (size_t)(row0 + ai * HALF + m * 16);
#pragma unroll
                for (int bj = 0; bj < 2; ++bj) {
                    const u32x2g b = *(const u32x2g*)(Gt + r * GC + DM + col0 + bj * HALF);
                    f32x4 v0 = acc[ai][bj][m][0], v1 = acc[ai][bj][m][1];
#define G2B(bw, sh) fmaxf((float)(((bw) >> (sh)) & 0xffu), 0.5f)
                    v0[0] *= G2B(b.x, 0); v0[1] *= G2B(b.x, 8); v0[2] *= G2B(b.x, 16); v0[3] *= G2B(b.x, 24);
                    v1[0] *= G2B(b.y, 0); v1[1] *= G2B(b.y, 8); v1[2] *= G2B(b.y, 16); v1[3] *= G2B(b.y, 24);
#undef G2B
                    u32x2g w; w.x = pk4_fp8g(v0[0] * 16.f, v0[1] * 16.f, v0[2] * 16.f, v0[3] * 16.f); w.y = pk4_fp8g(v1[0] * 16.f, v1[1] * 16.f, v1[2] * 16.f, v1[3] * 16.f);
                    *(u32x2g*)((unsigned char*)O + r * DM + col0 + bj * HALF) = w; }
                asm volatile("" ::: "memory"); }
    }
};
template <bool WB> struct EpiRes {
    static constexpr bool PERM = true, AFTER_DRAIN = false; static constexpr int MID_T = 0;
    const float* xp; const float* xs;
    float* out; bf16_t* xb; float* ssq; float ascale;
    __device__ __forceinline__ void operator()(const f32x4 (&acc)[2][2][4][2], const Unit& u, int wr, int wc, int fr, int fq) const {
        { int l_ = (int)(threadIdx.x & 63u); asm volatile("" : "+v"(l_)); fr = l_ & 15; fq = l_ >> 4; }
        const int row0 = u.pm * BM + wr * 64 + fr, col0 = u.pn * BM + wc * 32 + 8 * fq;
        const float* xbase = (u.pm * BM < TP) ? xp : (xs - (size_t)TP * DM);
#pragma unroll
        for (int ai = 0; ai < 2; ++ai) {
            f32x4 xv[4][2][2];
#pragma unroll
            for (int m = 0; m < 4; ++m)
#pragma unroll
                for (int bj = 0; bj < 2; ++bj) { const size_t off = (size_t)(row0 + ai * HALF + m * 16) * DM + col0 + bj * HALF; xv[m][bj][0] = *(const f32x4*)(xbase + off); xv[m][bj][1] = *(const f32x4*)(xbase + off + 4); }
#pragma unroll
            for (int m = 0; m < 4; ++m) { const size_t r = (size_t)(row0 + ai * HALF + m * 16); float ss = 0.f;
#pragma unroll
                for (int bj = 0; bj < 2; ++bj) { const size_t off = r * DM + col0 + bj * HALF;
                    const f32x4 v0 = acc[ai][bj][m][0] * ascale + xv[m][bj][0], v1 = acc[ai][bj][m][1] * ascale + xv[m][bj][1];
                    if (!WB) { *(f32x4*)(out + off) = v0; *(f32x4*)(out + off + 4) = v1; }
                    if (WB) { u32x4 w; w.x = cvt_pk_bf16(v0[0], v0[1]); w.y = cvt_pk_bf16(v0[2], v0[3]); w.z = cvt_pk_bf16(v1[0], v1[1]); w.w = cvt_pk_bf16(v1[2], v1[3]); *(u32x4*)(xb + off) = w; }
                    ss += (v0[0] * v0[0] + v0[1] * v0[1]) + (v0[2] * v0[2] + v0[3] * v0[3]) + (v1[0] * v1[0] + v1[1] * v1[1]) + (v1[2] * v1[2] + v1[3] * v1[3]); }
                ss += __shfl_xor(ss, 16); ss += __shfl_xor(ss, 32);
                if (fq == 0) ssq[r * 16 + u.pn * 4 + wc] = ss; }
            asm volatile("" ::: "memory"); }
    }
};
struct EpiUp {
    static constexpr bool PERM = true, AFTER_DRAIN = false; static constexpr int MID_T = 0;
    bf16_t* O; const float* ssq;
    __device__ __forceinline__ void operator()(const f32x4 (&acc)[2][2][4][2], const Unit& u, int wr, int wc, int fr, int fq) const {
        const int row0 = u.pm * BM + wr * 64 + fr, col0 = u.pn * BM + wc * 32 + 8 * fq;
#pragma unroll
        for (int ai = 0; ai < 2; ++ai)
#pragma unroll
            for (int m = 0; m < 4; ++m) { const size_t r = (size_t)(row0 + ai * HALF + m * 16);
                const f32x4 pq = *(const f32x4*)(ssq + r * 16 + 4 * fq);
                float ss = (pq[0] + pq[1]) + (pq[2] + pq[3]); ss += __shfl_xor(ss, 16); ss += __shfl_xor(ss, 32);
                const float rs = __builtin_amdgcn_rsqf(ss * (1.f / DM) + RMS_EPS);
#pragma unroll
                for (int bj = 0; bj < 2; ++bj) { f32x4 v0 = acc[ai][bj][m][0] * rs, v1 = acc[ai][bj][m][1] * rs;
#pragma unroll
                    for (int e = 0; e < 4; ++e) { const float a = fmaxf(v0[e], 0.f), b = fmaxf(v1[e], 0.f); v0[e] = a * a; v1[e] = b * b; }
                    u32x4 w; w.x = cvt_pk_bf16(v0[0], v0[1]); w.y = cvt_pk_bf16(v0[2], v0[3]); w.z = cvt_pk_bf16(v1[0], v1[1]); w.w = cvt_pk_bf16(v1[2], v1[3]);
                    *(u32x4*)(O + r * DFF + col0 + bj * HALF) = w; } }
    }
};
struct EpiFinal {
    static constexpr bool PERM = true, AFTER_DRAIN = false; static constexpr int MID_T = 0;
    float* out; const bf16_t* xb; float* ssq; unsigned* cnt; const float* gfin;
    __device__ __forceinline__ void operator()(f32x4 (&acc)[2][2][4][2], const Unit& u, int wr, int wc, int fr, int fq) const {
        const int row0 = u.pm * BM + wr * 64 + fr, col0 = u.pn * BM + wc * 32 + 8 * fq;
#pragma unroll
        for (int ai = 0; ai < 2; ++ai) {
            u32x4 xv[4][2];
#pragma unroll
            for (int m = 0; m < 4; ++m)
#pragma unroll
                for (int bj = 0; bj < 2; ++bj) { const size_t off = (size_t)(row0 + ai * HALF + m * 16) * DM + col0 + bj * HALF; xv[m][bj] = *(const u32x4*)(xb + off); }
#pragma unroll
            for (int m = 0; m < 4; ++m) { const size_t r = (size_t)(row0 + ai * HALF + m * 16); float ss = 0.f;
#pragma unroll
                for (int bj = 0; bj < 2; ++bj) { const u32x4 xw = xv[m][bj];
                    const f32x4 x0 = {bf_lo(xw.x), bf_hi(xw.x), bf_lo(xw.y), bf_hi(xw.y)}, x1 = {bf_lo(xw.z), bf_hi(xw.z), bf_lo(xw.w), bf_hi(xw.w)};
                    const f32x4 v0 = acc[ai][bj][m][0] + x0, v1 = acc[ai][bj][m][1] + x1; acc[ai][bj][m][0] = v0; acc[ai][bj][m][1] = v1;
                    ss += (v0[0] * v0[0] + v0[1] * v0[1]) + (v0[2] * v0[2] + v0[3] * v0[3]) + (v1[0] * v1[0] + v1[1] * v1[1]) + (v1[2] * v1[2] + v1[3] * v1[3]); }
                ss += __shfl_xor(ss, 16); ss += __shfl_xor(ss, 32);
                if (fq == 0) __hip_atomic_store(ssq + r * 16 + u.pn * 4 + wc, ss, __ATOMIC_RELAXED, __HIP_MEMORY_SCOPE_AGENT); }
            asm volatile("" ::: "memory"); }
        asm volatile("s_waitcnt vmcnt(0)" ::: "memory");
        unsigned* pc = cnt + 64 * u.pm;
        if (fr == 0 && fq == 0) __hip_atomic_fetch_add(pc, 1u, __ATOMIC_RELAXED, __HIP_MEMORY_SCOPE_AGENT);
        unsigned seen;
        { unsigned spins = 0;
          while ((seen = (unsigned)__builtin_amdgcn_readfirstlane(__hip_atomic_load(pc, __ATOMIC_RELAXED, __HIP_MEMORY_SCOPE_AGENT))) < 32u) { __builtin_amdgcn_s_sleep(2); if (++spins > (1u << 22)) break; } }
        const unsigned dep0 = seen >> 31;
        f32x4 gv[2][2];
#pragma unroll
        for (int bj = 0; bj < 2; ++bj)
#pragma unroll
            for (int n = 0; n < 2; ++n) gv[bj][n] = *(const f32x4*)(gfin + col0 + bj * HALF + 4 * n);
#pragma unroll
        for (int ai = 0; ai < 2; ++ai)
#pragma unroll
            for (int m = 0; m < 4; ++m) { const size_t r = (size_t)(row0 + ai * HALF + m * 16);
                const float* pp = ssq + r * 16 + 4 * fq + dep0;
                const float q0 = __hip_atomic_load(pp + 0, __ATOMIC_RELAXED, __HIP_MEMORY_SCOPE_AGENT), q1 = __hip_atomic_load(pp + 1, __ATOMIC_RELAXED, __HIP_MEMORY_SCOPE_AGENT),
                            q2 = __hip_atomic_load(pp + 2, __ATOMIC_RELAXED, __HIP_MEMORY_SCOPE_AGENT), q3 = __hip_atomic_load(pp + 3, __ATOMIC_RELAXED, __HIP_MEMORY_SCOPE_AGENT);
                float tot = (q0 + q1) + (q2 + q3); tot += __shfl_xor(tot, 16); tot += __shfl_xor(tot, 32);
                const float rs = __builtin_amdgcn_rsqf(tot * (1.f / DM) + RMS_EPS);
#pragma unroll
                for (int bj = 0; bj < 2; ++bj) { const size_t off = r * DM + col0 + bj * HALF;
                    *(f32x4*)(out + off) = acc[ai][bj][m][0] * rs * gv[bj][0]; *(f32x4*)(out + off + 4) = acc[ai][bj][m][1] * rs * gv[bj][1]; } }
    }
};
}

__device__ __forceinline__ float wave_sum(float v) {
#pragma unroll
    for (int o = 1; o < 64; o <<= 1) v += __shfl_xor(v, o);
    return v;
}
__device__ __forceinline__ unsigned pk4_fp8(float a, float b, float c, float d) { int r = __builtin_amdgcn_cvt_pk_fp8_f32(a, b, 0, false); r = __builtin_amdgcn_cvt_pk_fp8_f32(c, d, r, true); return (unsigned)r; }
__device__ __forceinline__ void p0_transpose_item_fp8(const float* W, int K, int N, unsigned char* WT, LAS float* scr, int item, int lane, float sscale) {
    const int nblk = N / 32, kb = item / nblk, nb = item % nblk, k0 = 64 * kb, n0 = 32 * nb;
#pragma unroll 8
    for (int i = 0; i < 32; ++i) { const int kk = 2 * i + (lane >> 5); scr[kk * 33 + (lane & 31)] = W[(size_t)(k0 + kk) * N + n0 + (lane & 31)] * sscale; }
    asm volatile("s_waitcnt lgkmcnt(0)" ::: "memory");
    const int c = lane & 7;
#pragma unroll
    for (int j = 0; j < 4; ++j) { const int n = (lane >> 3) + 8 * j; const LAS float* s = scr + (8 * c) * 33 + n;
        v2u o; o.x = pk4_fp8(s[0 * 33], s[1 * 33], s[2 * 33], s[3 * 33]); o.y = pk4_fp8(s[4 * 33], s[5 * 33], s[6 * 33], s[7 * 33]);
        *(v2u*)(WT + (size_t)(n0 + n) * K + k0 + 8 * c) = o; }
    asm volatile("s_waitcnt lgkmcnt(0)" ::: "memory");
}
__device__ __forceinline__ void p0_transpose_item(const float* W, int K, int N, bf16* WT, const float* kscale, LAS float* scr, int item, int lane, float sscale = 1.f, int ld = 0, int koff = 0) {
    if (ld == 0) ld = K;
    const int nblk = N / 32, kb = item / nblk, nb = item % nblk, k0 = 64 * kb, n0 = 32 * nb;
#pragma unroll 8
    for (int i = 0; i < 32; ++i) { const int kk = 2 * i + (lane >> 5); float v = W[(size_t)(k0 + kk) * N + n0 + (lane & 31)] * sscale; if (kscale) v *= kscale[k0 + kk]; scr[kk * 33 + (lane & 31)] = v; }
    asm volatile("s_waitcnt lgkmcnt(0)" ::: "memory");
    const int c = lane & 7;
#pragma unroll
    for (int j = 0; j < 4; ++j) { const int n = (lane >> 3) + 8 * j; const LAS float* s = scr + (8 * c) * 33 + n;
        v4u o; o.x = cvtpk(s[0 * 33], s[1 * 33]); o.y = cvtpk(s[2 * 33], s[3 * 33]); o.z = cvtpk(s[4 * 33], s[5 * 33]); o.w = cvtpk(s[6 * 33], s[7 * 33]);
        *(v4u*)(WT + (size_t)(n0 + n) * ld + koff + k0 + 8 * c) = o; }
    asm volatile("s_waitcnt lgkmcnt(0)" ::: "memory");
}

namespace att {
constexpr int KRS = 144, VRS = 160, NKS_MAX = 384, TBL = 640;
constexpr int L_K = 0, L_V = NKS_MAX * KRS, L_T = L_V + NKS_MAX * VRS, L_PM = L_T + 4 * TBL * 4, L_END = L_PM + 2 * NKS_MAX * 4;
static_assert(L_END <= RING_BYTES, "attention LDS");
constexpr int NITEM_A = (TT / 128) * 2, NITEM_B = (TT / 256) * 12;

__device__ __forceinline__ int rel_bucket(int rel) {
    const int n = rel < 0 ? -rel : rel; int b;
    if (n < 8) b = n; else if (n < 15) b = 8; else if (n < 27) b = 9; else if (n < 50) b = 10; else if (n < 91) b = 11; else if (n < 166) b = 12; else if (n < 305) b = 13; else if (n < 559) b = 14; else b = 15;
    return b + (rel > 0 ? 16 : 0);
}
__device__ __forceinline__ s16x4 vtr(LAS const unsigned char* p) { return __builtin_bit_cast(s16x4, __builtin_amdgcn_ds_read_tr16_b64_v4i16((LAS s16x4*)p)); }

template <int NCH, bool IS_A>
__device__ __forceinline__ void attn_task(LAS const unsigned char* ldsK, LAS const unsigned char* ldsV, LAS const float* tbl, LAS const float* pm, int kstart,
                                          bf16x8& qf0, bf16x8& qf1, const bf16* nq, bool has_nq, int qrel, float sink2, bf16* orow, float* lsep, int qi, int g, int abl = 0) {
    constexpr int NT = 2 * NCH;
    f32x4 s[NT];
    LAS const unsigned char* kp = ldsK + (kstart + qi) * KRS + g * 16;
    LAS const float* pmb = pm + (kstart + 4 * g);
    {
        bf16x8 ka[2][2][2]; f32x4 pz[2][2];
#pragma unroll
        for (int j = 0; j < 2; ++j) { ka[0][j][0] = *(LAS const bf16x8*)(kp + j * 16 * KRS); ka[0][j][1] = *(LAS const bf16x8*)(kp + j * 16 * KRS + 64); pz[0][j] = *(LAS const f32x4*)(pmb + 16 * j); }
#pragma unroll
        for (int tp = 0; tp < NT / 2; ++tp) { const int b = tp & 1;
            if (tp + 1 < NT / 2) {
#pragma unroll
                for (int j = 0; j < 2; ++j) { const int t = 2 * (tp + 1) + j; ka[b ^ 1][j][0] = *(LAS const bf16x8*)(kp + t * 16 * KRS); ka[b ^ 1][j][1] = *(LAS const bf16x8*)(kp + t * 16 * KRS + 64); pz[b ^ 1][j] = *(LAS const f32x4*)(pmb + 16 * t); } }
            __builtin_amdgcn_sched_barrier(0);
#pragma unroll
            for (int j = 0; j < 2; ++j) { f32x4 z = __builtin_amdgcn_mfma_f32_16x16x32_bf16(ka[b][j][0], qf0, pz[b][j], 0, 0, 0); s[2 * tp + j] = __builtin_amdgcn_mfma_f32_16x16x32_bf16(ka[b][j][1], qf1, z, 0, 0, 0); }
            __builtin_amdgcn_sched_barrier(0);
        }
    }
    if (has_nq) { qf0 = *(const bf16x8*)(nq + g * 8); qf1 = *(const bf16x8*)(nq + 32 + g * 8); }
    constexpr float C = 0.125f * LOG2E; const float NEG = -__builtin_inff();
    LAS const float* tb = tbl + (kstart + 4 * g - qrel + TBL / 2);
    float m = NEG;
    {
        float tv[2][8];
#pragma unroll
        for (int i = 0; i < 8; ++i) tv[0][i] = tb[16 * (i >> 2) + (i & 3)];
#pragma unroll
        for (int tp = 0; tp < NT / 2; ++tp) { const int b = tp & 1;
            if (tp + 1 < NT / 2) {
#pragma unroll
                for (int i = 0; i < 8; ++i) tv[b ^ 1][i] = tb[16 * (2 * (tp + 1) + (i >> 2)) + (i & 3)]; }
            __builtin_amdgcn_sched_barrier(0);
#pragma unroll
            for (int i = 0; i < 8; ++i) { const int t = 2 * tp + (i >> 2), r = i & 3; const float v = s[t][r] * C + tv[b][i]; s[t][r] = v; m = fmaxf(m, v); }
            __builtin_amdgcn_sched_barrier(0);
        }
    }
    m = fmaxf(m, __shfl_xor(m, 16)); m = fmaxf(m, __shfl_xor(m, 32));
    if (IS_A) m = fmaxf(m, sink2);
    float sum = 0.f;
#pragma unroll
    for (int t = 0; t < NT; ++t)
#pragma unroll
        for (int r = 0; r < 4; ++r) { const float p = __builtin_amdgcn_exp2f(s[t][r] - m); s[t][r] = p; sum += p; }
    sum += __shfl_xor(sum, 16); sum += __shfl_xor(sum, 32);
    if (IS_A) sum += __builtin_amdgcn_exp2f(sink2 - m);
    const float inv = __builtin_amdgcn_rcpf(sum);
    f32x4 o[4];
#pragma unroll
    for (int d = 0; d < 4; ++d) o[d] = (f32x4){0.f, 0.f, 0.f, 0.f};
    LAS const unsigned char* vp = ldsV + (kstart + 4 * g + (qi >> 2)) * VRS + (qi & 3) * 8;
    {
        s16x4 vl[2][4], vh[2][4];
#pragma unroll
        for (int d = 0; d < 4; ++d) { vl[0][d] = vtr(vp + d * 32); vh[0][d] = vtr(vp + 16 * VRS + d * 32); }
#pragma unroll
        for (int c = 0; c < NCH; ++c) { const int b = c & 1;
            if (c + 1 < NCH) {
#pragma unroll
                for (int d = 0; d < 4; ++d) { vl[b ^ 1][d] = vtr(vp + (32 * (c + 1)) * VRS + d * 32); vh[b ^ 1][d] = vtr(vp + (32 * (c + 1) + 16) * VRS + d * 32); } }
            v4u pw; pw.x = cvtpk(s[2 * c][0], s[2 * c][1]); pw.y = cvtpk(s[2 * c][2], s[2 * c][3]); pw.z = cvtpk(s[2 * c + 1][0], s[2 * c + 1][1]); pw.w = cvtpk(s[2 * c + 1][2], s[2 * c + 1][3]);
            const bf16x8 pb = __builtin_bit_cast(bf16x8, pw);
            __builtin_amdgcn_sched_barrier(0);
#pragma unroll
            for (int d = 0; d < 4; ++d) { const s16x4 lo = vl[b][d], hi = vh[b][d];
                const bf16x8 va = (bf16x8){lo[0], lo[1], lo[2], lo[3], hi[0], hi[1], hi[2], hi[3]};
                o[d] = __builtin_amdgcn_mfma_f32_16x16x32_bf16(va, pb, o[d], 0, 0, 0); }
            __builtin_amdgcn_sched_barrier(0);
        }
    }
#pragma unroll
    for (int d = 0; d < 4; ++d) { v2u w; w.x = cvtpk(o[d][0] * inv, o[d][1] * inv); w.y = cvtpk(o[d][2] * inv, o[d][3] * inv); if (!(abl & 1) || w.x == 0x12345678u) *(v2u*)(orow + 16 * d + 4 * g) = w; }
    if (!IS_A) { if (g == 0 && !(abl & 1)) *lsep = m + __builtin_log2f(sum); }
}

struct Item { int isA, seq0, j0, Lr, Lre, dil, res, hs, pair;
    __device__ __forceinline__ int n() const { return isA ? 128 : 64; }
    __device__ __forceinline__ int nh() const { return isA ? 4 : 1; }
    __device__ __forceinline__ int kslot() const { return isA ? 8 + hs : 24 + hs; }
    __device__ __forceinline__ int vslot() const { return isA ? 10 + hs : 36 + hs; }
    __device__ __forceinline__ int qslot0() const { return isA ? hs * 4 : 12 + hs; }
    __device__ __forceinline__ int bcol0() const { return isA ? hs * 4 : 8 + hs; }
    __device__ __forceinline__ int key() const { return isA ? hs : 2 + hs; }
};
__device__ __forceinline__ Item decode(int k, int na0, int nA, int nb0) {
    Item I; int tok0;
    if (k < nA) { const int ia = na0 + k; I.isA = 1; I.hs = ia / (TT / 128); tok0 = (ia % (TT / 128)) * 128; I.dil = 1; }
    else { const int ib = nb0 + (k - nA); I.hs = ib / (TT / 256); I.isA = 0; const int gi = I.hs >> 2; tok0 = (ib % (TT / 256)) * 256; I.dil = gi == 0 ? 1 : (gi == 1 ? 4 : 16); }
    int L;
    if (tok0 < TP) { L = 2048; I.seq0 = (tok0 / 2048) * 2048; } else { L = 8192; I.seq0 = TP + ((tok0 - TP) / 8192) * 8192; }
    I.res = 0; I.j0 = tok0 - I.seq0; I.Lr = L; I.Lre = L; I.pair = 0;
    if (!I.isA) { I.Lr = L / I.dil; const int blk = (tok0 - I.seq0) / 256;
        if (I.Lr >= 256) { const int bpr = I.Lr / 256; I.res = blk / bpr; I.j0 = (blk % bpr) * 256; I.Lre = I.Lr; }
        else { I.res = 2 * blk; I.j0 = 0; I.Lre = 2 * I.Lr; I.pair = 1; } }
    return I;
}

__device__ __forceinline__ void attn_phase(LAS unsigned char* lds, const bf16* Z, const float* rel_bias, const float* sink, bf16* OA, bf16* OBG, float* LSE, int abl = 0) {
    int tid_l = threadIdx.x; asm volatile("" : "+v"(tid_l));
    const int tid = tid_l, lane = tid & 63, wave = __builtin_amdgcn_readfirstlane(tid >> 6), qi = lane & 15, g = lane >> 4;
    LAS unsigned char* ldsK = lds + L_K; LAS unsigned char* ldsV = lds + L_V; LAS float* tbl = (LAS float*)(lds + L_T); LAS float* pmt = (LAS float*)(lds + L_PM);
    const int G = gridDim.x, bx = blockIdx.x;
    const int na0 = (int)((long)bx * NITEM_A / G), nA = (int)((long)(bx + 1) * NITEM_A / G) - na0;
    const int nb0 = (int)((long)bx * NITEM_B / G), nB = (int)((long)(bx + 1) * NITEM_B / G) - nb0;
    const int nloc = nA + nB, r0 = tid >> 3, ch = tid & 7;
    v4u pk[6], pv[6];
#define ATT_ISSUE(I) do { _Pragma("unroll") for (int i_ = 0; i_ < 6; ++i_) { const int row_ = r0 + 64 * i_, kpos_ = (I).j0 - (I).n() + row_; pk[i_] = (v4u){0u, 0u, 0u, 0u}; pv[i_] = (v4u){0u, 0u, 0u, 0u}; \
        if ((unsigned)kpos_ < (unsigned)(I).Lre && !(abl & 2)) { const size_t ro_ = (size_t)((I).seq0 + (I).res * (I).Lr + kpos_) * 64 + ch * 8; pk[i_] = *(const v4u*)(Z + (size_t)(I).kslot() * TT * 64 + ro_); pv[i_] = *(const v4u*)(Z + (size_t)(I).vslot() * TT * 64 + ro_); } } } while (0)
    if (nloc <= 0) return;
    Item cur = decode(0, na0, nA, nb0), nxt = cur;
#define ATT_QT(I, i_) ((I).isA ? ((wave * 4 + (i_)) & 7) : (wave * 2 + (i_)))
#define ATT_QPTR(I, i_) (Z + ((size_t)((I).qslot0() + ((I).isA ? ((wave * 4 + (i_)) >> 3) : 0)) * TT + (I).seq0 + (I).res * (I).Lr + (I).j0 + 16 * ATT_QT(I, i_) + qi) * 64)
    bf16x8 q0, q1;
    { const bf16* qp = ATT_QPTR(cur, 0); q0 = *(const bf16x8*)(qp + g * 8); q1 = *(const bf16x8*)(qp + 32 + g * 8); }
    asm volatile("" ::: "memory");
    ATT_ISSUE(cur);
    int tkey = -1;
    for (int k = 0; k < nloc; ++k) {
        __syncthreads();
#pragma unroll
        for (int i = 0; i < 6; ++i) { const int row = r0 + 64 * i; *(LAS v4u*)(ldsK + row * KRS + ch * 16) = pk[i]; *(LAS v4u*)(ldsV + row * VRS + ch * 16) = pv[i];
            if (ch == 0) { const unsigned kp = (unsigned)(cur.j0 - cur.n() + row); const float ninf = -__builtin_inff();
                pmt[row] = (kp < (unsigned)(cur.pair ? cur.Lr : cur.Lre)) ? 0.f : ninf;
                pmt[NKS_MAX + row] = (cur.pair ? (kp - (unsigned)cur.Lr < (unsigned)cur.Lr) : (kp < (unsigned)cur.Lre)) ? 0.f : ninf; } }
        if (cur.key() != tkey) { tkey = cur.key();
            for (int i = tid; i < cur.nh() * TBL; i += 512) { const int h = i / TBL, rel = i % TBL - TBL / 2; const int ar = rel < 0 ? -rel : rel;
                tbl[i] = (ar <= cur.n()) ? rel_bias[rel_bucket(rel * cur.dil) * 20 + cur.bcol0() + h] * LOG2E : -__builtin_inff(); } }
        __syncthreads();
        const bool more = (k + 1 < nloc);
        if (more) { nxt = decode(k + 1, na0, nA, nb0); ATT_ISSUE(nxt); }
        asm volatile("" ::: "memory");
        const int ntask = cur.isA ? 4 : 2;
#ifdef ATT_DEPHASE
        if (wave >= 4) { if (cur.isA) __builtin_amdgcn_s_sleep(ATT_DEPHASE); else __builtin_amdgcn_s_sleep((ATT_DEPHASE * 5) / 8); }
#endif
#pragma unroll 1
        for (int i = 0; i < ntask; ++i) {
            const int qt = ATT_QT(cur, i); const bool lastt = (i + 1 == ntask);
            const bf16* nq = lastt ? ATT_QPTR(nxt, 0) : ATT_QPTR(cur, i + 1);
            const bool has_nq = !lastt || more;
            if (cur.isA) { const int h = (wave * 4 + i) >> 3, habs = cur.hs * 4 + h; const int qtok = cur.seq0 + cur.j0 + 16 * qt + qi; const int ks = qt < 6 ? 16 * qt : 96;
                attn_task<9, true>(ldsK, ldsV, tbl + h * TBL, pmt, ks, q0, q1, nq, has_nq, cur.n() + 16 * qt + qi, sink[habs] * LOG2E, OA + (size_t)qtok * 768 + habs * 64, nullptr, qi, g, abl);
            } else { const int jj = cur.j0 + 16 * qt + qi; const int jr = cur.pair ? (jj & (cur.Lr - 1)) : jj, rs = cur.res + (cur.pair ? (jj / cur.Lr) : 0);
                const int qtok = cur.seq0 + jr * cur.dil + rs; const int ks = qt < 14 ? 16 * qt : 224;
                attn_task<5, false>(ldsK, ldsV, tbl, pmt + (qt >> 3) * NKS_MAX, ks, q0, q1, nq, has_nq, cur.n() + 16 * qt + qi, 0.f, OBG + ((size_t)(cur.hs >> 2) * TT + qtok) * 256 + (cur.hs & 3) * 64, LSE + ((size_t)(cur.hs >> 2) * TT + qtok) * 4 + (cur.hs & 3), qi, g, abl);
            }
        }
        cur = nxt;
    }
    __syncthreads();
#undef ATT_ISSUE
#undef ATT_QPTR
#undef ATT_QT
}
}

#ifndef ABL_P2
#define ABL_P2 0
#endif
#ifndef REP_P0
#define REP_P0 1
#endif
#ifndef REP_P2B
#define REP_P2B 1
#endif
#ifndef REP_P3
#define REP_P3 1
#endif
#ifndef REP_P1
#define REP_P1 1
#endif
#ifndef REP_P2
#define REP_P2 1
#endif
#ifndef REP_P4
#define REP_P4 1
#endif
#ifndef REP_P5
#define REP_P5 1
#endif
__device__ __forceinline__ void grid_barrier(unsigned* ctr, unsigned target) {
    asm volatile("s_waitcnt vmcnt(0)" ::: "memory");
    __syncthreads();
    if (threadIdx.x == 0) {
        __builtin_amdgcn_fence(__ATOMIC_RELEASE, "agent");
        asm volatile("s_waitcnt vmcnt(0)" ::: "memory");
        __hip_atomic_fetch_add(ctr, 1u, __ATOMIC_RELAXED, __HIP_MEMORY_SCOPE_AGENT);
        unsigned spins = 0;
        while (__hip_atomic_load(ctr, __ATOMIC_RELAXED, __HIP_MEMORY_SCOPE_AGENT) < target) { __builtin_amdgcn_s_sleep(2); if (++spins > (1u << 24)) break; }
        __builtin_amdgcn_fence(__ATOMIC_ACQUIRE, "agent");
        asm volatile("s_waitcnt vmcnt(0)" ::: "memory");
    }
    __syncthreads();
}
#define GSYNC() do { ++bar_n; grid_barrier(bar_ctr, bar_n * (unsigned)G); } while (0)
struct Args { const float* in[14]; float* out; unsigned char* ws; };

__global__ void __launch_bounds__(512, 2) mk_fwd(Args a) {
    extern __shared__ __attribute__((aligned(16))) unsigned char lds_raw[];
    LAS unsigned char* lds = (LAS unsigned char*)lds_raw;
    cg::grid_group grid = cg::this_grid();
    const int tid = threadIdx.x, lane = tid & 63, wave = __builtin_amdgcn_readfirstlane(tid >> 6);
    const int G = gridDim.x, bx = blockIdx.x;
    const float* x_p = a.in[0]; const float* x_s = a.in[1]; const float* rel_bias = a.in[2]; const float* g_mix = a.in[3]; const float* w_in = a.in[4]; const float* b_gate = a.in[5];
    const float* w_a = a.in[6]; const float* w_b = a.in[7]; const float* w_out = a.in[8]; const float* sink = a.in[9]; const float* g_mlp = a.in[10]; const float* w_up = a.in[11]; const float* w_dn = a.in[12]; const float* g_fin = a.in[13];
    unsigned char* ws = a.ws; float* out = a.out;
    bf16* Win_t = (bf16*)(ws + WS_WIN); bf16* Wa_t = (bf16*)(ws + WS_WA); bf16* Wb_t = (bf16*)(ws + WS_WB); bf16* Wout_t = (bf16*)(ws + WS_WOUT); bf16* Wup_t = (bf16*)(ws + WS_WUP); bf16* Wdn_t = (bf16*)(ws + WS_WDN);
    float* SSQ1 = (float*)(ws + WS_SSQ1); float* SSQ2 = (float*)(ws + WS_SSQ2);
    bf16* XN = (bf16*)(ws + WS_XN); bf16* OA = (bf16*)(ws + WS_OA); bf16* OB = (bf16*)(ws + WS_OB); bf16* X1B = (bf16*)(ws + WS_X1B);
    bf16* Zb = (bf16*)(ws + WS_Z); bf16* MRG = (bf16*)(ws + WS_MRG); bf16* Hb = (bf16*)(ws + WS_H); bf16* Gt = (bf16*)(ws + WS_G);
    bf16* OBG = (bf16*)((unsigned char*)out + DO_OBG); float* LSE = (float*)((unsigned char*)out + DO_LSE);
    grid.sync();
    const int gw = bx * 8 + wave, NGW = G * 8;
    unsigned* bar_ctr = (unsigned*)ws; unsigned bar_n = 0;
    const unsigned my_xcc = (unsigned)__builtin_amdgcn_s_getreg((3 << 11) | 20) & 0xFu;
    if (tid == 0) *(LAS unsigned*)(lds + RING_BYTES + 64) = __hip_atomic_fetch_add(bar_ctr + 512 + 64 * (my_xcc & 7u), 1u, __ATOMIC_RELAXED, __HIP_MEMORY_SCOPE_AGENT);

    for (int rep0 = 0; rep0 < REP_P0; ++rep0) {
        LAS float* scr = (LAS float*)(lds + wave * 16384);
        constexpr int I_IN = (DM / 64) * (NIN / 32), I_A = (512 / 64) * (DM / 32), I_B = (256 / 64) * (DM / 32), I_O = (DM / 64) * (DM / 32), I_U = (DM / 64) * (DFF / 32), I_D = (DFF / 64) * (DM / 32);
        constexpr int NIT = I_IN + I_A + I_B + I_O + I_U + I_D;
        for (int it = gw; it < NIT; it += NGW) {
            int r = it;
            if (r < I_IN) { p0_transpose_item_fp8(w_in, DM, NIN, (unsigned char*)Win_t, scr, r, lane, 32.f); continue; } r -= I_IN;
            if (r < I_A) { p0_transpose_item(w_a, 512, DM, Wa_t, nullptr, scr, r, lane, 1.f / 255.f, 768, 0); continue; }     r -= I_A;
            if (r < I_B) { p0_transpose_item(w_b, 256, DM, Wa_t, nullptr, scr, r, lane, 1.f / 255.f, 768, 512); continue; }     r -= I_B;
            if (r < I_O) { p0_transpose_item_fp8(w_out, DM, DM, (unsigned char*)Wout_t, scr, r, lane, 32.f); continue; } r -= I_O;
            if (r < I_U) { p0_transpose_item(w_up, DM, DFF, Wup_t, g_mlp, scr, r, lane); continue; } r -= I_U;
            p0_transpose_item(w_dn, DFF, DM, Wdn_t, nullptr, scr, r, lane);
        }
        f32x4 gv[4];
#pragma unroll
        for (int j = 0; j < 4; ++j) gv[j] = ((const f32x4*)g_mix)[lane + 64 * j];
        for (int m = gw; m < TT; m += 2 * NGW) {
            const int m2 = m + NGW; const bool has2 = m2 < TT;
            const float* xrow = (m < TP) ? x_p + (size_t)m * DM : x_s + (size_t)(m - TP) * DM;
            const float* xrow2 = has2 ? ((m2 < TP) ? x_p + (size_t)m2 * DM : x_s + (size_t)(m2 - TP) * DM) : xrow;
            const f32x4* xr = (const f32x4*)xrow + lane; const f32x4* xr2 = (const f32x4*)xrow2 + lane; f32x4 v[4], w2[4]; float s2 = 0.f, t2 = 0.f;
#pragma unroll
            for (int j = 0; j < 4; ++j) { v[j] = xr[64 * j]; w2[j] = xr2[64 * j]; }
#pragma unroll
            for (int j = 0; j < 4; ++j) { s2 += (v[j].x * v[j].x + v[j].y * v[j].y) + (v[j].z * v[j].z + v[j].w * v[j].w); t2 += (w2[j].x * w2[j].x + w2[j].y * w2[j].y) + (w2[j].z * w2[j].z + w2[j].w * w2[j].w); }
            const float rs = __builtin_amdgcn_rsqf(wave_sum(s2) * (1.f / DM) + RMS_EPS), rt = __builtin_amdgcn_rsqf(wave_sum(t2) * (1.f / DM) + RMS_EPS);
            unsigned* o8 = (unsigned*)((unsigned char*)XN + (size_t)m * DM) + lane;
#pragma unroll
            for (int j = 0; j < 4; ++j) o8[64 * j] = pk4_fp8(v[j].x * rs * gv[j].x, v[j].y * rs * gv[j].y, v[j].z * rs * gv[j].z, v[j].w * rs * gv[j].w);
            if (has2) { unsigned* p8 = (unsigned*)((unsigned char*)XN + (size_t)m2 * DM) + lane;
#pragma unroll
                for (int j = 0; j < 4; ++j) p8[64 * j] = pk4_fp8(w2[j].x * rt * gv[j].x, w2[j].y * rt * gv[j].y, w2[j].z * rt * gv[j].z, w2[j].w * rt * gv[j].w); }
        }
    }
    GSYNC();
    int vbx = bx;
    { LAS int* vslot = (LAS int*)(lds + RING_BYTES);
      if (threadIdx.x == 0) { const unsigned my_rank = *(LAS unsigned*)(lds + RING_BYTES + 64); bool ok = (G % 8 == 0) && (my_xcc < 8u);
          for (int j = 0; j < 8; ++j) ok = ok && (__hip_atomic_load(bar_ctr + 512 + 64 * j, __ATOMIC_RELAXED, __HIP_MEMORY_SCOPE_AGENT) == (unsigned)(G / 8));
          *vslot = ok ? (int)(my_rank * 8u + my_xcc) : bx; }
      __syncthreads(); vbx = __builtin_amdgcn_readfirstlane(*vslot); }
#ifndef NO_P1
#ifdef STAGGER
    if ((bx & 7) >= 4) { for (int z_ = 0; z_ < STAGGER; ++z_) __builtin_amdgcn_s_sleep(127); }
#endif
    for (int rep = 0; rep < REP_P1; ++rep) { pg8::Gemm g{XN, Win_t, TT, NIN, DM / 2, 0x7F7F7F7F}; pg8::StaticOrder S; S.init(TT, NIN, G, vbx); pg8::EpiIn E{Zb, Gt, b_gate};
      pg8::gemm_phase<pg8::EpiIn, pg8::StaticOrder, true, true, true>(lds, g, S, E); }
#endif
    GSYNC();
#ifndef NO_P2
    for (int rep = 0; rep < REP_P2; ++rep) att::attn_phase(lds, Zb, rel_bias, sink, OA, OBG, LSE, rep ? ABL_P2 : 0);
#endif
    GSYNC();
#ifndef NO_P2B
#ifdef EXTRA_BAR
    for (int e_ = 0; e_ < EXTRA_BAR; ++e_) GSYNC();
#endif
    for (int repb = 0; repb < REP_P2B; ++repb)
    for (unsigned idx = (unsigned)bx * 512u + (unsigned)threadIdx.x; idx < (unsigned)TT * 32u; idx += (unsigned)G * 512u) {
        const size_t tok = idx >> 5; const int part = (int)(idx & 31u), hh = part >> 3;
        const float l0 = LSE[tok * 4 + hh], l1 = LSE[((size_t)TT + tok) * 4 + hh], l2 = LSE[((size_t)2 * TT + tok) * 4 + hh];
        const float mx = fmaxf(l0, fmaxf(l1, l2)); float w0 = __builtin_amdgcn_exp2f(l0 - mx), w1 = __builtin_amdgcn_exp2f(l1 - mx), w2 = __builtin_amdgcn_exp2f(l2 - mx);
        const float inv = 1.f / (w0 + w1 + w2); w0 *= inv; w1 *= inv; w2 *= inv;
        const v4u a0 = *(const v4u*)(OBG + tok * 256 + part * 8), a1 = *(const v4u*)(OBG + ((size_t)TT + tok) * 256 + part * 8), a2 = *(const v4u*)(OBG + ((size_t)2 * TT + tok) * 256 + part * 8);
        v4u o;
        o.x = cvtpk(w0 * bf_lo(a0.x) + w1 * bf_lo(a1.x) + w2 * bf_lo(a2.x), w0 * bf_hi(a0.x) + w1 * bf_hi(a1.x) + w2 * bf_hi(a2.x));
        o.y = cvtpk(w0 * bf_lo(a0.y) + w1 * bf_lo(a1.y) + w2 * bf_lo(a2.y), w0 * bf_hi(a0.y) + w1 * bf_hi(a1.y) + w2 * bf_hi(a2.y));
        o.z = cvtpk(w0 * bf_lo(a0.z) + w1 * bf_lo(a1.z) + w2 * bf_lo(a2.z), w0 * bf_hi(a0.z) + w1 * bf_hi(a1.z) + w2 * bf_hi(a2.z));
        o.w = cvtpk(w0 * bf_lo(a0.w) + w1 * bf_lo(a1.w) + w2 * bf_lo(a2.w), w0 * bf_hi(a0.w) + w1 * bf_hi(a1.w) + w2 * bf_hi(a2.w));
        *(v4u*)(OA + tok * 768 + 512 + part * 8) = o;
    }
#endif
    GSYNC();
#ifndef NO_P3
    { pg8::Gemm g{OA, Wa_t, TT, DM, 768}; pg8::StaticOrder S; S.init(TT, DM, G, vbx); pg8::EpiGate2 E{MRG, (const unsigned char*)Gt};
      pg8::gemm_phase<pg8::EpiGate2, pg8::StaticOrder, true, true>(lds, g, S, E); }
#endif
    GSYNC();
#ifndef NO_P4
    for (int rep = 0; rep < REP_P4; ++rep) { pg8::Gemm g{MRG, Wout_t, TT, DM, DM / 2}; pg8::StaticOrder S; S.init(TT, DM, G, vbx); pg8::EpiRes<true> E{x_p, x_s, out, X1B, SSQ1, 1.f / 512.f};
      pg8::gemm_phase<pg8::EpiRes<true>, pg8::StaticOrder, true, true, true>(lds, g, S, E); }
#endif
    GSYNC();
#ifndef NO_P5
#ifdef STAGGER
    if ((bx & 7) >= 4) { for (int z_ = 0; z_ < STAGGER; ++z_) __builtin_amdgcn_s_sleep(127); }
#endif
    for (int rep = 0; rep < REP_P5; ++rep) { pg8::Gemm g{X1B, Wup_t, TT, DFF, DM}; pg8::StaticOrder S; S.init(TT, DFF, G, vbx); pg8::EpiUp E{Hb, SSQ1};
      pg8::gemm_phase<pg8::EpiUp, pg8::StaticOrder, true, true>(lds, g, S, E); }
#endif
    GSYNC();
#ifndef NO_P6
    { pg8::Gemm g{Hb, Wdn_t, TT, DM, DFF}; pg8::StaticOrder S; S.init(TT, DM, G, vbx); pg8::EpiFinal E{out, X1B, SSQ2, bar_ctr + 1024, g_fin};
      pg8::gemm_phase<pg8::EpiFinal, pg8::StaticOrder, true, true>(lds, g, S, E); }
#endif
}

extern "C" void kernel_launch(void* const* d_in, const int* in_sizes, int n_in, void* d_out, int out_size, void* d_ws, size_t ws_size, hipStream_t stream) {
    static int grid = 0;
    if (grid == 0) {
        if (n_in != 14 || ws_size < WS_END || out_size != TT * DM) { fprintf(stderr, "kernel_launch: unexpected shapes (n_in %d, ws %zu, out %d)\n", n_in, ws_size, out_size); grid = -1; return; }
        int dev = 0, cus = 0, per_cu = 0;
        hipGetDevice(&dev); hipDeviceGetAttribute(&cus, hipDeviceAttributeMultiprocessorCount, dev);
        if (hipFuncSetAttribute((const void*)mk_fwd, hipFuncAttributeMaxDynamicSharedMemorySize, LDS_BYTES) != hipSuccess) { fprintf(stderr, "kernel_launch: hipFuncSetAttribute failed\n"); grid = -1; return; }
        if (hipOccupancyMaxActiveBlocksPerMultiprocessor(&per_cu, (const void*)mk_fwd, 512, LDS_BYTES) != hipSuccess || per_cu < 1) { fprintf(stderr, "kernel_launch: occupancy query failed (%d)\n", per_cu); (void)hipGetLastError(); per_cu = 1; }
        grid = cus * per_cu;
        if (grid != 256) fprintf(stderr, "kernel_launch: grid %d != 256: the fused final-norm exchange assumes 256 workgroups (waits are bounded, results would be wrong)\n", grid);
    }
    if (grid < 0) return;
    if (hipMemsetAsync(d_ws, 0, 131072, stream) != hipSuccess) { fprintf(stderr, "kernel_launch: memset of the barrier words failed\n"); return; }
    Args a{};
    for (int i = 0; i < 14; ++i) a.in[i] = (const float*)d_in[i];
    a.out = (float*)d_out; a.ws = (unsigned char*)d_ws;
    void* args[] = {&a};
    hipError_t e = hipLaunchCooperativeKernel((const void*)mk_fwd, dim3(grid), dim3(512), args, LDS_BYTES, stream);
    if (e != hipSuccess) fprintf(stderr, "cooperative launch failed: %s (grid %d)\n", hipGetErrorString(e), grid);
}
```

```cpp
#include <hip/hip_runtime.h>
#include <hip/hip_cooperative_groups.h>
#include <cstdio>
#include <cstdint>
namespace cg = cooperative_groups;
namespace pg8 {
#define PG8_LAS __attribute__((address_space(3)))
typedef unsigned short bf16_t;
typedef short bf16x8 __attribute__((ext_vector_type(8)));
typedef float f32x4 __attribute__((ext_vector_type(4)));
typedef unsigned u32x4 __attribute__((ext_vector_type(4)));
constexpr int BM = 256, BK = 64, HALF = 128, HTB = HALF * BK * 2  , STAGE_BYTES = 8 * HTB, NXCD = 8, WGM = 8;

__host__ __device__ __forceinline__ int lds_byte(int r, int c) { const int st = (r >> 4) * 2 + (c >> 5), rr = r & 15, cc = c & 31, ob = rr * 64 + cc * 2; return st * 1024 + (ob ^ (((ob >> 9) & 1) << 5)); }
__host__ __device__ __forceinline__ void stage_rc(int b, int& R, int& C) { const int st = b / 1024, sb = b % 1024, swz = sb ^ (((sb >> 9) & 1) << 5); R = (st >> 1) * 16 + swz / 64; C = (st & 1) * 32 + (swz % 64) / 2; }
__host__ __device__ __forceinline__ int perm32(int rho) { const int n = rho >> 4, i = rho & 15; return 8 * (i >> 2) + 4 * n + (i & 3); }

struct Unit { int pm, pn; };
struct Gemm { const bf16_t* A; const bf16_t* Bt; int M, N, K; int scale_b = 0x7F7F7F7F; };

struct StaticOrder {
    int nM, nN, nwg, G, c;
    __host__ __device__ void init(int M, int N, int G_, int c_) { nM = M / BM; nN = N / BM; nwg = nM * nN; G = G_; c = c_; }
    __host__ __device__ bool next(int i, Unit& u) const {
        const long L = (long)i * G + c; if (L >= nwg) return false;
        int wgid = (int)L; { const int q = nwg / NXCD, r = nwg % NXCD, xcd = wgid % NXCD, off = wgid / NXCD; wgid = (xcd < r ? xcd * (q + 1) : r * (q + 1) + (xcd - r) * q) + off; }
        const int nig = WGM * nN, gid = wgid / nig, fm = gid * WGM, gsz = (nM - fm) < WGM ? (nM - fm) : WGM;
        u.pm = fm + ((wgid % nig) % gsz); u.pn = (wgid % nig) / gsz; return true;
    }
    __device__ __forceinline__ void a_ready(const Unit&) const {}
    __device__ __forceinline__ void done(const Unit&) const {}
};

typedef float f32x2c_t __attribute__((ext_vector_type(2))); typedef __bf16 bf16x2c_t __attribute__((ext_vector_type(2)));
__device__ __forceinline__ unsigned cvt_pk_bf16(float lo, float hi) { const f32x2c_t v = {lo, hi}; const bf16x2c_t b = __builtin_convertvector(v, bf16x2c_t); return __builtin_bit_cast(unsigned, b); }
typedef float f32x2 __attribute__((ext_vector_type(2)));
__device__ __forceinline__ f32x2 gelu_pk(f32x2 v) {
    const f32x2 av = __builtin_elementwise_abs(v), d = av * 0.2316418882f + 1.0f;
    f32x2 t; t.x = __builtin_amdgcn_rcpf(d.x); t.y = __builtin_amdgcn_rcpf(d.y);
    f32x2 q = t * 0.5307027145f + (-0.7265760135f); q = q * t + 0.7107068705f; q = q * t + (-0.142248368f); q = q * t + 0.127414796f; q = q * t;
    const f32x2 s = (v * v) * (-0.72134752044f);
    f32x2 e; e.x = __builtin_amdgcn_exp2f(s.x); e.y = __builtin_amdgcn_exp2f(s.y);
    const f32x2 m = v * (q * e), r = v - m;
    f32x2 o; o.x = v.x < 0.f ? m.x : r.x; o.y = v.y < 0.f ? m.y : r.y; return o;
}

template <int ACT  > struct EpiBf16 {
    static constexpr bool PERM = true, AFTER_DRAIN = false; static_assert(ACT == 0 || ACT == 1, "EpiBf16: ACT is 0 (none) or 1 (gelu_pk)");
    bf16_t* O; int ldc; const float* bias; int split_cols; size_t split_stride; float scale0;
    __device__ __forceinline__ void operator()(const f32x4 (&acc)[2][2][4][2], const Unit& u, int wr, int wc, int fr, int fq) const {
        const int row0 = u.pm * BM + wr * 64 + fr; int colt = u.pn * BM; bf16_t* base = O;
        float sc = 1.f; if (split_cols) { const int t = colt / split_cols; base += (size_t)t * split_stride; colt -= t * split_cols; if (t == 0) sc = scale0; }
        const int col0 = colt + wc * 32 + 8 * fq, bcol0 = u.pn * BM + wc * 32 + 8 * fq;
        f32x4 bv[2][2];
#pragma unroll
        for (int bj = 0; bj < 2; ++bj)
#pragma unroll
            for (int n = 0; n < 2; ++n) bv[bj][n] = bias ? *(const f32x4*)(bias + bcol0 + bj * HALF + 4 * n) : (f32x4){0.f, 0.f, 0.f, 0.f};
#pragma unroll
        for (int ai = 0; ai < 2; ++ai)
#pragma unroll
            for (int m = 0; m < 4; ++m) { bf16_t* rowp = base + (size_t)(row0 + ai * HALF + m * 16) * ldc + col0;
#pragma unroll
                for (int bj = 0; bj < 2; ++bj) { f32x4 v0 = acc[ai][bj][m][0] + bv[bj][0], v1 = acc[ai][bj][m][1] + bv[bj][1];
                    if (ACT == 1) { f32x2 a = gelu_pk((f32x2){v0[0], v0[1]}), b = gelu_pk((f32x2){v0[2], v0[3]}), c = gelu_pk((f32x2){v1[0], v1[1]}), d = gelu_pk((f32x2){v1[2], v1[3]});
                        v0 = (f32x4){a.x, a.y, b.x, b.y}; v1 = (f32x4){c.x, c.y, d.x, d.y}; }
                    v0 = v0 * sc; v1 = v1 * sc; u32x4 w; w.x = cvt_pk_bf16(v0[0], v0[1]); w.y = cvt_pk_bf16(v0[2], v0[3]); w.z = cvt_pk_bf16(v1[0], v1[1]); w.w = cvt_pk_bf16(v1[2], v1[3]);
                    *(u32x4*)(rowp + bj * HALF) = w; } }
    }
};
template <class Epi, class Sched, bool ALIGN_EPI = false, bool SP2 = false, bool FP8 = false>
__device__ __forceinline__ void gemm_phase(PG8_LAS unsigned char* lds, const Gemm g, const Sched& S, const Epi& E) {
    int tid_l = threadIdx.x; asm volatile("" : "+v"(tid_l));
    const int tid = tid_l, wid = __builtin_amdgcn_readfirstlane(tid >> 6), lane = tid & 63, wr = wid >> 2, wc = wid & 3, fr = lane & 15, fq = lane >> 4;
    const int K = g.K, nt = K / BK;
    unsigned voffA[2], voffB[2];
#pragma unroll
    for (int i = 0; i < 2; ++i) { int R, C; stage_rc(tid * 16 + i * 8192, R, C); const int Rb = Epi::PERM ? ((R & ~31) + perm32(R & 31)) : R;
        voffA[i] = (unsigned)(R * K + C) * 2u; voffB[i] = (unsigned)(Rb * K + C) * 2u; }
    const size_t kstep = (size_t)(BK * 2);
    const size_t hstep = (size_t)HALF * K * 2;
    const size_t tstep = 2 * hstep;
    const unsigned ldsw = (unsigned)wid * 1024u;
    const int aoff = lds_byte(wr * 64 + fr, fq * 8), boff = lds_byte(wc * 32 + fr, fq * 8);
#define PG8_SA(b, h) (((b) * 2 + (h)) * HTB)
#define PG8_SB(b, h) ((4 + (b) * 2 + (h)) * HTB)
#define PG8_STAGE(bufoff, gbase, voff) do { _Pragma("unroll") for (int _i = 0; _i < 2; ++_i) { unsigned vo_ = (voff)[_i]; if constexpr (FP8) asm volatile("" : "+v"(vo_)); \
        __builtin_amdgcn_global_load_lds((const unsigned*)((const char*)(gbase) + vo_), (PG8_LAS unsigned*)(lds + (bufoff) + ldsw + _i * 8192), 16, 0, 0); } } while (0)
#define PG8_LDA(dst, b, h) do { _Pragma("unroll") for (int m = 0; m < 4; ++m) _Pragma("unroll") for (int k = 0; k < 2; ++k) dst[m][k] = *(const PG8_LAS bf16x8*)(lds + PG8_SA(b, h) + aoff + m * 2048 + k * 1024); } while (0)
#define PG8_LDB(dst, b, h) do { _Pragma("unroll") for (int n = 0; n < 2; ++n) _Pragma("unroll") for (int k = 0; k < 2; ++k) dst[n][k] = *(const PG8_LAS bf16x8*)(lds + PG8_SB(b, h) + boff + n * 2048 + k * 1024); } while (0)
#define PG8_MMA(ai, bj, At, Bt) do { if constexpr (FP8) __builtin_amdgcn_sched_barrier(0); __builtin_amdgcn_s_setprio(1); _Pragma("unroll") for (int m = 0; m < 4; ++m) _Pragma("unroll") for (int n = 0; n < 2; ++n) { \
        if constexpr (FP8) { \
            const v4i_t b0_ = __builtin_bit_cast(v4i_t, Bt[n][0]), b1_ = __builtin_bit_cast(v4i_t, Bt[n][1]), a0_ = __builtin_bit_cast(v4i_t, At[m][0]), a1_ = __builtin_bit_cast(v4i_t, At[m][1]); \
            acc[ai][bj][m][n] = __builtin_amdgcn_mfma_scale_f32_16x16x128_f8f6f4(__builtin_shufflevector(b0_, b1_, 0, 1, 2, 3, 4, 5, 6, 7), __builtin_shufflevector(a0_, a1_, 0, 1, 2, 3, 4, 5, 6, 7), acc[ai][bj][m][n], 0, 0, 0, g.scale_b, 0, 0x7F7F7F7F); \
        } else { _Pragma("unroll") for (int k = 0; k < 2; ++k) acc[ai][bj][m][n] = __builtin_amdgcn_mfma_f32_16x16x32_bf16(Bt[n][k], At[m][k], acc[ai][bj][m][n], 0, 0, 0); } } \
        __builtin_amdgcn_s_setprio(0); if constexpr (FP8) __builtin_amdgcn_sched_barrier(0); } while (0)
#define PG8_WAIT_V(n) asm volatile("s_waitcnt vmcnt(" #n ")" ::: "memory")
#define PG8_WAIT_L(n) asm volatile("s_waitcnt lgkmcnt(" #n ")" ::: "memory")
#define PG8_BAR __builtin_amdgcn_s_barrier()
#define PG8_SCHED __builtin_amdgcn_sched_barrier(0)
    Unit cur, nxt; int ui = 0;
    if (!S.next(0, cur)) return;
    f32x4 acc[2][2][4][2];
#pragma unroll
    for (int a = 0; a < 2; ++a)
#pragma unroll
        for (int b = 0; b < 2; ++b)
#pragma unroll
            for (int m = 0; m < 4; ++m)
#pragma unroll
                for (int n = 0; n < 2; ++n) { acc[a][b][m][n] = (f32x4){0.f, 0.f, 0.f, 0.f}; if constexpr (FP8) asm volatile("" : "+v"(acc[a][b][m][n])); }
    bf16x8 At[4][2], B0[2][2], B1[2][2];
    typedef int v4i_t __attribute__((ext_vector_type(4))); typedef int v8i_t __attribute__((ext_vector_type(8)));
    const char* cA = (const char*)g.A + (size_t)cur.pm * tstep; const char* cB = (const char*)g.Bt + (size_t)cur.pn * tstep;
    S.a_ready(cur);
    if constexpr (SP2) {
        PG8_STAGE(PG8_SB(0, 0), cB, voffB); PG8_STAGE(PG8_SB(0, 1), cB + hstep, voffB); PG8_STAGE(PG8_SA(0, 0), cA, voffA); PG8_STAGE(PG8_SA(0, 1), cA + hstep, voffA);
        if (wr == 1) PG8_BAR;
        PG8_WAIT_V(2); PG8_BAR;
        PG8_STAGE(PG8_SB(1, 0), cB + kstep, voffB); PG8_STAGE(PG8_SA(1, 0), cA + kstep, voffA); PG8_STAGE(PG8_SB(1, 1), cB + hstep + kstep, voffB);
        PG8_WAIT_V(6); PG8_BAR;
    } else {
        PG8_STAGE(PG8_SB(0, 0), cB, voffB); PG8_STAGE(PG8_SA(0, 0), cA, voffA); PG8_STAGE(PG8_SB(0, 1), cB + hstep, voffB); PG8_STAGE(PG8_SA(0, 1), cA + hstep, voffA);
        if (wr == 1) PG8_BAR;
        PG8_WAIT_V(4); PG8_BAR;
        PG8_STAGE(PG8_SB(1, 0), cB + kstep, voffB); PG8_STAGE(PG8_SA(1, 0), cA + kstep, voffA); PG8_STAGE(PG8_SB(1, 1), cB + hstep + kstep, voffB);
        PG8_WAIT_V(6); PG8_BAR;
    }
    for (;;) {
        const bool has_next = S.next(ui + 1, nxt);
        const char* nA = has_next ? (const char*)g.A + (size_t)nxt.pm * tstep : cA; const char* nB = has_next ? (const char*)g.Bt + (size_t)nxt.pn * tstep : cB;
#pragma unroll 1
        for (int t = 0; t < nt; t += 2) {
            if constexpr (Epi::MID_T > 0) { if (t == Epi::MID_T) E.mid(acc, cur, wr, wc, fr, fq); }
            const bool last = (t == nt - 2);
            const char* a1 = cA + (size_t)(t + 1) * kstep;
            const char* a2 = last ? nA : cA + (size_t)(t + 2) * kstep; const char* b2 = last ? nB : cB + (size_t)(t + 2) * kstep;
            const char* a3 = a2 + kstep; const char* b3 = b2 + kstep;
            if (last && has_next) S.a_ready(nxt);
            if constexpr (SP2) {
            PG8_LDB(B0, 0, 0); PG8_LDB(B1, 0, 1); PG8_SCHED; PG8_LDA(At, 0, 0); PG8_STAGE(PG8_SA(1, 1), a1 + hstep, voffA);
            PG8_WAIT_V(8); PG8_WAIT_L(0); PG8_BAR; PG8_MMA(0, 0, At, B0); PG8_MMA(0, 1, At, B1); PG8_BAR; PG8_SCHED;
            PG8_LDA(At, 0, 1); PG8_STAGE(PG8_SB(0, 0), b2, voffB); PG8_STAGE(PG8_SB(0, 1), b2 + hstep, voffB); PG8_STAGE(PG8_SA(0, 0), a2, voffA);
            PG8_WAIT_V(8); PG8_WAIT_L(0); PG8_BAR; PG8_MMA(1, 0, At, B0); PG8_MMA(1, 1, At, B1); PG8_BAR; PG8_SCHED;
            PG8_LDB(B0, 1, 0); PG8_LDB(B1, 1, 1); PG8_SCHED; PG8_LDA(At, 1, 0); PG8_STAGE(PG8_SA(0, 1), a2 + hstep, voffA);
            PG8_WAIT_V(8); PG8_WAIT_L(0); PG8_BAR; PG8_MMA(0, 0, At, B0); PG8_MMA(0, 1, At, B1); PG8_BAR; PG8_SCHED;
            PG8_LDA(At, 1, 1); PG8_STAGE(PG8_SB(1, 0), b3, voffB); PG8_STAGE(PG8_SB(1, 1), b3 + hstep, voffB); PG8_STAGE(PG8_SA(1, 0), a3, voffA);
            PG8_WAIT_V(8); PG8_WAIT_L(0); PG8_BAR; PG8_MMA(1, 0, At, B0); PG8_MMA(1, 1, At, B1); PG8_BAR; PG8_SCHED;
            } else {
            PG8_LDB(B0, 0, 0); PG8_SCHED; PG8_LDA(At, 0, 0); PG8_STAGE(PG8_SA(1, 1), a1 + hstep, voffA);
            PG8_WAIT_L(8); PG8_BAR; PG8_WAIT_L(0); PG8_MMA(0, 0, At, B0); PG8_BAR; PG8_SCHED;
            PG8_LDB(B1, 0, 1); PG8_STAGE(PG8_SB(0, 0), b2, voffB);
            PG8_BAR; PG8_WAIT_L(0); PG8_MMA(0, 1, At, B1); PG8_BAR;
            PG8_LDA(At, 0, 1); PG8_STAGE(PG8_SA(0, 0), a2, voffA);
            PG8_BAR; PG8_WAIT_L(0); PG8_MMA(1, 0, At, B0); PG8_BAR; PG8_SCHED;
            PG8_STAGE(PG8_SB(0, 1), b2 + hstep, voffB);
            PG8_WAIT_V(6); PG8_BAR; PG8_MMA(1, 1, At, B1); PG8_BAR;
            PG8_LDB(B0, 1, 0); PG8_SCHED; PG8_LDA(At, 1, 0); PG8_STAGE(PG8_SA(0, 1), a2 + hstep, voffA);
            PG8_WAIT_L(8); PG8_BAR; PG8_WAIT_L(0); PG8_MMA(0, 0, At, B0); PG8_BAR; PG8_SCHED;
            PG8_LDB(B1, 1, 1); PG8_STAGE(PG8_SB(1, 0), b3, voffB);
            PG8_BAR; PG8_WAIT_L(0); PG8_MMA(0, 1, At, B1); PG8_BAR;
            PG8_LDA(At, 1, 1); PG8_STAGE(PG8_SA(1, 0), a3, voffA);
            PG8_BAR; PG8_WAIT_L(0); PG8_MMA(1, 0, At, B0); PG8_BAR; PG8_SCHED;
            PG8_STAGE(PG8_SB(1, 1), b3 + hstep, voffB);
            PG8_WAIT_V(6); PG8_BAR; PG8_MMA(1, 1, At, B1); PG8_BAR;
            }
        }
        if constexpr (ALIGN_EPI) { if (wr == 0) PG8_BAR; }
        if constexpr (!Epi::AFTER_DRAIN) { E(acc, cur, wr, wc, fr, fq); S.done(cur); }
        if (!has_next) break;
#pragma unroll
        for (int a = 0; a < 2; ++a)
#pragma unroll
            for (int b = 0; b < 2; ++b)
#pragma unroll
                for (int m = 0; m < 4; ++m)
#pragma unroll
                    for (int n = 0; n < 2; ++n) { acc[a][b][m][n] = (f32x4){0.f, 0.f, 0.f, 0.f}; if constexpr (FP8) asm volatile("" : "+v"(acc[a][b][m][n])); }
        cur = nxt; cA = nA; cB = nB; ++ui;
        if constexpr (ALIGN_EPI) { if (wr == 1) PG8_BAR; }
    }
    PG8_WAIT_V(0);
    if constexpr (!ALIGN_EPI) { if (wr == 0) PG8_BAR; }
    PG8_BAR;
    if constexpr (Epi::AFTER_DRAIN) { E.fused(acc, cur, wr, wc, fr, fq, lds, wid, lane); S.done(cur); }
#undef PG8_SA
#undef PG8_SB
#undef PG8_STAGE
#undef PG8_LDA
#undef PG8_LDB
#undef PG8_MMA
#undef PG8_WAIT_V
#undef PG8_WAIT_L
#undef PG8_BAR
#undef PG8_SCHED
}
}

constexpr int DM = 1024, TP = 8 * 2048, TSM = 8 * 8192, TT = TP + TSM;
constexpr int NIN = 5120, DFF = 4096, ZC = 3072, GC = 2048;
constexpr float RMS_EPS = 1e-6f, LOG2E = 1.4426950408889634f;
constexpr size_t MiB = 1u << 20;
constexpr size_t WS_WIN = 1 * MiB, WS_WA = 11 * MiB, WS_WB = 12 * MiB, WS_WOUT = 13 * MiB, WS_WUP = 15 * MiB, WS_WDN = 23 * MiB;
constexpr size_t WS_SSQ1 = 32 * MiB, WS_SSQ2 = 37 * MiB;
constexpr size_t WS_XN = 48 * MiB;
constexpr size_t WS_OA = WS_XN, WS_OB = WS_XN + 80 * MiB, WS_X1B = WS_XN;
constexpr size_t WS_Z = 208 * MiB;
constexpr size_t WS_MRG = WS_Z, WS_H = WS_Z;
constexpr size_t WS_G = 688 * MiB;
constexpr size_t WS_END = 1008 * MiB;
constexpr size_t DO_OBG = 0, DO_LSE = 120 * MiB;

constexpr int RING_BYTES = 131072, LDS_BYTES = 147456;

#define LAS __attribute__((address_space(3)))
typedef unsigned short bf16;
typedef unsigned v4u __attribute__((ext_vector_type(4)));
typedef unsigned v2u __attribute__((ext_vector_type(2)));
typedef float f32x4 __attribute__((ext_vector_type(4)));
typedef short bf16x8 __attribute__((ext_vector_type(8)));
typedef short s16x4 __attribute__((ext_vector_type(4)));

__device__ __forceinline__ unsigned cvtpk(float lo, float hi) { return pg8::cvt_pk_bf16(lo, hi); }
__device__ __forceinline__ float bf_lo(unsigned u) { return __builtin_bit_cast(float, u << 16); }
__device__ __forceinline__ float bf_hi(unsigned u) { return __builtin_bit_cast(float, u & 0xffff0000u); }

namespace pg8 {
typedef unsigned u32x2g __attribute__((ext_vector_type(2)));
__device__ __forceinline__ unsigned pk4_fp8g(float a, float b, float c, float d) { int r = __builtin_amdgcn_cvt_pk_fp8_f32(a, b, 0, false); r = __builtin_amdgcn_cvt_pk_fp8_f32(c, d, r, true); return (unsigned)r; }
struct EpiIn {
    static constexpr bool PERM = true, AFTER_DRAIN = false; static constexpr int MID_T = 0;
    bf16_t* Z; bf16_t* Gt; const float* bgate;
    __device__ __forceinline__ void operator()(const f32x4 (&acc)[2][2][4][2], const Unit& u, int wr, int wc, int fr, int fq) const {
        { int l_ = (int)(threadIdx.x & 63u); asm volatile("" : "+v"(l_)); fr = l_ & 15; fq = l_ >> 4; }
        const int row0 = u.pm * BM + wr * 64 + fr;
        const bool isg = u.pn >= 12;
        if (isg) {
            const int col0 = (u.pn - 12) * BM + wc * 32 + 8 * fq;
            f32x4 bv[2][2];
#pragma unroll
            for (int bj = 0; bj < 2; ++bj)
#pragma unroll
                for (int n = 0; n < 2; ++n) bv[bj][n] = *(const f32x4*)(bgate + col0 + bj * HALF + 4 * n);
#pragma unroll
            for (int ai = 0; ai < 2; ++ai)
#pragma unroll
                for (int m = 0; m < 4; ++m) { unsigned char* rowp = (unsigned char*)Gt + (size_t)(row0 + ai * HALF + m * 16) * GC + col0;
#pragma unroll
                    for (int bj = 0; bj < 2; ++bj) { f32x4 v0 = acc[ai][bj][m][0] * 0.03125f + bv[bj][0], v1 = acc[ai][bj][m][1] * 0.03125f + bv[bj][1];
                        unsigned q[8];
#pragma unroll
                        for (int e = 0; e < 4; ++e) { q[e] = (unsigned)__builtin_rintf(255.f * __builtin_amdgcn_rcpf(1.f + __builtin_amdgcn_exp2f(-LOG2E * v0[e]))); q[4 + e] = (unsigned)__builtin_rintf(255.f * __builtin_amdgcn_rcpf(1.f + __builtin_amdgcn_exp2f(-LOG2E * v1[e]))); }
                        u32x2g w; w.x = q[0] | (q[1] << 8) | (q[2] << 16) | (q[3] << 24); w.y = q[4] | (q[5] << 8) | (q[6] << 16) | (q[7] << 24);
                        *(u32x2g*)(rowp + bj * HALF) = w; } }
        } else {
            const int seqL = (u.pm * BM < TP) ? 2048 : 8192, lsh = (u.pm * BM < TP) ? 11 : 13;
#pragma unroll
            for (int bj = 0; bj < 2; ++bj) {
                const int hslot = (u.pn * BM + bj * HALF + wc * 32) >> 6; const int within = (wc & 1) * 32 + 8 * fq;
                int dsh = 0; if (hslot >= 12) { const int gi = ((hslot - 12) % 12) >> 2; dsh = gi == 0 ? 0 : (gi == 1 ? 2 : 4); }
                bf16_t* hb = Z + (size_t)hslot * TT * 64 + within;
#pragma unroll
                for (int ai = 0; ai < 2; ++ai)
#pragma unroll
                    for (int m = 0; m < 4; ++m) { const int r = row0 + ai * HALF + m * 16; const int rr = r - TP * (r >= TP ? 1 : 0); const int seq0 = r - (rr & (seqL - 1)); const int t = rr & (seqL - 1);
                        const int pos = seq0 + ((t & ((1 << dsh) - 1)) << (lsh - dsh)) + (t >> dsh);
                        const f32x4 v0 = acc[ai][bj][m][0] * 0.03125f, v1 = acc[ai][bj][m][1] * 0.03125f;
                        u32x4 w; w.x = cvt_pk_bf16(v0[0], v0[1]); w.y = cvt_pk_bf16(v0[2], v0[3]); w.z = cvt_pk_bf16(v1[0], v1[1]); w.w = cvt_pk_bf16(v1[2], v1[3]);
                        *(u32x4*)(hb + (size_t)pos * 64) = w; } }
        }
    }
};
struct EpiGate2 {
    static constexpr bool PERM = true, AFTER_DRAIN = false; static constexpr int MID_T = 4;
    bf16_t* O; const unsigned char* Gt;
    __device__ __forceinline__ void mid(f32x4 (&acc)[2][2][4][2], const Unit& u, int wr, int wc, int fr, int fq) const {
        asm volatile("" : "+v"(fr), "+v"(fq));
        const int row0 = u.pm * BM + wr * 64 + fr, col0 = u.pn * BM + wc * 32 + 8 * fq;
#pragma unroll
        for (int ai = 0; ai < 2; ++ai)
#pragma unroll
            for (int m = 0; m < 4; ++m) { const size_t r = (size_t)(row0 + ai * HALF + m * 16);
#pragma unroll
                for (int bj = 0; bj < 2; ++bj) {
                    const u32x2g a = *(const u32x2g*)(Gt + r * GC + col0 + bj * HALF), b = *(const u32x2g*)(Gt + r * GC + DM + col0 + bj * HALF);
                    f32x4 v0 = acc[ai][bj][m][0], v1 = acc[ai][bj][m][1];
#define G2R(aw, bw, sh) ((float)(((aw) >> (sh)) & 0xffu) * __builtin_amdgcn_rcpf(fmaxf((float)(((bw) >> (sh)) & 0xffu), 0.5f)))
                    v0[0] *= G2R(a.x, b.x, 0); v0[1] *= G2R(a.x, b.x, 8); v0[2] *= G2R(a.x, b.x, 16); v0[3] *= G2R(a.x, b.x, 24);
                    v1[0] *= G2R(a.y, b.y, 0); v1[1] *= G2R(a.y, b.y, 8); v1[2] *= G2R(a.y, b.y, 16); v1[3] *= G2R(a.y, b.y, 24);
#undef G2R
                    acc[ai][bj][m][0] = v0; acc[ai][bj][m][1] = v1; }
                asm volatile("" ::: "memory"); }
    }
    __device__ __forceinline__ void operator()(const f32x4 (&acc)[2][2][4][2], const Unit& u, int wr, int wc, int fr, int fq) const {
        asm volatile("" : "+v"(fr), "+v"(fq));
        const int row0 = u.pm * BM + wr * 64 + fr, col0 = u.pn * BM + wc * 32 + 8 * fq;
#pragma unroll
        for (int ai = 0; ai < 2; ++ai)
#pragma unroll
            for (int m = 0; m < 4; ++m) { const size_t r = (size_t)(row0 + ai * HALF + m * 16);
#pragma unroll
                for (int bj = 0; bj < 2; ++bj) {
                    const u32x2g b = *(const u32x2g*)(Gt + r * GC + DM + col0 + bj * HALF);
                    f32x4 v0 = acc[ai][bj][m][0], v1 = acc[ai][bj][m][1];
#define G2B(bw, sh) (fmaxf((float)(((bw) >> (sh)) & 0xffu), 0.5f) * (1.f / 2040.f))
                    v0[0] *= G2B(b.x, 0); v0[1] *= G2B(b.x, 8); v0[2] *= G2B(b.x, 16); v0[3] *= G2B(b.x, 24);
                    v1[0] *= G2B(b.y, 0); v1[1] *= G2B(b.y, 8); v1[2] *= G2B(b.y, 16); v1[3] *= G2B(b.y, 24);
#undef G2B
                    u32x2g w; w.x = pk4_fp8g(v0[0], v0[1], v0[2], v0[3]); w.y = pk4_fp8g(v1[0], v1[1], v1[2], v1[3]);
                    *(u32x2g*)((unsigned char*)O + r * DM + col0 + bj * HALF) = w; }
                asm volatile("" ::: "memory"); }
    }
};
template <bool WB> struct EpiRes {
    static constexpr bool PERM = true, AFTER_DRAIN = false; static constexpr int MID_T = 0;
    const float* xp; const float* xs;
    float* out; bf16_t* xb; float* ssq; float ascale;
    __device__ __forceinline__ void operator()(const f32x4 (&acc)[2][2][4][2], const Unit& u, int wr, int wc, int fr, int fq) const {
        { int l_ = (int)(threadIdx.x & 63u); asm volatile("" : "+v"(l_)); fr = l_ & 15; fq = l_ >> 4; }
        const int row0 = u.pm * BM + wr * 64 + fr, col0 = u.pn * BM + wc * 32 + 8 * fq;
        const float* xbase = (u.pm * BM < TP) ? xp : (xs - (size_t)TP * DM);
#pragma unroll
        for (int ai = 0; ai < 2; ++ai) {
            f32x4 xv[4][2][2];
#pragma unroll
            for (int m = 0; m < 4; ++m)
#pragma unroll
                for (int bj = 0; bj < 2; ++bj) { const size_t off = (size_t)(row0 + ai * HALF + m * 16) * DM + col0 + bj * HALF; xv[m][bj][0] = *(const f32x4*)(xbase + off); xv[m][bj][1] = *(const f32x4*)(xbase + off + 4); }
#pragma unroll
            for (int m = 0; m < 4; ++m) { const size_t r = (size_t)(row0 + ai * HALF + m * 16); float ss = 0.f;
#pragma unroll
                for (int bj = 0; bj < 2; ++bj) { const size_t off = r * DM + col0 + bj * HALF;
                    const f32x4 v0 = acc[ai][bj][m][0] * ascale + xv[m][bj][0], v1 = acc[ai][bj][m][1] * ascale + xv[m][bj][1];
                    if (!WB) { *(f32x4*)(out + off) = v0; *(f32x4*)(out + off + 4) = v1; }
                    if (WB) { u32x4 w; w.x = cvt_pk_bf16(v0[0], v0[1]); w.y = cvt_pk_bf16(v0[2], v0[3]); w.z = cvt_pk_bf16(v1[0], v1[1]); w.w = cvt_pk_bf16(v1[2], v1[3]); *(u32x4*)(xb + off) = w; }
                    ss += (v0[0] * v0[0] + v0[1] * v0[1]) + (v0[2] * v0[2] + v0[3] * v0[3]) + (v1[0] * v1[0] + v1[1] * v1[1]) + (v1[2] * v1[2] + v1[3] * v1[3]); }
                ss += __shfl_xor(ss, 16); ss += __shfl_xor(ss, 32);
                if (fq == 0) ssq[r * 16 + u.pn * 4 + wc] = ss; }
            asm volatile("" ::: "memory"); }
    }
};
struct EpiUp {
    static constexpr bool PERM = true, AFTER_DRAIN = false; static constexpr int MID_T = 0;
    bf16_t* O; const float* ssq;
    __device__ __forceinline__ void operator()(const f32x4 (&acc)[2][2][4][2], const Unit& u, int wr, int wc, int fr, int fq) const {
        const int row0 = u.pm * BM + wr * 64 + fr, col0 = u.pn * BM + wc * 32 + 8 * fq;
#pragma unroll
        for (int ai = 0; ai < 2; ++ai)
#pragma unroll
            for (int m = 0; m < 4; ++m) { const size_t r = (size_t)(row0 + ai * HALF + m * 16);
                const f32x4 pq = *(const f32x4*)(ssq + r * 16 + 4 * fq);
                float ss = (pq[0] + pq[1]) + (pq[2] + pq[3]); ss += __shfl_xor(ss, 16); ss += __shfl_xor(ss, 32);
                const float rs = __builtin_amdgcn_rsqf(ss * (1.f / DM) + RMS_EPS);
#pragma unroll
                for (int bj = 0; bj < 2; ++bj) { f32x4 v0 = acc[ai][bj][m][0] * rs, v1 = acc[ai][bj][m][1] * rs;
#pragma unroll
                    for (int e = 0; e < 4; ++e) { const float a = fmaxf(v0[e], 0.f), b = fmaxf(v1[e], 0.f); v0[e] = a * a; v1[e] = b * b; }
                    u32x4 w; w.x = cvt_pk_bf16(v0[0], v0[1]); w.y = cvt_pk_bf16(v0[2], v0[3]); w.z = cvt_pk_bf16(v1[0], v1[1]); w.w = cvt_pk_bf16(v1[2], v1[3]);
                    *(u32x4*)(O + r * DFF + col0 + bj * HALF) = w; } }
    }
};
struct EpiFinal {
    static constexpr bool PERM = true, AFTER_DRAIN = false; static constexpr int MID_T = 0;
    float* out; const bf16_t* xb; float* ssq; unsigned* cnt; const float* gfin;
    __device__ __forceinline__ void operator()(f32x4 (&acc)[2][2][4][2], const Unit& u, int wr, int wc, int fr, int fq) const {
        const int row0 = u.pm * BM + wr * 64 + fr, col0 = u.pn * BM + wc * 32 + 8 * fq;
#pragma unroll
        for (int ai = 0; ai < 2; ++ai) {
            u32x4 xv[4][2];
#pragma unroll
            for (int m = 0; m < 4; ++m)
#pragma unroll
                for (int bj = 0; bj < 2; ++bj) { const size_t off = (size_t)(row0 + ai * HALF + m * 16) * DM + col0 + bj * HALF; xv[m][bj] = *(const u32x4*)(xb + off); }
#pragma unroll
            for (int m = 0; m < 4; ++m) { const size_t r = (size_t)(row0 + ai * HALF + m * 16); float ss = 0.f;
#pragma unroll
                for (int bj = 0; bj < 2; ++bj) { const u32x4 xw = xv[m][bj];
                    const f32x4 x0 = {bf_lo(xw.x), bf_hi(xw.x), bf_lo(xw.y), bf_hi(xw.y)}, x1 = {bf_lo(xw.z), bf_hi(xw.z), bf_lo(xw.w), bf_hi(xw.w)};
                    const f32x4 v0 = acc[ai][bj][m][0] + x0, v1 = acc[ai][bj][m][1] + x1; acc[ai][bj][m][0] = v0; acc[ai][bj][m][1] = v1;
                    ss += (v0[0] * v0[0] + v0[1] * v0[1]) + (v0[2] * v0[2] + v0[3] * v0[3]) + (v1[0] * v1[0] + v1[1] * v1[1]) + (v1[2] * v1[2] + v1[3] * v1[3]); }
                ss += __shfl_xor(ss, 16); ss += __shfl_xor(ss, 32);
                if (fq == 0) __hip_atomic_store(ssq + r * 16 + u.pn * 4 + wc, ss, __ATOMIC_RELAXED, __HIP_MEMORY_SCOPE_AGENT); }
            asm volatile("" ::: "memory"); }
        asm volatile("s_waitcnt vmcnt(0)" ::: "memory");
        unsigned* pc = cnt + 64 * u.pm;
        if (fr == 0 && fq == 0) __hip_atomic_fetch_add(pc, 1u, __ATOMIC_RELAXED, __HIP_MEMORY_SCOPE_AGENT);
        unsigned seen;
        { unsigned spins = 0;
          while ((seen = (unsigned)__builtin_amdgcn_readfirstlane(__hip_atomic_load(pc, __ATOMIC_RELAXED, __HIP_MEMORY_SCOPE_AGENT))) < 32u) { __builtin_amdgcn_s_sleep(2); if (++spins > (1u << 22)) break; } }
        const unsigned dep0 = seen >> 31;
        f32x4 gv[2][2];
#pragma unroll
        for (int bj = 0; bj < 2; ++bj)
#pragma unroll
            for (int n = 0; n < 2; ++n) gv[bj][n] = *(const f32x4*)(gfin + col0 + bj * HALF + 4 * n);
#pragma unroll
        for (int ai = 0; ai < 2; ++ai)
#pragma unroll
            for (int m = 0; m < 4; ++m) { const size_t r = (size_t)(row0 + ai * HALF + m * 16);
                const float* pp = ssq + r * 16 + 4 * fq + dep0;
                const float q0 = __hip_atomic_load(pp + 0, __ATOMIC_RELAXED, __HIP_MEMORY_SCOPE_AGENT), q1 = __hip_atomic_load(pp + 1, __ATOMIC_RELAXED, __HIP_MEMORY_SCOPE_AGENT),
                            q2 = __hip_atomic_load(pp + 2, __ATOMIC_RELAXED, __HIP_MEMORY_SCOPE_AGENT), q3 = __hip_atomic_load(pp + 3, __ATOMIC_RELAXED, __HIP_MEMORY_SCOPE_AGENT);
                float tot = (q0 + q1) + (q2 + q3); tot += __shfl_xor(tot, 16); tot += __shfl_xor(tot, 32);
                const float rs = __builtin_amdgcn_rsqf(tot * (1.f / DM) + RMS_EPS);
#pragma unroll
                for (int bj = 0; bj < 2; ++bj) { const size_t off = r * DM + col0 + bj * HALF;
                    *(f32x4*)(out + off) = acc[ai][bj][m][0] * rs * gv[bj][0]; *(f32x4*)(out + off + 4) = acc[ai][bj][m][1] * rs * gv[bj][1]; } }
    }
};
}

__device__ __forceinline__ float wave_sum(float v) {
#pragma unroll
    for (int o = 1; o < 64; o <<= 1) v += __shfl_xor(v, o);
    return v;
}
__device__ __forceinline__ unsigned pk4_fp8(float a, float b, float c, float d) { int r = __builtin_amdgcn_cvt_pk_fp8_f32(a, b, 0, false); r = __builtin_amdgcn_cvt_pk_fp8_f32(c, d, r, true); return (unsigned)r; }
__device__ __forceinline__ void p0_transpose_item_fp8(const float* W, int K, int N, unsigned char* WT, LAS float* scr, int item, int lane, float sscale, int ld = 0, int koff = 0) {
    if (ld == 0) ld = K;
    const int nblk = N / 32, kb = item / nblk, nb = item % nblk, k0 = 64 * kb, n0 = 32 * nb;
#pragma unroll 8
    for (int i = 0; i < 32; ++i) { const int kk = 2 * i + (lane >> 5); scr[kk * 33 + (lane & 31)] = W[(size_t)(k0 + kk) * N + n0 + (lane & 31)] * sscale; }
    asm volatile("s_waitcnt lgkmcnt(0)" ::: "memory");
    const int c = lane & 7;
#pragma unroll
    for (int j = 0; j < 4; ++j) { const int n = (lane >> 3) + 8 * j; const LAS float* s = scr + (8 * c) * 33 + n;
        v2u o; o.x = pk4_fp8(s[0 * 33], s[1 * 33], s[2 * 33], s[3 * 33]); o.y = pk4_fp8(s[4 * 33], s[5 * 33], s[6 * 33], s[7 * 33]);
        *(v2u*)(WT + (size_t)(n0 + n) * ld + koff + k0 + 8 * c) = o; }
    asm volatile("s_waitcnt lgkmcnt(0)" ::: "memory");
}
__device__ __forceinline__ void p0_transpose_item(const float* W, int K, int N, bf16* WT, const float* kscale, LAS float* scr, int item, int lane, float sscale = 1.f, int ld = 0, int koff = 0) {
    if (ld == 0) ld = K;
    const int nblk = N / 32, kb = item / nblk, nb = item % nblk, k0 = 64 * kb, n0 = 32 * nb;
#pragma unroll 8
    for (int i = 0; i < 32; ++i) { const int kk = 2 * i + (lane >> 5); float v = W[(size_t)(k0 + kk) * N + n0 + (lane & 31)] * sscale; if (kscale) v *= kscale[k0 + kk]; scr[kk * 33 + (lane & 31)] = v; }
    asm volatile("s_waitcnt lgkmcnt(0)" ::: "memory");
    const int c = lane & 7;
#pragma unroll
    for (int j = 0; j < 4; ++j) { const int n = (lane >> 3) + 8 * j; const LAS float* s = scr + (8 * c) * 33 + n;
        v4u o; o.x = cvtpk(s[0 * 33], s[1 * 33]); o.y = cvtpk(s[2 * 33], s[3 * 33]); o.z = cvtpk(s[4 * 33], s[5 * 33]); o.w = cvtpk(s[6 * 33], s[7 * 33]);
        *(v4u*)(WT + (size_t)(n0 + n) * ld + koff + k0 + 8 * c) = o; }
    asm volatile("s_waitcnt lgkmcnt(0)" ::: "memory");
}

namespace att {
constexpr int KRS = 144, VRS = 160, NKS_MAX = 384, TBL = 640;
constexpr int L_K = 0, L_V = NKS_MAX * KRS, L_T = L_V + NKS_MAX * VRS, L_PM = L_T + 4 * TBL * 4, L_END = L_PM + 2 * NKS_MAX * 4;
static_assert(L_END <= RING_BYTES, "attention LDS");
constexpr int NITEM_A = (TT / 128) * 2, NITEM_B = (TT / 256) * 12;

__device__ __forceinline__ int rel_bucket(int rel) {
    const int n = rel < 0 ? -rel : rel; int b;
    if (n < 8) b = n; else if (n < 15) b = 8; else if (n < 27) b = 9; else if (n < 50) b = 10; else if (n < 91) b = 11; else if (n < 166) b = 12; else if (n < 305) b = 13; else if (n < 559) b = 14; else b = 15;
    return b + (rel > 0 ? 16 : 0);
}
__device__ __forceinline__ s16x4 vtr(LAS const unsigned char* p) { return __builtin_bit_cast(s16x4, __builtin_amdgcn_ds_read_tr16_b64_v4i16((LAS s16x4*)p)); }

template <int NCH, bool IS_A>
__device__ __forceinline__ void attn_task(LAS const unsigned char* ldsK, LAS const unsigned char* ldsV, LAS const float* tbl, LAS const float* pm, int kstart,
                                          bf16x8& qf0, bf16x8& qf1, const bf16* nq, bool has_nq, int qrel, float sink2, bf16* orow, float* lsep, int qi, int g, int abl = 0) {
    constexpr int NT = 2 * NCH;
    f32x4 s[NT];
    LAS const unsigned char* kp = ldsK + (kstart + qi) * KRS + g * 16;
    LAS const float* pmb = pm + (kstart + 4 * g);
    {
        bf16x8 ka[2][2][2]; f32x4 pz[2][2];
#pragma unroll
        for (int j = 0; j < 2; ++j) { ka[0][j][0] = *(LAS const bf16x8*)(kp + j * 16 * KRS); ka[0][j][1] = *(LAS const bf16x8*)(kp + j * 16 * KRS + 64); pz[0][j] = *(LAS const f32x4*)(pmb + 16 * j); }
#pragma unroll
        for (int tp = 0; tp < NT / 2; ++tp) { const int b = tp & 1;
            if (tp + 1 < NT / 2) {
#pragma unroll
                for (int j = 0; j < 2; ++j) { const int t = 2 * (tp + 1) + j; ka[b ^ 1][j][0] = *(LAS const bf16x8*)(kp + t * 16 * KRS); ka[b ^ 1][j][1] = *(LAS const bf16x8*)(kp + t * 16 * KRS + 64); pz[b ^ 1][j] = *(LAS const f32x4*)(pmb + 16 * t); } }
            __builtin_amdgcn_sched_barrier(0);
#pragma unroll
            for (int j = 0; j < 2; ++j) { f32x4 z = __builtin_amdgcn_mfma_f32_16x16x32_bf16(ka[b][j][0], qf0, pz[b][j], 0, 0, 0); s[2 * tp + j] = __builtin_amdgcn_mfma_f32_16x16x32_bf16(ka[b][j][1], qf1, z, 0, 0, 0); }
            __builtin_amdgcn_sched_barrier(0);
        }
    }
    if (has_nq) { qf0 = *(const bf16x8*)(nq + g * 8); qf1 = *(const bf16x8*)(nq + 32 + g * 8); }
    constexpr float C = 0.125f * LOG2E; const float NEG = -__builtin_inff();
    LAS const float* tb = tbl + (kstart + 4 * g - qrel + TBL / 2);
    float m = NEG;
    {
        float tv[2][8];
#pragma unroll
        for (int i = 0; i < 8; ++i) tv[0][i] = tb[16 * (i >> 2) + (i & 3)];
#pragma unroll
        for (int tp = 0; tp < NT / 2; ++tp) { const int b = tp & 1;
            if (tp + 1 < NT / 2) {
#pragma unroll
                for (int i = 0; i < 8; ++i) tv[b ^ 1][i] = tb[16 * (2 * (tp + 1) + (i >> 2)) + (i & 3)]; }
            __builtin_amdgcn_sched_barrier(0);
#pragma unroll
            for (int i = 0; i < 8; ++i) { const int t = 2 * tp + (i >> 2), r = i & 3; const float v = s[t][r] * C + tv[b][i]; s[t][r] = v; m = fmaxf(m, v); }
            __builtin_amdgcn_sched_barrier(0);
        }
    }
    m = fmaxf(m, __shfl_xor(m, 16)); m = fmaxf(m, __shfl_xor(m, 32));
    if (IS_A) m = fmaxf(m, sink2);
    float sum = 0.f;
#pragma unroll
    for (int t = 0; t < NT; ++t)
#pragma unroll
        for (int r = 0; r < 4; ++r) { const float p = __builtin_amdgcn_exp2f(s[t][r] - m); s[t][r] = p; sum += p; }
    sum += __shfl_xor(sum, 16); sum += __shfl_xor(sum, 32);
    if (IS_A) sum += __builtin_amdgcn_exp2f(sink2 - m);
    const float inv = __builtin_amdgcn_rcpf(sum);
    f32x4 o[4];
#pragma unroll
    for (int d = 0; d < 4; ++d) o[d] = (f32x4){0.f, 0.f, 0.f, 0.f};
    LAS const unsigned char* vp = ldsV + (kstart + 4 * g + (qi >> 2)) * VRS + (qi & 3) * 8;
    {
        s16x4 vl[2][4], vh[2][4];
#pragma unroll
        for (int d = 0; d < 4; ++d) { vl[0][d] = vtr(vp + d * 32); vh[0][d] = vtr(vp + 16 * VRS + d * 32); }
#pragma unroll
        for (int c = 0; c < NCH; ++c) { const int b = c & 1;
            if (c + 1 < NCH) {
#pragma unroll
                for (int d = 0; d < 4; ++d) { vl[b ^ 1][d] = vtr(vp + (32 * (c + 1)) * VRS + d * 32); vh[b ^ 1][d] = vtr(vp + (32 * (c + 1) + 16) * VRS + d * 32); } }
            v4u pw; pw.x = cvtpk(s[2 * c][0], s[2 * c][1]); pw.y = cvtpk(s[2 * c][2], s[2 * c][3]); pw.z = cvtpk(s[2 * c + 1][0], s[2 * c + 1][1]); pw.w = cvtpk(s[2 * c + 1][2], s[2 * c + 1][3]);
            const bf16x8 pb = __builtin_bit_cast(bf16x8, pw);
            __builtin_amdgcn_sched_barrier(0);
#pragma unroll
            for (int d = 0; d < 4; ++d) { const s16x4 lo = vl[b][d], hi = vh[b][d];
                const bf16x8 va = (bf16x8){lo[0], lo[1], lo[2], lo[3], hi[0], hi[1], hi[2], hi[3]};
                o[d] = __builtin_amdgcn_mfma_f32_16x16x32_bf16(va, pb, o[d], 0, 0, 0); }
            __builtin_amdgcn_sched_barrier(0);
        }
    }
    if (IS_A) { const float i8 = inv * 8.f;
#pragma unroll
        for (int d = 0; d < 4; ++d) *(unsigned*)((unsigned char*)orow + 16 * d + 4 * g) = pk4_fp8(o[d][0] * i8, o[d][1] * i8, o[d][2] * i8, o[d][3] * i8);
    } else {
#pragma unroll
        for (int d = 0; d < 4; ++d) { v2u w; w.x = cvtpk(o[d][0] * inv, o[d][1] * inv); w.y = cvtpk(o[d][2] * inv, o[d][3] * inv); if (!(abl & 1) || w.x == 0x12345678u) *(v2u*)(orow + 16 * d + 4 * g) = w; } }
    if (!IS_A) { if (g == 0 && !(abl & 1)) *lsep = m + __builtin_log2f(sum); }
}

struct Item { int isA, seq0, j0, Lr, Lre, dil, res, hs, pair;
    __device__ __forceinline__ int n() const { return isA ? 128 : 64; }
    __device__ __forceinline__ int nh() const { return isA ? 4 : 1; }
    __device__ __forceinline__ int kslot() const { return isA ? 8 + hs : 24 + hs; }
    __device__ __forceinline__ int vslot() const { return isA ? 10 + hs : 36 + hs; }
    __device__ __forceinline__ int qslot0() const { return isA ? hs * 4 : 12 + hs; }
    __device__ __forceinline__ int bcol0() const { return isA ? hs * 4 : 8 + hs; }
    __device__ __forceinline__ int key() const { return isA ? hs : 2 + hs; }
};
__device__ __forceinline__ Item decode(int k, int na0, int nA, int nb0) {
    Item I; int tok0;
    if (k < nA) { const int ia = na0 + k; I.isA = 1; I.hs = ia / (TT / 128); tok0 = (ia % (TT / 128)) * 128; I.dil = 1; }
    else { const int ib = nb0 + (k - nA); I.hs = ib / (TT / 256); I.isA = 0; const int gi = I.hs >> 2; tok0 = (ib % (TT / 256)) * 256; I.dil = gi == 0 ? 1 : (gi == 1 ? 4 : 16); }
    int L;
    if (tok0 < TP) { L = 2048; I.seq0 = (tok0 / 2048) * 2048; } else { L = 8192; I.seq0 = TP + ((tok0 - TP) / 8192) * 8192; }
    I.res = 0; I.j0 = tok0 - I.seq0; I.Lr = L; I.Lre = L; I.pair = 0;
    if (!I.isA) { I.Lr = L / I.dil; const int blk = (tok0 - I.seq0) / 256;
        if (I.Lr >= 256) { const int bpr = I.Lr / 256; I.res = blk / bpr; I.j0 = (blk % bpr) * 256; I.Lre = I.Lr; }
        else { I.res = 2 * blk; I.j0 = 0; I.Lre = 2 * I.Lr; I.pair = 1; } }
    return I;
}

__device__ __forceinline__ void attn_phase(LAS unsigned char* lds, const bf16* Z, const float* rel_bias, const float* sink, bf16* OA, bf16* OBG, float* LSE, int abl = 0) {
    int tid_l = threadIdx.x; asm volatile("" : "+v"(tid_l));
    const int tid = tid_l, lane = tid & 63, wave = __builtin_amdgcn_readfirstlane(tid >> 6), qi = lane & 15, g = lane >> 4;
    LAS unsigned char* ldsK = lds + L_K; LAS unsigned char* ldsV = lds + L_V; LAS float* tbl = (LAS float*)(lds + L_T); LAS float* pmt = (LAS float*)(lds + L_PM);
    const int G = gridDim.x, bx = blockIdx.x;
    const int na0 = (int)((long)bx * NITEM_A / G), nA = (int)((long)(bx + 1) * NITEM_A / G) - na0;
    const int nb0 = (int)((long)bx * NITEM_B / G), nB = (int)((long)(bx + 1) * NITEM_B / G) - nb0;
    const int nloc = nA + nB, r0 = tid >> 3, ch = tid & 7;
    v4u pk[6], pv[6];
#define ATT_ISSUE(I) do { _Pragma("unroll") for (int i_ = 0; i_ < 6; ++i_) { const int row_ = r0 + 64 * i_, kpos_ = (I).j0 - (I).n() + row_; pk[i_] = (v4u){0u, 0u, 0u, 0u}; pv[i_] = (v4u){0u, 0u, 0u, 0u}; \
        if ((unsigned)kpos_ < (unsigned)(I).Lre && !(abl & 2)) { const size_t ro_ = (size_t)((I).seq0 + (I).res * (I).Lr + kpos_) * 64 + ch * 8; pk[i_] = *(const v4u*)(Z + (size_t)(I).kslot() * TT * 64 + ro_); pv[i_] = *(const v4u*)(Z + (size_t)(I).vslot() * TT * 64 + ro_); } } } while (0)
    if (nloc <= 0) return;
    Item cur = decode(0, na0, nA, nb0), nxt = cur;
#define ATT_QT(I, i_) ((I).isA ? ((wave * 4 + (i_)) & 7) : (wave * 2 + (i_)))
#define ATT_QPTR(I, i_) (Z + ((size_t)((I).qslot0() + ((I).isA ? ((wave * 4 + (i_)) >> 3) : 0)) * TT + (I).seq0 + (I).res * (I).Lr + (I).j0 + 16 * ATT_QT(I, i_) + qi) * 64)
    bf16x8 q0, q1;
    { const bf16* qp = ATT_QPTR(cur, 0); q0 = *(const bf16x8*)(qp + g * 8); q1 = *(const bf16x8*)(qp + 32 + g * 8); }
    asm volatile("" ::: "memory");
    ATT_ISSUE(cur);
    int tkey = -1;
    for (int k = 0; k < nloc; ++k) {
        __syncthreads();
#pragma unroll
        for (int i = 0; i < 6; ++i) { const int row = r0 + 64 * i; *(LAS v4u*)(ldsK + row * KRS + ch * 16) = pk[i]; *(LAS v4u*)(ldsV + row * VRS + ch * 16) = pv[i];
            if (ch == 0) { const unsigned kp = (unsigned)(cur.j0 - cur.n() + row); const float ninf = -__builtin_inff();
                pmt[row] = (kp < (unsigned)(cur.pair ? cur.Lr : cur.Lre)) ? 0.f : ninf;
                pmt[NKS_MAX + row] = (cur.pair ? (kp - (unsigned)cur.Lr < (unsigned)cur.Lr) : (kp < (unsigned)cur.Lre)) ? 0.f : ninf; } }
        if (cur.key() != tkey) { tkey = cur.key();
            for (int i = tid; i < cur.nh() * TBL; i += 512) { const int h = i / TBL, rel = i % TBL - TBL / 2; const int ar = rel < 0 ? -rel : rel;
                tbl[i] = (ar <= cur.n()) ? rel_bias[rel_bucket(rel * cur.dil) * 20 + cur.bcol0() + h] * LOG2E : -__builtin_inff(); } }
        __syncthreads();
        const bool more = (k + 1 < nloc);
        if (more) { nxt = decode(k + 1, na0, nA, nb0); ATT_ISSUE(nxt); }
        asm volatile("" ::: "memory");
        const int ntask = cur.isA ? 4 : 2;
#ifdef ATT_DEPHASE
        if (wave >= 4) { if (cur.isA) __builtin_amdgcn_s_sleep(ATT_DEPHASE); else __builtin_amdgcn_s_sleep((ATT_DEPHASE * 5) / 8); }
#endif
#pragma unroll 1
        for (int i = 0; i < ntask; ++i) {
            const int qt = ATT_QT(cur, i); const bool lastt = (i + 1 == ntask);
            const bf16* nq = lastt ? ATT_QPTR(nxt, 0) : ATT_QPTR(cur, i + 1);
            const bool has_nq = !lastt || more;
            if (cur.isA) { const int h = (wave * 4 + i) >> 3, habs = cur.hs * 4 + h; const int qtok = cur.seq0 + cur.j0 + 16 * qt + qi; const int ks = qt < 6 ? 16 * qt : 96;
                attn_task<9, true>(ldsK, ldsV, tbl + h * TBL, pmt, ks, q0, q1, nq, has_nq, cur.n() + 16 * qt + qi, sink[habs] * LOG2E, (bf16*)((unsigned char*)OA + (size_t)qtok * 768 + habs * 64), nullptr, qi, g, abl);
            } else { const int jj = cur.j0 + 16 * qt + qi; const int jr = cur.pair ? (jj & (cur.Lr - 1)) : jj, rs = cur.res + (cur.pair ? (jj / cur.Lr) : 0);
                const int qtok = cur.seq0 + jr * cur.dil + rs; const int ks = qt < 14 ? 16 * qt : 224;
                attn_task<5, false>(ldsK, ldsV, tbl, pmt + (qt >> 3) * NKS_MAX, ks, q0, q1, nq, has_nq, cur.n() + 16 * qt + qi, 0.f, OBG + ((size_t)(cur.hs >> 2) * TT + qtok) * 256 + (cur.hs & 3) * 64, LSE + ((size_t)(cur.hs >> 2) * TT + qtok) * 4 + (cur.hs & 3), qi, g, abl);
            }
        }
        cur = nxt;
    }
    __syncthreads();
#undef ATT_ISSUE
#undef ATT_QPTR
#undef ATT_QT
}
}

#ifndef ABL_P2
#define ABL_P2 0
#endif
#ifndef REP_P0
#define REP_P0 1
#endif
#ifndef REP_P2B
#define REP_P2B 1
#endif
#ifndef REP_P3
#define REP_P3 1
#endif
#ifndef REP_P1
#define REP_P1 1
#endif
#ifndef REP_P2
#define REP_P2 1
#endif
#ifndef REP_P4
#define REP_P4 1
#endif
#ifndef REP_P5
#define REP_P5 1
#endif
__device__ __forceinline__ void grid_barrier(unsigned* ctr, unsigned target) {
    asm volatile("s_waitcnt vmcnt(0)" ::: "memory");
    __syncthreads();
    if (threadIdx.x == 0) {
        __builtin_amdgcn_fence(__ATOMIC_RELEASE, "agent");
        asm volatile("s_waitcnt vmcnt(0)" ::: "memory");
        __hip_atomic_fetch_add(ctr, 1u, __ATOMIC_RELAXED, __HIP_MEMORY_SCOPE_AGENT);
        unsigned spins = 0;
        while (__hip_atomic_load(ctr, __ATOMIC_RELAXED, __HIP_MEMORY_SCOPE_AGENT) < target) { __builtin_amdgcn_s_sleep(2); if (++spins > (1u << 24)) break; }
        __builtin_amdgcn_fence(__ATOMIC_ACQUIRE, "agent");
        asm volatile("s_waitcnt vmcnt(0)" ::: "memory");
    }
    __syncthreads();
}
#define GSYNC() do { ++bar_n; grid_barrier(bar_ctr, bar_n * (unsigned)G); } while (0)
struct Args { const float* in[14]; float* out; unsigned char* ws; };

__global__ void __launch_bounds__(512, 2) mk_fwd(Args a) {
    extern __shared__ __attribute__((aligned(16))) unsigned char lds_raw[];
    LAS unsigned char* lds = (LAS unsigned char*)lds_raw;
    cg::grid_group grid = cg::this_grid();
    const int tid = threadIdx.x, lane = tid & 63, wave = __builtin_amdgcn_readfirstlane(tid >> 6);
    const int G = gridDim.x, bx = blockIdx.x;
    const float* x_p = a.in[0]; const float* x_s = a.in[1]; const float* rel_bias = a.in[2]; const float* g_mix = a.in[3]; const float* w_in = a.in[4]; const float* b_gate = a.in[5];
    const float* w_a = a.in[6]; const float* w_b = a.in[7]; const float* w_out = a.in[8]; const float* sink = a.in[9]; const float* g_mlp = a.in[10]; const float* w_up = a.in[11]; const float* w_dn = a.in[12]; const float* g_fin = a.in[13];
    unsigned char* ws = a.ws; float* out = a.out;
    bf16* Win_t = (bf16*)(ws + WS_WIN); bf16* Wa_t = (bf16*)(ws + WS_WA); bf16* Wb_t = (bf16*)(ws + WS_WB); bf16* Wout_t = (bf16*)(ws + WS_WOUT); bf16* Wup_t = (bf16*)(ws + WS_WUP); bf16* Wdn_t = (bf16*)(ws + WS_WDN);
    float* SSQ1 = (float*)(ws + WS_SSQ1); float* SSQ2 = (float*)(ws + WS_SSQ2);
    bf16* XN = (bf16*)(ws + WS_XN); bf16* OA = (bf16*)(ws + WS_OA); bf16* OB = (bf16*)(ws + WS_OB); bf16* X1B = (bf16*)(ws + WS_X1B);
    bf16* Zb = (bf16*)(ws + WS_Z); bf16* MRG = (bf16*)(ws + WS_MRG); bf16* Hb = (bf16*)(ws + WS_H); bf16* Gt = (bf16*)(ws + WS_G);
    bf16* OBG = (bf16*)((unsigned char*)out + DO_OBG); float* LSE = (float*)((unsigned char*)out + DO_LSE);
    grid.sync();
    const int gw = bx * 8 + wave, NGW = G * 8;
    unsigned* bar_ctr = (unsigned*)ws; unsigned bar_n = 0;
    const unsigned my_xcc = (unsigned)__builtin_amdgcn_s_getreg((3 << 11) | 20) & 0xFu;
    if (tid == 0) *(LAS unsigned*)(lds + RING_BYTES + 64) = __hip_atomic_fetch_add(bar_ctr + 512 + 64 * (my_xcc & 7u), 1u, __ATOMIC_RELAXED, __HIP_MEMORY_SCOPE_AGENT);

    for (int rep0 = 0; rep0 < REP_P0; ++rep0) {
        LAS float* scr = (LAS float*)(lds + wave * 16384);
        constexpr int I_IN = (DM / 64) * (NIN / 32), I_A = (512 / 64) * (DM / 32), I_B = (256 / 64) * (DM / 32), I_O = (DM / 64) * (DM / 32), I_U = (DM / 64) * (DFF / 32), I_D = (DFF / 64) * (DM / 32);
        constexpr int NIT = I_IN + I_A + I_B + I_O + I_U + I_D;
        for (int it = gw; it < NIT; it += NGW) {
            int r = it;
            if (r < I_IN) { p0_transpose_item_fp8(w_in, DM, NIN, (unsigned char*)Win_t, scr, r, lane, 32.f); continue; } r -= I_IN;
            if (r < I_A) { p0_transpose_item_fp8(w_a, 512, DM, (unsigned char*)Wa_t, scr, r, lane, 16.f, 768, 0); continue; }     r -= I_A;
            if (r < I_B) { p0_transpose_item_fp8(w_b, 256, DM, (unsigned char*)Wa_t, scr, r, lane, 16.f, 768, 512); continue; }     r -= I_B;
            if (r < I_O) { p0_transpose_item_fp8(w_out, DM, DM, (unsigned char*)Wout_t, scr, r, lane, 32.f); continue; } r -= I_O;
            if (r < I_U) { p0_transpose_item(w_up, DM, DFF, Wup_t, g_mlp, scr, r, lane); continue; } r -= I_U;
            p0_transpose_item(w_dn, DFF, DM, Wdn_t, nullptr, scr, r, lane);
        }
        f32x4 gv[4];
#pragma unroll
        for (int j = 0; j < 4; ++j) gv[j] = ((const f32x4*)g_mix)[lane + 64 * j];
        for (int m = gw; m < TT; m += 2 * NGW) {
            const int m2 = m + NGW; const bool has2 = m2 < TT;
            const float* xrow = (m < TP) ? x_p + (size_t)m * DM : x_s + (size_t)(m - TP) * DM;
            const float* xrow2 = has2 ? ((m2 < TP) ? x_p + (size_t)m2 * DM : x_s + (size_t)(m2 - TP) * DM) : xrow;
            const f32x4* xr = (const f32x4*)xrow + lane; const f32x4* xr2 = (const f32x4*)xrow2 + lane; f32x4 v[4], w2[4]; float s2 = 0.f, t2 = 0.f;
#pragma unroll
            for (int j = 0; j < 4; ++j) { v[j] = xr[64 * j]; w2[j] = xr2[64 * j]; }
#pragma unroll
            for (int j = 0; j < 4; ++j) { s2 += (v[j].x * v[j].x + v[j].y * v[j].y) + (v[j].z * v[j].z + v[j].w * v[j].w); t2 += (w2[j].x * w2[j].x + w2[j].y * w2[j].y) + (w2[j].z * w2[j].z + w2[j].w * w2[j].w); }
            const float rs = __builtin_amdgcn_rsqf(wave_sum(s2) * (1.f / DM) + RMS_EPS), rt = __builtin_amdgcn_rsqf(wave_sum(t2) * (1.f / DM) + RMS_EPS);
            unsigned* o8 = (unsigned*)((unsigned char*)XN + (size_t)m * DM) + lane;
#pragma unroll
            for (int j = 0; j < 4; ++j) o8[64 * j] = pk4_fp8(v[j].x * rs * gv[j].x, v[j].y * rs * gv[j].y, v[j].z * rs * gv[j].z, v[j].w * rs * gv[j].w);
            if (has2) { unsigned* p8 = (unsigned*)((unsigned char*)XN + (size_t)m2 * DM) + lane;
#pragma unroll
                for (int j = 0; j < 4; ++j) p8[64 * j] = pk4_fp8(w2[j].x * rt * gv[j].x, w2[j].y * rt * gv[j].y, w2[j].z * rt * gv[j].z, w2[j].w * rt * gv[j].w); }
        }
    }
    GSYNC();
    int vbx = bx;
    { LAS int* vslot = (LAS int*)(lds + RING_BYTES);
      if (threadIdx.x == 0) { const unsigned my_rank = *(LAS unsigned*)(lds + RING_BYTES + 64); bool ok = (G % 8 == 0) && (my_xcc < 8u);
          for (int j = 0; j < 8; ++j) ok = ok && (__hip_atomic_load(bar_ctr + 512 + 64 * j, __ATOMIC_RELAXED, __HIP_MEMORY_SCOPE_AGENT) == (unsigned)(G / 8));
          *vslot = ok ? (int)(my_rank * 8u + my_xcc) : bx; }
      __syncthreads(); vbx = __builtin_amdgcn_readfirstlane(*vslot); }
#ifndef NO_P1
#ifdef STAGGER
    if ((bx & 7) >= 4) { for (int z_ = 0; z_ < STAGGER; ++z_) __builtin_amdgcn_s_sleep(127); }
#endif
    for (int rep = 0; rep < REP_P1; ++rep) { pg8::Gemm g{XN, Win_t, TT, NIN, DM / 2, 0x7F7F7F7F}; pg8::StaticOrder S; S.init(TT, NIN, G, vbx); pg8::EpiIn E{Zb, Gt, b_gate};
      pg8::gemm_phase<pg8::EpiIn, pg8::StaticOrder, true, true, true>(lds, g, S, E); }
#endif
    GSYNC();
#ifndef NO_P2
    for (int rep = 0; rep < REP_P2; ++rep) att::attn_phase(lds, Zb, rel_bias, sink, OA, OBG, LSE, rep ? ABL_P2 : 0);
#endif
    GSYNC();
#ifndef NO_P2B
#ifdef EXTRA_BAR
    for (int e_ = 0; e_ < EXTRA_BAR; ++e_) GSYNC();
#endif
    for (int repb = 0; repb < REP_P2B; ++repb)
    for (unsigned idx = (unsigned)bx * 512u + (unsigned)threadIdx.x; idx < (unsigned)TT * 32u; idx += (unsigned)G * 512u) {
        const size_t tok = idx >> 5; const int part = (int)(idx & 31u), hh = part >> 3;
        const float l0 = LSE[tok * 4 + hh], l1 = LSE[((size_t)TT + tok) * 4 + hh], l2 = LSE[((size_t)2 * TT + tok) * 4 + hh];
        const float mx = fmaxf(l0, fmaxf(l1, l2)); float w0 = __builtin_amdgcn_exp2f(l0 - mx), w1 = __builtin_amdgcn_exp2f(l1 - mx), w2 = __builtin_amdgcn_exp2f(l2 - mx);
        const float inv = 1.f / (w0 + w1 + w2); w0 *= inv; w1 *= inv; w2 *= inv;
        const v4u a0 = *(const v4u*)(OBG + tok * 256 + part * 8), a1 = *(const v4u*)(OBG + ((size_t)TT + tok) * 256 + part * 8), a2 = *(const v4u*)(OBG + ((size_t)2 * TT + tok) * 256 + part * 8);
        w0 *= 8.f; w1 *= 8.f; w2 *= 8.f;
        v2u o;
        o.x = pk4_fp8(w0 * bf_lo(a0.x) + w1 * bf_lo(a1.x) + w2 * bf_lo(a2.x), w0 * bf_hi(a0.x) + w1 * bf_hi(a1.x) + w2 * bf_hi(a2.x), w0 * bf_lo(a0.y) + w1 * bf_lo(a1.y) + w2 * bf_lo(a2.y), w0 * bf_hi(a0.y) + w1 * bf_hi(a1.y) + w2 * bf_hi(a2.y));
        o.y = pk4_fp8(w0 * bf_lo(a0.z) + w1 * bf_lo(a1.z) + w2 * bf_lo(a2.z), w0 * bf_hi(a0.z) + w1 * bf_hi(a1.z) + w2 * bf_hi(a2.z), w0 * bf_lo(a0.w) + w1 * bf_lo(a1.w) + w2 * bf_lo(a2.w), w0 * bf_hi(a0.w) + w1 * bf_hi(a1.w) + w2 * bf_hi(a2.w));
        *(v2u*)((unsigned char*)OA + tok * 768 + 512 + part * 8) = o;
    }
#endif
    GSYNC();
#ifndef NO_P3
    { pg8::Gemm g{OA, Wa_t, TT, DM, 768 / 2}; pg8::StaticOrder S; S.init(TT, DM, G, vbx); pg8::EpiGate2 E{MRG, (const unsigned char*)Gt};
      pg8::gemm_phase<pg8::EpiGate2, pg8::StaticOrder, true, true, true>(lds, g, S, E); }
#endif
    GSYNC();
#ifndef NO_P4
    for (int rep = 0; rep < REP_P4; ++rep) { pg8::Gemm g{MRG, Wout_t, TT, DM, DM / 2}; pg8::StaticOrder S; S.init(TT, DM, G, vbx); pg8::EpiRes<true> E{x_p, x_s, out, X1B, SSQ1, 1.f / 512.f};
      pg8::gemm_phase<pg8::EpiRes<true>, pg8::StaticOrder, true, true, true>(lds, g, S, E); }
#endif
    GSYNC();
#ifndef NO_P5
#ifdef STAGGER
    if ((bx & 7) >= 4) { for (int z_ = 0; z_ < STAGGER; ++z_) __builtin_amdgcn_s_sleep(127); }
#endif
    for (int rep = 0; rep < REP_P5; ++rep) { pg8::Gemm g{X1B, Wup_t, TT, DFF, DM}; pg8::StaticOrder S; S.init(TT, DFF, G, vbx); pg8::EpiUp E{Hb, SSQ1};
      pg8::gemm_phase<pg8::EpiUp, pg8::StaticOrder, true, true>(lds, g, S, E); }
#endif
    GSYNC();
#ifndef NO_P6
    { pg8::Gemm g{Hb, Wdn_t, TT, DM, DFF}; pg8::StaticOrder S; S.init(TT, DM, G, vbx); pg8::EpiFinal E{out, X1B, SSQ2, bar_ctr + 1024, g_fin};
      pg8::gemm_phase<pg8::EpiFinal, pg8::StaticOrder, true, true>(lds, g, S, E); }
#endif
}

extern "C" void kernel_launch(void* const* d_in, const int* in_sizes, int n_in, void* d_out, int out_size, void* d_ws, size_t ws_size, hipStream_t stream) {
    static int grid = 0;
    if (grid == 0) {
        if (n_in != 14 || ws_size < WS_END || out_size != TT * DM) { fprintf(stderr, "kernel_launch: unexpected shapes (n_in %d, ws %zu, out %d)\n", n_in, ws_size, out_size); grid = -1; return; }
        int dev = 0, cus = 0, per_cu = 0;
        hipGetDevice(&dev); hipDeviceGetAttribute(&cus, hipDeviceAttributeMultiprocessorCount, dev);
        if (hipFuncSetAttribute((const void*)mk_fwd, hipFuncAttributeMaxDynamicSharedMemorySize, LDS_BYTES) != hipSuccess) { fprintf(stderr, "kernel_launch: hipFuncSetAttribute failed\n"); grid = -1; return; }
        if (hipOccupancyMaxActiveBlocksPerMultiprocessor(&per_cu, (const void*)mk_fwd, 512, LDS_BYTES) != hipSuccess || per_cu < 1) { fprintf(stderr, "kernel_launch: occupancy query failed (%d)\n", per_cu); (void)hipGetLastError(); per_cu = 1; }
        grid = cus * per_cu;
        if (grid != 256) fprintf(stderr, "kernel_launch: grid %d != 256: the fused final-norm exchange assumes 256 workgroups (waits are bounded, results would be wrong)\n", grid);
    }
    if (grid < 0) return;
    if (hipMemsetAsync(d_ws, 0, 131072, stream) != hipSuccess) { fprintf(stderr, "kernel_launch: memset of the barrier words failed\n"); return; }
    Args a{};
    for (int i = 0; i < 14; ++i) a.in[i] = (const float*)d_in[i];
    a.out = (float*)d_out; a.ws = (unsigned char*)d_ws;
    void* args[] = {&a};
    hipError_t e = hipLaunchCooperativeKernel((const void*)mk_fwd, dim3(grid), dim3(512), args, LDS_BYTES, stream);
    if (e != hipSuccess) fprintf(stderr, "cooperative launch failed: %s (grid %d)\n", hipGetErrorString(e), grid);
}
```

```cpp
#include <hip/hip_runtime.h>
#include <hip/hip_cooperative_groups.h>
#include <cstdio>
#include <cstdint>
namespace cg = cooperative_groups;
namespace pg8 {
#define PG8_LAS __attribute__((address_space(3)))
typedef unsigned short bf16_t;
typedef short bf16x8 __attribute__((ext_vector_type(8)));
typedef float f32x4 __attribute__((ext_vector_type(4)));
typedef unsigned u32x4 __attribute__((ext_vector_type(4)));
constexpr int BM = 256, BK = 64, HALF = 128, HTB = HALF * BK * 2  , STAGE_BYTES = 8 * HTB, NXCD = 8, WGM = 8;

__host__ __device__ __forceinline__ int lds_byte(int r, int c) { const int st = (r >> 4) * 2 + (c >> 5), rr = r & 15, cc = c & 31, ob = rr * 64 + cc * 2; return st * 1024 + (ob ^ (((ob >> 9) & 1) << 5)); }
__host__ __device__ __forceinline__ void stage_rc(int b, int& R, int& C) { const int st = b / 1024, sb = b % 1024, swz = sb ^ (((sb >> 9) & 1) << 5); R = (st >> 1) * 16 + swz / 64; C = (st & 1) * 32 + (swz % 64) / 2; }
__host__ __device__ __forceinline__ int perm32(int rho) { const int n = rho >> 4, i = rho & 15; return 8 * (i >> 2) + 4 * n + (i & 3); }

struct Unit { int pm, pn; };
struct Gemm { const bf16_t* A; const bf16_t* Bt; int M, N, K; int scale_b = 0x7F7F7F7F; };

struct StaticOrder {
    int nM, nN, nwg, G, c;
    __host__ __device__ void init(int M, int N, int G_, int c_) { nM = M / BM; nN = N / BM; nwg = nM * nN; G = G_; c = c_; }
    __host__ __device__ bool next(int i, Unit& u) const {
        const long L = (long)i * G + c; if (L >= nwg) return false;
        int wgid = (int)L; { const int q = nwg / NXCD, r = nwg % NXCD, xcd = wgid % NXCD, off = wgid / NXCD; wgid = (xcd < r ? xcd * (q + 1) : r * (q + 1) + (xcd - r) * q) + off; }
        const int nig = WGM * nN, gid = wgid / nig, fm = gid * WGM, gsz = (nM - fm) < WGM ? (nM - fm) : WGM;
        u.pm = fm + ((wgid % nig) % gsz); u.pn = (wgid % nig) / gsz; return true;
    }
    __device__ __forceinline__ void a_ready(const Unit&) const {}
    __device__ __forceinline__ void done(const Unit&) const {}
};

typedef float f32x2c_t __attribute__((ext_vector_type(2))); typedef __bf16 bf16x2c_t __attribute__((ext_vector_type(2)));
__device__ __forceinline__ unsigned cvt_pk_bf16(float lo, float hi) { const f32x2c_t v = {lo, hi}; const bf16x2c_t b = __builtin_convertvector(v, bf16x2c_t); return __builtin_bit_cast(unsigned, b); }
typedef float f32x2 __attribute__((ext_vector_type(2)));
__device__ __forceinline__ f32x2 gelu_pk(f32x2 v) {
    const f32x2 av = __builtin_elementwise_abs(v), d = av * 0.2316418882f + 1.0f;
    f32x2 t; t.x = __builtin_amdgcn_rcpf(d.x); t.y = __builtin_amdgcn_rcpf(d.y);
    f32x2 q = t * 0.5307027145f + (-0.7265760135f); q = q * t + 0.7107068705f; q = q * t + (-0.142248368f); q = q * t + 0.127414796f; q = q * t;
    const f32x2 s = (v * v) * (-0.72134752044f);
    f32x2 e; e.x = __builtin_amdgcn_exp2f(s.x); e.y = __builtin_amdgcn_exp2f(s.y);
    const f32x2 m = v * (q * e), r = v - m;
    f32x2 o; o.x = v.x < 0.f ? m.x : r.x; o.y = v.y < 0.f ? m.y : r.y; return o;
}

template <int ACT  > struct EpiBf16 {
    static constexpr bool PERM = true, AFTER_DRAIN = false; static_assert(ACT == 0 || ACT == 1, "EpiBf16: ACT is 0 (none) or 1 (gelu_pk)");
    bf16_t* O; int ldc; const float* bias; int split_cols; size_t split_stride; float scale0;
    __device__ __forceinline__ void operator()(const f32x4 (&acc)[2][2][4][2], const Unit& u, int wr, int wc, int fr, int fq) const {
        const int row0 = u.pm * BM + wr * 64 + fr; int colt = u.pn * BM; bf16_t* base = O;
        float sc = 1.f; if (split_cols) { const int t = colt / split_cols; base += (size_t)t * split_stride; colt -= t * split_cols; if (t == 0) sc = scale0; }
        const int col0 = colt + wc * 32 + 8 * fq, bcol0 = u.pn * BM + wc * 32 + 8 * fq;
        f32x4 bv[2][2];
#pragma unroll
        for (int bj = 0; bj < 2; ++bj)
#pragma unroll
            for (int n = 0; n < 2; ++n) bv[bj][n] = bias ? *(const f32x4*)(bias + bcol0 + bj * HALF + 4 * n) : (f32x4){0.f, 0.f, 0.f, 0.f};
#pragma unroll
        for (int ai = 0; ai < 2; ++ai)
#pragma unroll
            for (int m = 0; m < 4; ++m) { bf16_t* rowp = base + (size_t)(row0 + ai * HALF + m * 16) * ldc + col0;
#pragma unroll
                for (int bj = 0; bj < 2; ++bj) { f32x4 v0 = acc[ai][bj][m][0] + bv[bj][0], v1 = acc[ai][bj][m][1] + bv[bj][1];
                    if (ACT == 1) { f32x2 a = gelu_pk((f32x2){v0[0], v0[1]}), b = gelu_pk((f32x2){v0[2], v0[3]}), c = gelu_pk((f32x2){v1[0], v1[1]}), d = gelu_pk((f32x2){v1[2], v1[3]});
                        v0 = (f32x4){a.x, a.y, b.x, b.y}; v1 = (f32x4){c.x, c.y, d.x, d.y}; }
                    v0 = v0 * sc; v1 = v1 * sc; u32x4 w; w.x = cvt_pk_bf16(v0[0], v0[1]); w.y = cvt_pk_bf16(v0[2], v0[3]); w.z = cvt_pk_bf16(v1[0], v1[1]); w.w = cvt_pk_bf16(v1[2], v1[3]);
                    *(u32x4*)(rowp + bj * HALF) = w; } }
    }
};
template <class Epi, class Sched, bool ALIGN_EPI = false, bool SP2 = false, bool FP8 = false>
__device__ __forceinline__ void gemm_phase(PG8_LAS unsigned char* lds, const Gemm g, const Sched& S, const Epi& E) {
    int tid_l = threadIdx.x; asm volatile("" : "+v"(tid_l));
    const int tid = tid_l, wid = __builtin_amdgcn_readfirstlane(tid >> 6), lane = tid & 63, wr = wid >> 2, wc = wid & 3, fr = lane & 15, fq = lane >> 4;
    const int K = g.K, nt = K / BK;
    unsigned voffA[2], voffB[2];
#pragma unroll
    for (int i = 0; i < 2; ++i) { int R, C; stage_rc(tid * 16 + i * 8192, R, C); const int Rb = Epi::PERM ? ((R & ~31) + perm32(R & 31)) : R;
        voffA[i] = (unsigned)(R * K + C) * 2u; voffB[i] = (unsigned)(Rb * K + C) * 2u; }
    const size_t kstep = (size_t)(BK * 2);
    const size_t hstep = (size_t)HALF * K * 2;
    const size_t tstep = 2 * hstep;
    const unsigned ldsw = (unsigned)wid * 1024u;
    const int aoff = lds_byte(wr * 64 + fr, fq * 8), boff = lds_byte(wc * 32 + fr, fq * 8);
#define PG8_SA(b, h) (((b) * 2 + (h)) * HTB)
#define PG8_SB(b, h) ((4 + (b) * 2 + (h)) * HTB)
#define PG8_STAGE(bufoff, gbase, voff) do { _Pragma("unroll") for (int _i = 0; _i < 2; ++_i) { unsigned vo_ = (voff)[_i]; if constexpr (FP8) asm volatile("" : "+v"(vo_)); \
        __builtin_amdgcn_global_load_lds((const unsigned*)((const char*)(gbase) + vo_), (PG8_LAS unsigned*)(lds + (bufoff) + ldsw + _i * 8192), 16, 0, 0); } } while (0)
#define PG8_LDA(dst, b, h) do { _Pragma("unroll") for (int m = 0; m < 4; ++m) _Pragma("unroll") for (int k = 0; k < 2; ++k) dst[m][k] = *(const PG8_LAS bf16x8*)(lds + PG8_SA(b, h) + aoff + m * 2048 + k * 1024); } while (0)
#define PG8_LDB(dst, b, h) do { _Pragma("unroll") for (int n = 0; n < 2; ++n) _Pragma("unroll") for (int k = 0; k < 2; ++k) dst[n][k] = *(const PG8_LAS bf16x8*)(lds + PG8_SB(b, h) + boff + n * 2048 + k * 1024); } while (0)
#define PG8_MMA(ai, bj, At, Bt) do { if constexpr (FP8) __builtin_amdgcn_sched_barrier(0); __builtin_amdgcn_s_setprio(1); _Pragma("unroll") for (int m = 0; m < 4; ++m) _Pragma("unroll") for (int n = 0; n < 2; ++n) { \
        if constexpr (FP8) { \
            const v4i_t b0_ = __builtin_bit_cast(v4i_t, Bt[n][0]), b1_ = __builtin_bit_cast(v4i_t, Bt[n][1]), a0_ = __builtin_bit_cast(v4i_t, At[m][0]), a1_ = __builtin_bit_cast(v4i_t, At[m][1]); \
            acc[ai][bj][m][n] = __builtin_amdgcn_mfma_scale_f32_16x16x128_f8f6f4(__builtin_shufflevector(b0_, b1_, 0, 1, 2, 3, 4, 5, 6, 7), __builtin_shufflevector(a0_, a1_, 0, 1, 2, 3, 4, 5, 6, 7), acc[ai][bj][m][n], 0, 0, 0, g.scale_b, 0, 0x7F7F7F7F); \
        } else { _Pragma("unroll") for (int k = 0; k < 2; ++k) acc[ai][bj][m][n] = __builtin_amdgcn_mfma_f32_16x16x32_bf16(Bt[n][k], At[m][k], acc[ai][bj][m][n], 0, 0, 0); } } \
        __builtin_amdgcn_s_setprio(0); if constexpr (FP8) __builtin_amdgcn_sched_barrier(0); } while (0)
#define PG8_WAIT_V(n) asm volatile("s_waitcnt vmcnt(" #n ")" ::: "memory")
#define PG8_WAIT_L(n) asm volatile("s_waitcnt lgkmcnt(" #n ")" ::: "memory")
#define PG8_BAR __builtin_amdgcn_s_barrier()
#define PG8_SCHED __builtin_amdgcn_sched_barrier(0)
    Unit cur, nxt; int ui = 0;
    if (!S.next(0, cur)) return;
    f32x4 acc[2][2][4][2];
#pragma unroll
    for (int a = 0; a < 2; ++a)
#pragma unroll
        for (int b = 0; b < 2; ++b)
#pragma unroll
            for (int m = 0; m < 4; ++m)
#pragma unroll
                for (int n = 0; n < 2; ++n) { acc[a][b][m][n] = (f32x4){0.f, 0.f, 0.f, 0.f}; if constexpr (FP8) asm volatile("" : "+v"(acc[a][b][m][n])); }
    bf16x8 At[4][2], B0[2][2], B1[2][2];
    typedef int v4i_t __attribute__((ext_vector_type(4))); typedef int v8i_t __attribute__((ext_vector_type(8)));
    const char* cA = (const char*)g.A + (size_t)cur.pm * tstep; const char* cB = (const char*)g.Bt + (size_t)cur.pn * tstep;
    S.a_ready(cur);
    if constexpr (SP2) {
        PG8_STAGE(PG8_SB(0, 0), cB, voffB); PG8_STAGE(PG8_SB(0, 1), cB + hstep, voffB); PG8_STAGE(PG8_SA(0, 0), cA, voffA); PG8_STAGE(PG8_SA(0, 1), cA + hstep, voffA);
        if (wr == 1) PG8_BAR;
        PG8_WAIT_V(2); PG8_BAR;
        PG8_STAGE(PG8_SB(1, 0), cB + kstep, voffB); PG8_STAGE(PG8_SA(1, 0), cA + kstep, voffA); PG8_STAGE(PG8_SB(1, 1), cB + hstep + kstep, voffB);
        PG8_WAIT_V(6); PG8_BAR;
    } else {
        PG8_STAGE(PG8_SB(0, 0), cB, voffB); PG8_STAGE(PG8_SA(0, 0), cA, voffA); PG8_STAGE(PG8_SB(0, 1), cB + hstep, voffB); PG8_STAGE(PG8_SA(0, 1), cA + hstep, voffA);
        if (wr == 1) PG8_BAR;
        PG8_WAIT_V(4); PG8_BAR;
        PG8_STAGE(PG8_SB(1, 0), cB + kstep, voffB); PG8_STAGE(PG8_SA(1, 0), cA + kstep, voffA); PG8_STAGE(PG8_SB(1, 1), cB + hstep + kstep, voffB);
        PG8_WAIT_V(6); PG8_BAR;
    }
    for (;;) {
        const bool has_next = S.next(ui + 1, nxt);
        const char* nA = has_next ? (const char*)g.A + (size_t)nxt.pm * tstep : cA; const char* nB = has_next ? (const char*)g.Bt + (size_t)nxt.pn * tstep : cB;
#pragma unroll 1
        for (int t = 0; t < nt; t += 2) {
            if constexpr (Epi::MID_T > 0) { if (t == Epi::MID_T) E.mid(acc, cur, wr, wc, fr, fq); }
            const bool last = (t == nt - 2);
            const char* a1 = cA + (size_t)(t + 1) * kstep;
            const char* a2 = last ? nA : cA + (size_t)(t + 2) * kstep; const char* b2 = last ? nB : cB + (size_t)(t + 2) * kstep;
            const char* a3 = a2 + kstep; const char* b3 = b2 + kstep;
            if (last && has_next) S.a_ready(nxt);
            if constexpr (SP2) {
            PG8_LDB(B0, 0, 0); PG8_LDB(B1, 0, 1); PG8_SCHED; PG8_LDA(At, 0, 0); PG8_STAGE(PG8_SA(1, 1), a1 + hstep, voffA);
            PG8_WAIT_V(8); PG8_WAIT_L(0); PG8_BAR; PG8_MMA(0, 0, At, B0); PG8_MMA(0, 1, At, B1); PG8_BAR; PG8_SCHED;
            PG8_LDA(At, 0, 1); PG8_STAGE(PG8_SB(0, 0), b2, voffB); PG8_STAGE(PG8_SB(0, 1), b2 + hstep, voffB); PG8_STAGE(PG8_SA(0, 0), a2, voffA);
            PG8_WAIT_V(8); PG8_WAIT_L(0); PG8_BAR; PG8_MMA(1, 0, At, B0); PG8_MMA(1, 1, At, B1); PG8_BAR; PG8_SCHED;
            PG8_LDB(B0, 1, 0); PG8_LDB(B1, 1, 1); PG8_SCHED; PG8_LDA(At, 1, 0); PG8_STAGE(PG8_SA(0, 1), a2 + hstep, voffA);
            PG8_WAIT_V(8); PG8_WAIT_L(0); PG8_BAR; PG8_MMA(0, 0, At, B0); PG8_MMA(0, 1, At, B1); PG8_BAR; PG8_SCHED;
            PG8_LDA(At, 1, 1); PG8_STAGE(PG8_SB(1, 0), b3, voffB); PG8_STAGE(PG8_SB(1, 1), b3 + hstep, voffB); PG8_STAGE(PG8_SA(1, 0), a3, voffA);
            PG8_WAIT_V(8); PG8_WAIT_L(0); PG8_BAR; PG8_MMA(1, 0, At, B0); PG8_MMA(1, 1, At, B1); PG8_BAR; PG8_SCHED;
            } else {
            PG8_LDB(B0, 0, 0); PG8_SCHED; PG8_LDA(At, 0, 0); PG8_STAGE(PG8_SA(1, 1), a1 + hstep, voffA);
            PG8_WAIT_L(8); PG8_BAR; PG8_WAIT_L(0); PG8_MMA(0, 0, At, B0); PG8_BAR; PG8_SCHED;
            PG8_LDB(B1, 0, 1); PG8_STAGE(PG8_SB(0, 0), b2, voffB);
            PG8_BAR; PG8_WAIT_L(0); PG8_MMA(0, 1, At, B1); PG8_BAR;
            PG8_LDA(At, 0, 1); PG8_STAGE(PG8_SA(0, 0), a2, voffA);
            PG8_BAR; PG8_WAIT_L(0); PG8_MMA(1, 0, At, B0); PG8_BAR; PG8_SCHED;
            PG8_STAGE(PG8_SB(0, 1), b2 + hstep, voffB);
            PG8_WAIT_V(6); PG8_BAR; PG8_MMA(1, 1, At, B1); PG8_BAR;
            PG8_LDB(B0, 1, 0); PG8_SCHED; PG8_LDA(At, 1, 0); PG8_STAGE(PG8_SA(0, 1), a2 + hstep, voffA);
            PG8_WAIT_L(8); PG8_BAR; PG8_WAIT_L(0); PG8_MMA(0, 0, At, B0); PG8_BAR; PG8_SCHED;
            PG8_LDB(B1, 1, 1); PG8_STAGE(PG8_SB(1, 0), b3, voffB);
            PG8_BAR; PG8_WAIT_L(0); PG8_MMA(0, 1, At, B1); PG8_BAR;
            PG8_LDA(At, 1, 1); PG8_STAGE(PG8_SA(1, 0), a3, voffA);
            PG8_BAR; PG8_WAIT_L(0); PG8_MMA(1, 0, At, B0); PG8_BAR; PG8_SCHED;
            PG8_STAGE(PG8_SB(1, 1), b3 + hstep, voffB);
            PG8_WAIT_V(6); PG8_BAR; PG8_MMA(1, 1, At, B1); PG8_BAR;
            }
        }
        if constexpr (ALIGN_EPI) { if (wr == 0) PG8_BAR; }
        if constexpr (!Epi::AFTER_DRAIN) { E(acc, cur, wr, wc, fr, fq); S.done(cur); }
        if (!has_next) break;
#pragma unroll
        for (int a = 0; a < 2; ++a)
#pragma unroll
            for (int b = 0; b < 2; ++b)
#pragma unroll
                for (int m = 0; m < 4; ++m)
#pragma unroll
                    for (int n = 0; n < 2; ++n) { acc[a][b][m][n] = (f32x4){0.f, 0.f, 0.f, 0.f}; if constexpr (FP8) asm volatile("" : "+v"(acc[a][b][m][n])); }
        cur = nxt; cA = nA; cB = nB; ++ui;
        if constexpr (ALIGN_EPI) { if (wr == 1) PG8_BAR; }
    }
    PG8_WAIT_V(0);
    if constexpr (!ALIGN_EPI) { if (wr == 0) PG8_BAR; }
    PG8_BAR;
    if constexpr (Epi::AFTER_DRAIN) { E.fused(acc, cur, wr, wc, fr, fq, lds, wid, lane); S.done(cur); }
#undef PG8_SA
#undef PG8_SB
#undef PG8_STAGE
#undef PG8_LDA
#undef PG8_LDB
#undef PG8_MMA
#undef PG8_WAIT_V
#undef PG8_WAIT_L
#undef PG8_BAR
#undef PG8_SCHED
}
}

constexpr int DM = 1024, TP = 8 * 2048, TSM = 8 * 8192, TT = TP + TSM;
constexpr int NIN = 5120, DFF = 4096, ZC = 3072, GC = 2048;
constexpr float RMS_EPS = 1e-6f, LOG2E = 1.4426950408889634f;
constexpr size_t MiB = 1u << 20;
constexpr size_t WS_WIN = 1 * MiB, WS_WA = 11 * MiB, WS_WB = 12 * MiB, WS_WOUT = 13 * MiB, WS_WUP = 15 * MiB, WS_WDN = 23 * MiB;
constexpr size_t WS_SSQ1 = 32 * MiB, WS_SSQ2 = 37 * MiB;
constexpr size_t WS_XN = 48 * MiB;
constexpr size_t WS_OA = WS_XN, WS_OB = WS_XN + 80 * MiB, WS_X1B = WS_XN;
constexpr size_t WS_Z = 208 * MiB;
constexpr size_t WS_MRG = WS_Z, WS_H = WS_Z;
constexpr size_t WS_G = 688 * MiB;
constexpr size_t WS_END = 1008 * MiB;
constexpr size_t DO_OBG = 0, DO_LSE = 120 * MiB;

constexpr int RING_BYTES = 131072, LDS_BYTES = 147456;

#define LAS __attribute__((address_space(3)))
typedef unsigned short bf16;
typedef unsigned v4u __attribute__((ext_vector_type(4)));
typedef unsigned v2u __attribute__((ext_vector_type(2)));
typedef float f32x4 __attribute__((ext_vector_type(4)));
typedef short bf16x8 __attribute__((ext_vector_type(8)));
typedef short s16x4 __attribute__((ext_vector_type(4)));

__device__ __forceinline__ unsigned cvtpk(float lo, float hi) { return pg8::cvt_pk_bf16(lo, hi); }
__device__ __forceinline__ float bf_lo(unsigned u) { return __builtin_bit_cast(float, u << 16); }
__device__ __forceinline__ float bf_hi(unsigned u) { return __builtin_bit_cast(float, u & 0xffff0000u); }

namespace pg8 {
typedef unsigned u32x2g __attribute__((ext_vector_type(2)));
__device__ __forceinline__ unsigned pk4_fp8g(float a, float b, float c, float d) { int r = __builtin_amdgcn_cvt_pk_fp8_f32(a, b, 0, false); r = __builtin_amdgcn_cvt_pk_fp8_f32(c, d, r, true); return (unsigned)r; }
struct EpiIn {
    static constexpr bool PERM = true, AFTER_DRAIN = false; static constexpr int MID_T = 0;
    bf16_t* Z; bf16_t* Gt; const float* bgate;
    __device__ __forceinline__ void operator()(const f32x4 (&acc)[2][2][4][2], const Unit& u, int wr, int wc, int fr, int fq) const {
        { int l_ = (int)(threadIdx.x & 63u); asm volatile("" : "+v"(l_)); fr = l_ & 15; fq = l_ >> 4; }
        const int row0 = u.pm * BM + wr * 64 + fr;
        const bool isg = u.pn >= 12;
        if (isg) {
            const int col0 = (u.pn - 12) * BM + wc * 32 + 8 * fq;
            f32x4 bv[2][2];
#pragma unroll
            for (int bj = 0; bj < 2; ++bj)
#pragma unroll
                for (int n = 0; n < 2; ++n) bv[bj][n] = *(const f32x4*)(bgate + col0 + bj * HALF + 4 * n);
#pragma unroll
            for (int ai = 0; ai < 2; ++ai)
#pragma unroll
                for (int m = 0; m < 4; ++m) { unsigned char* rowp = (unsigned char*)Gt + (size_t)(row0 + ai * HALF + m * 16) * GC + col0;
#pragma unroll
                    for (int bj = 0; bj < 2; ++bj) { f32x4 v0 = acc[ai][bj][m][0] * 0.03125f + bv[bj][0], v1 = acc[ai][bj][m][1] * 0.03125f + bv[bj][1];
                        unsigned q[8];
#pragma unroll
                        for (int e = 0; e < 4; ++e) { q[e] = (unsigned)__builtin_rintf(255.f * __builtin_amdgcn_rcpf(1.f + __builtin_amdgcn_exp2f(-LOG2E * v0[e]))); q[4 + e] = (unsigned)__builtin_rintf(255.f * __builtin_amdgcn_rcpf(1.f + __builtin_amdgcn_exp2f(-LOG2E * v1[e]))); }
                        u32x2g w; w.x = q[0] | (q[1] << 8) | (q[2] << 16) | (q[3] << 24); w.y = q[4] | (q[5] << 8) | (q[6] << 16) | (q[7] << 24);
                        *(u32x2g*)(rowp + bj * HALF) = w; } }
        } else {
            const int seqL = (u.pm * BM < TP) ? 2048 : 8192, lsh = (u.pm * BM < TP) ? 11 : 13;
#pragma unroll
            for (int bj = 0; bj < 2; ++bj) {
                const int hslot = (u.pn * BM + bj * HALF + wc * 32) >> 6; const int within = (wc & 1) * 32 + 8 * fq;
                int dsh = 0; if (hslot >= 12) { const int gi = ((hslot - 12) % 12) >> 2; dsh = gi == 0 ? 0 : (gi == 1 ? 2 : 4); }
                bf16_t* hb = Z + (size_t)hslot * TT * 64 + within;
#pragma unroll
                for (int ai = 0; ai < 2; ++ai)
#pragma unroll
                    for (int m = 0; m < 4; ++m) { const int r = row0 + ai * HALF + m * 16; const int rr = r - TP * (r >= TP ? 1 : 0); const int seq0 = r - (rr & (seqL - 1)); const int t = rr & (seqL - 1);
                        const int pos = seq0 + ((t & ((1 << dsh) - 1)) << (lsh - dsh)) + (t >> dsh);
                        const f32x4 v0 = acc[ai][bj][m][0] * 0.03125f, v1 = acc[ai][bj][m][1] * 0.03125f;
                        u32x4 w; w.x = cvt_pk_bf16(v0[0], v0[1]); w.y = cvt_pk_bf16(v0[2], v0[3]); w.z = cvt_pk_bf16(v1[0], v1[1]); w.w = cvt_pk_bf16(v1[2], v1[3]);
                        *(u32x4*)(hb + (size_t)pos * 64) = w; } }
        }
    }
};
struct EpiGate2 {
    static constexpr bool PERM = true, AFTER_DRAIN = false; static constexpr int MID_T = 4;
    bf16_t* O; const unsigned char* Gt;
    __device__ __forceinline__ void mid(f32x4 (&acc)[2][2][4][2], const Unit& u, int wr, int wc, int fr, int fq) const {
        asm volatile("" : "+v"(fr), "+v"(fq));
        const int row0 = u.pm * BM + wr * 64 + fr, col0 = u.pn * BM + wc * 32 + 8 * fq;
#pragma unroll
        for (int ai = 0; ai < 2; ++ai)
#pragma unroll
            for (int m = 0; m < 4; ++m) { const size_t r = (size_t)(row0 + ai * HALF + m * 16);
#pragma unroll
                for (int bj = 0; bj < 2; ++bj) {
                    const u32x2g a = *(const u32x2g*)(Gt + r * GC + col0 + bj * HALF), b = *(const u32x2g*)(Gt + r * GC + DM + col0 + bj * HALF);
                    f32x4 v0 = acc[ai][bj][m][0], v1 = acc[ai][bj][m][1];
#define G2R(aw, bw, sh) ((float)(((aw) >> (sh)) & 0xffu) * __builtin_amdgcn_rcpf(fmaxf((float)(((bw) >> (sh)) & 0xffu), 0.5f)))
                    v0[0] *= G2R(a.x, b.x, 0); v0[1] *= G2R(a.x, b.x, 8); v0[2] *= G2R(a.x, b.x, 16); v0[3] *= G2R(a.x, b.x, 24);
                    v1[0] *= G2R(a.y, b.y, 0); v1[1] *= G2R(a.y, b.y, 8); v1[2] *= G2R(a.y, b.y, 16); v1[3] *= G2R(a.y, b.y, 24);
#undef G2R
                    acc[ai][bj][m][0] = v0; acc[ai][bj][m][1] = v1; }
                asm volatile("" ::: "memory"); }
    }
    __device__ __forceinline__ void operator()(const f32x4 (&acc)[2][2][4][2], const Unit& u, int wr, int wc, int fr, int fq) const {
        asm volatile("" : "+v"(fr), "+v"(fq));
        const int row0 = u.pm * BM + wr * 64 + fr, col0 = u.pn * BM + wc * 32 + 8 * fq;
#pragma unroll
        for (int ai = 0; ai < 2; ++ai)
#pragma unroll
            for (int m = 0; m < 4; ++m) { const size_t r = (size_t)(row0 + ai * HALF + m * 16);
#pragma unroll
                for (int bj = 0; bj < 2; ++bj) {
                    const u32x2g b = *(const u32x2g*)(Gt + r * GC + DM + col0 + bj * HALF);
                    f32x4 v0 = acc[ai][bj][m][0], v1 = acc[ai][bj][m][1];
#define G2B(bw, sh) (fmaxf((float)(((bw) >> (sh)) & 0xffu), 0.5f) * (1.f / 2040.f))
                    v0[0] *= G2B(b.x, 0); v0[1] *= G2B(b.x, 8); v0[2] *= G2B(b.x, 16); v0[3] *= G2B(b.x, 24);
                    v1[0] *= G2B(b.y, 0); v1[1] *= G2B(b.y, 8); v1[2] *= G2B(b.y, 16); v1[3] *= G2B(b.y, 24);
#undef G2B
                    u32x2g w; w.x = pk4_fp8g(v0[0], v0[1], v0[2], v0[3]); w.y = pk4_fp8g(v1[0], v1[1], v1[2], v1[3]);
                    *(u32x2g*)((unsigned char*)O + r * DM + col0 + bj * HALF) = w; }
                asm volatile("" ::: "memory"); }
    }
};
template <bool WB> struct EpiRes {
    static constexpr bool PERM = true, AFTER_DRAIN = false; static constexpr int MID_T = 0;
    const float* xp; const float* xs;
    float* out; bf16_t* xb; float* ssq; float ascale;
    __device__ __forceinline__ void operator()(const f32x4 (&acc)[2][2][4][2], const Unit& u, int wr, int wc, int fr, int fq) const {
        { int l_ = (int)(threadIdx.x & 63u); asm volatile("" : "+v"(l_)); fr = l_ & 15; fq = l_ >> 4; }
        const int row0 = u.pm * BM + wr * 64 + fr, col0 = u.pn * BM + wc * 32 + 8 * fq;
        const float* xbase = (u.pm * BM < TP) ? xp : (xs - (size_t)TP * DM);
#pragma unroll
        for (int ai = 0; ai < 2; ++ai) {
            f32x4 xv[4][2][2];
#pragma unroll
            for (int m = 0; m < 4; ++m)
#pragma unroll
                for (int bj = 0; bj < 2; ++bj) { const size_t off = (size_t)(row0 + ai * HALF + m * 16) * DM + col0 + bj * HALF; xv[m][bj][0] = *(const f32x4*)(xbase + off); xv[m][bj][1] = *(const f32x4*)(xbase + off + 4); }
#pragma unroll
            for (int m = 0; m < 4; ++m) { const size_t r = (size_t)(row0 + ai * HALF + m * 16); float ss = 0.f;
#pragma unroll
                for (int bj = 0; bj < 2; ++bj) { const size_t off = r * DM + col0 + bj * HALF;
                    const f32x4 v0 = acc[ai][bj][m][0] * ascale + xv[m][bj][0], v1 = acc[ai][bj][m][1] * ascale + xv[m][bj][1];
                    if (!WB) { *(f32x4*)(out + off) = v0; *(f32x4*)(out + off + 4) = v1; }
                    if (WB) { u32x4 w; w.x = cvt_pk_bf16(v0[0], v0[1]); w.y = cvt_pk_bf16(v0[2], v0[3]); w.z = cvt_pk_bf16(v1[0], v1[1]); w.w = cvt_pk_bf16(v1[2], v1[3]); *(u32x4*)(xb + off) = w; }
                    ss += (v0[0] * v0[0] + v0[1] * v0[1]) + (v0[2] * v0[2] + v0[3] * v0[3]) + (v1[0] * v1[0] + v1[1] * v1[1]) + (v1[2] * v1[2] + v1[3] * v1[3]); }
                ss += __shfl_xor(ss, 16); ss += __shfl_xor(ss, 32);
                if (fq == 0) ssq[r * 16 + u.pn * 4 + wc] = ss; }
            asm volatile("" ::: "memory"); }
    }
};
struct EpiUp {
    static constexpr bool PERM = true, AFTER_DRAIN = false; static constexpr int MID_T = 0;
    bf16_t* O; const float* ssq;
    __device__ __forceinline__ void operator()(const f32x4 (&acc)[2][2][4][2], const Unit& u, int wr, int wc, int fr, int fq) const {
        const int row0 = u.pm * BM + wr * 64 + fr, col0 = u.pn * BM + wc * 32 + 8 * fq;
#pragma unroll
        for (int ai = 0; ai < 2; ++ai)
#pragma unroll
            for (int m = 0; m < 4; ++m) { const size_t r = (size_t)(row0 + ai * HALF + m * 16);
                const f32x4 pq = *(const f32x4*)(ssq + r * 16 + 4 * fq);
                float ss = (pq[0] + pq[1]) + (pq[2] + pq[3]); ss += __shfl_xor(ss, 16); ss += __shfl_xor(ss, 32);
                const float rs = __builtin_amdgcn_rsqf(ss * (1.f / DM) + RMS_EPS);
#pragma unroll
                for (int bj = 0; bj < 2; ++bj) { f32x4 v0 = acc[ai][bj][m][0] * rs, v1 = acc[ai][bj][m][1] * rs;
#pragma unroll
                    for (int e = 0; e < 4; ++e) { const float a = fmaxf(v0[e], 0.f), b = fmaxf(v1[e], 0.f); v0[e] = a * a; v1[e] = b * b; }
                    u32x4 w; w.x = cvt_pk_bf16(v0[0], v0[1]); w.y = cvt_pk_bf16(v0[2], v0[3]); w.z = cvt_pk_bf16(v1[0], v1[1]); w.w = cvt_pk_bf16(v1[2], v1[3]);
                    *(u32x4*)(O + r * DFF + col0 + bj * HALF) = w; } }
    }
};
struct EpiFinal {
    static constexpr bool PERM = true, AFTER_DRAIN = false; static constexpr int MID_T = 0;
    float* out; const bf16_t* xb; float* ssq; unsigned* cnt; const float* gfin;
    __device__ __forceinline__ void operator()(f32x4 (&acc)[2][2][4][2], const Unit& u, int wr, int wc, int fr, int fq) const {
        const int row0 = u.pm * BM + wr * 64 + fr, col0 = u.pn * BM + wc * 32 + 8 * fq;
#pragma unroll
        for (int ai = 0; ai < 2; ++ai) {
            u32x4 xv[4][2];
#pragma unroll
            for (int m = 0; m < 4; ++m)
#pragma unroll
                for (int bj = 0; bj < 2; ++bj) { const size_t off = (size_t)(row0 + ai * HALF + m * 16) * DM + col0 + bj * HALF; xv[m][bj] = *(const u32x4*)(xb + off); }
#pragma unroll
            for (int m = 0; m < 4; ++m) { const size_t r = (size_t)(row0 + ai * HALF + m * 16); float ss = 0.f;
#pragma unroll
                for (int bj = 0; bj < 2; ++bj) { const u32x4 xw = xv[m][bj];
                    const f32x4 x0 = {bf_lo(xw.x), bf_hi(xw.x), bf_lo(xw.y), bf_hi(xw.y)}, x1 = {bf_lo(xw.z), bf_hi(xw.z), bf_lo(xw.w), bf_hi(xw.w)};
                    const f32x4 v0 = acc[ai][bj][m][0] + x0, v1 = acc[ai][bj][m][1] + x1; acc[ai][bj][m][0] = v0; acc[ai][bj][m][1] = v1;
                    ss += (v0[0] * v0[0] + v0[1] * v0[1]) + (v0[2] * v0[2] + v0[3] * v0[3]) + (v1[0] * v1[0] + v1[1] * v1[1]) + (v1[2] * v1[2] + v1[3] * v1[3]); }
                ss += __shfl_xor(ss, 16); ss += __shfl_xor(ss, 32);
                if (fq == 0) __hip_atomic_store(ssq + r * 16 + u.pn * 4 + wc, ss, __ATOMIC_RELAXED, __HIP_MEMORY_SCOPE_AGENT); }
            asm volatile("" ::: "memory"); }
        asm volatile("s_waitcnt vmcnt(0)" ::: "memory");
        unsigned* pc = cnt + 64 * u.pm;
        if (fr == 0 && fq == 0) __hip_atomic_fetch_add(pc, 1u, __ATOMIC_RELAXED, __HIP_MEMORY_SCOPE_AGENT);
        unsigned seen;
        { unsigned spins = 0;
          while ((seen = (unsigned)__builtin_amdgcn_readfirstlane(__hip_atomic_load(pc, __ATOMIC_RELAXED, __HIP_MEMORY_SCOPE_AGENT))) < 32u) { __builtin_amdgcn_s_sleep(2); if (++spins > (1u << 22)) break; } }
        const unsigned dep0 = seen >> 31;
        f32x4 gv[2][2];
#pragma unroll
        for (int bj = 0; bj < 2; ++bj)
#pragma unroll
            for (int n = 0; n < 2; ++n) gv[bj][n] = *(const f32x4*)(gfin + col0 + bj * HALF + 4 * n);
#pragma unroll
        for (int ai = 0; ai < 2; ++ai)
#pragma unroll
            for (int m = 0; m < 4; ++m) { const size_t r = (size_t)(row0 + ai * HALF + m * 16);
                const float* pp = ssq + r * 16 + 4 * fq + dep0;
                const float q0 = __hip_atomic_load(pp + 0, __ATOMIC_RELAXED, __HIP_MEMORY_SCOPE_AGENT), q1 = __hip_atomic_load(pp + 1, __ATOMIC_RELAXED, __HIP_MEMORY_SCOPE_AGENT),
                            q2 = __hip_atomic_load(pp + 2, __ATOMIC_RELAXED, __HIP_MEMORY_SCOPE_AGENT), q3 = __hip_atomic_load(pp + 3, __ATOMIC_RELAXED, __HIP_MEMORY_SCOPE_AGENT);
                float tot = (q0 + q1) + (q2 + q3); tot += __shfl_xor(tot, 16); tot += __shfl_xor(tot, 32);
                const float rs = __builtin_amdgcn_rsqf(tot * (1.f / DM) + RMS_EPS);
#pragma unroll
                for (int bj = 0; bj < 2; ++bj) { const size_t off = r * DM + col0 + bj * HALF;
                    *(f32x4*)(out + off) = acc[ai][bj][m][0] * rs * gv[bj][0]; *(f32x4*)(out + off + 4) = acc[ai][bj][m][1] * rs * gv[bj][1]; } }
    }
};
}

__device__ __forceinline__ float wave_sum(float v) {
#pragma unroll
    for (int o = 1; o < 64; o <<= 1) v += __shfl_xor(v, o);
    return v;
}
__device__ __forceinline__ unsigned pk4_fp8(float a, float b, float c, float d) { int r = __builtin_amdgcn_cvt_pk_fp8_f32(a, b, 0, false); r = __builtin_amdgcn_cvt_pk_fp8_f32(c, d, r, true); return (unsigned)r; }
__device__ __forceinline__ void p0_transpose_item_fp8(const float* W, int K, int N, unsigned char* WT, LAS float* scr, int item, int lane, float sscale, int ld = 0, int koff = 0) {
    if (ld == 0) ld = K;
    const int nblk = N / 32, kb = item / nblk, nb = item % nblk, k0 = 64 * kb, n0 = 32 * nb;
#pragma unroll
    for (int i = 0; i < 8; ++i) { const int kk = 8 * i + (lane >> 3), c4 = lane & 7;
        const f32x4 v = *(const f32x4*)(W + (size_t)(k0 + kk) * N + n0 + 4 * c4) * sscale;
        LAS float* d = scr + kk * 33 + 4 * c4; d[0] = v[0]; d[1] = v[1]; d[2] = v[2]; d[3] = v[3]; }
    asm volatile("s_waitcnt lgkmcnt(0)" ::: "memory");
    const int c = lane & 7;
#pragma unroll
    for (int j = 0; j < 4; ++j) { const int n = (lane >> 3) + 8 * j; const LAS float* s = scr + (8 * c) * 33 + n;
        v2u o; o.x = pk4_fp8(s[0 * 33], s[1 * 33], s[2 * 33], s[3 * 33]); o.y = pk4_fp8(s[4 * 33], s[5 * 33], s[6 * 33], s[7 * 33]);
        *(v2u*)(WT + (size_t)(n0 + n) * ld + koff + k0 + 8 * c) = o; }
    asm volatile("s_waitcnt lgkmcnt(0)" ::: "memory");
}
__device__ __forceinline__ void p0_transpose_item(const float* W, int K, int N, bf16* WT, const float* kscale, LAS float* scr, int item, int lane, float sscale = 1.f, int ld = 0, int koff = 0) {
    if (ld == 0) ld = K;
    const int nblk = N / 32, kb = item / nblk, nb = item % nblk, k0 = 64 * kb, n0 = 32 * nb;
#pragma unroll
    for (int i = 0; i < 8; ++i) { const int kk = 8 * i + (lane >> 3), c4 = lane & 7;
        f32x4 v = *(const f32x4*)(W + (size_t)(k0 + kk) * N + n0 + 4 * c4) * sscale; if (kscale) v = v * kscale[k0 + kk];
        LAS float* d = scr + kk * 33 + 4 * c4; d[0] = v[0]; d[1] = v[1]; d[2] = v[2]; d[3] = v[3]; }
    asm volatile("s_waitcnt lgkmcnt(0)" ::: "memory");
    const int c = lane & 7;
#pragma unroll
    for (int j = 0; j < 4; ++j) { const int n = (lane >> 3) + 8 * j; const LAS float* s = scr + (8 * c) * 33 + n;
        v4u o; o.x = cvtpk(s[0 * 33], s[1 * 33]); o.y = cvtpk(s[2 * 33], s[3 * 33]); o.z = cvtpk(s[4 * 33], s[5 * 33]); o.w = cvtpk(s[6 * 33], s[7 * 33]);
        *(v4u*)(WT + (size_t)(n0 + n) * ld + koff + k0 + 8 * c) = o; }
    asm volatile("s_waitcnt lgkmcnt(0)" ::: "memory");
}

namespace att {
constexpr int KRS = 144, VRS = 160, NKS_MAX = 384, TBL = 640;
constexpr int L_K = 0, L_V = NKS_MAX * KRS, L_T = L_V + NKS_MAX * VRS, L_PM = L_T + 4 * TBL * 4, L_END = L_PM + 2 * NKS_MAX * 4;
static_assert(L_END <= RING_BYTES, "attention LDS");
constexpr int NITEM_A = (TT / 128) * 2, NITEM_B = (TT / 256) * 12;

__device__ __forceinline__ int rel_bucket(int rel) {
    const int n = rel < 0 ? -rel : rel; int b;
    if (n < 8) b = n; else if (n < 15) b = 8; else if (n < 27) b = 9; else if (n < 50) b = 10; else if (n < 91) b = 11; else if (n < 166) b = 12; else if (n < 305) b = 13; else if (n < 559) b = 14; else b = 15;
    return b + (rel > 0 ? 16 : 0);
}
__device__ __forceinline__ s16x4 vtr(LAS const unsigned char* p) { return __builtin_bit_cast(s16x4, __builtin_amdgcn_ds_read_tr16_b64_v4i16((LAS s16x4*)p)); }

template <int NCH, bool IS_A>
__device__ __forceinline__ void attn_task(LAS const unsigned char* ldsK, LAS const unsigned char* ldsV, LAS const float* tbl, LAS const float* pm, int kstart,
                                          bf16x8& qf0, bf16x8& qf1, const bf16* nq, bool has_nq, int qrel, float sink2, bf16* orow, float* lsep, int qi, int g, int abl = 0) {
    constexpr int NT = 2 * NCH;
    f32x4 s[NT];
    LAS const unsigned char* kp = ldsK + (kstart + qi) * KRS + g * 16;
    LAS const float* pmb = pm + (kstart + 4 * g);
    {
        bf16x8 ka[2][2][2]; f32x4 pz[2][2];
#pragma unroll
        for (int j = 0; j < 2; ++j) { ka[0][j][0] = *(LAS const bf16x8*)(kp + j * 16 * KRS); ka[0][j][1] = *(LAS const bf16x8*)(kp + j * 16 * KRS + 64); pz[0][j] = *(LAS const f32x4*)(pmb + 16 * j); }
#pragma unroll
        for (int tp = 0; tp < NT / 2; ++tp) { const int b = tp & 1;
            if (tp + 1 < NT / 2) {
#pragma unroll
                for (int j = 0; j < 2; ++j) { const int t = 2 * (tp + 1) + j; ka[b ^ 1][j][0] = *(LAS const bf16x8*)(kp + t * 16 * KRS); ka[b ^ 1][j][1] = *(LAS const bf16x8*)(kp + t * 16 * KRS + 64); pz[b ^ 1][j] = *(LAS const f32x4*)(pmb + 16 * t); } }
            __builtin_amdgcn_sched_barrier(0);
#pragma unroll
            for (int j = 0; j < 2; ++j) { f32x4 z = __builtin_amdgcn_mfma_f32_16x16x32_bf16(ka[b][j][0], qf0, pz[b][j], 0, 0, 0); s[2 * tp + j] = __builtin_amdgcn_mfma_f32_16x16x32_bf16(ka[b][j][1], qf1, z, 0, 0, 0); }
            __builtin_amdgcn_sched_barrier(0);
        }
    }
    if (has_nq) { qf0 = *(const bf16x8*)(nq + g * 8); qf1 = *(const bf16x8*)(nq + 32 + g * 8); }
    constexpr float C = 0.125f * LOG2E; const float NEG = -__builtin_inff();
    LAS const float* tb = tbl + (kstart + 4 * g - qrel + TBL / 2);
    float m = NEG;
    {
        float tv[2][8];
#pragma unroll
        for (int i = 0; i < 8; ++i) tv[0][i] = tb[16 * (i >> 2) + (i & 3)];
#pragma unroll
        for (int tp = 0; tp < NT / 2; ++tp) { const int b = tp & 1;
            if (tp + 1 < NT / 2) {
#pragma unroll
                for (int i = 0; i < 8; ++i) tv[b ^ 1][i] = tb[16 * (2 * (tp + 1) + (i >> 2)) + (i & 3)]; }
            __builtin_amdgcn_sched_barrier(0);
#pragma unroll
            for (int i = 0; i < 8; ++i) { const int t = 2 * tp + (i >> 2), r = i & 3; const float v = s[t][r] * C + tv[b][i]; s[t][r] = v; m = fmaxf(m, v); }
            __builtin_amdgcn_sched_barrier(0);
        }
    }
    m = fmaxf(m, __shfl_xor(m, 16)); m = fmaxf(m, __shfl_xor(m, 32));
    if (IS_A) m = fmaxf(m, sink2);
    float sum = 0.f;
#pragma unroll
    for (int t = 0; t < NT; ++t)
#pragma unroll
        for (int r = 0; r < 4; ++r) { const float p = __builtin_amdgcn_exp2f(s[t][r] - m); s[t][r] = p; sum += p; }
    sum += __shfl_xor(sum, 16); sum += __shfl_xor(sum, 32);
    if (IS_A) sum += __builtin_amdgcn_exp2f(sink2 - m);
    const float inv = __builtin_amdgcn_rcpf(sum);
    f32x4 o[4];
#pragma unroll
    for (int d = 0; d < 4; ++d) o[d] = (f32x4){0.f, 0.f, 0.f, 0.f};
    LAS const unsigned char* vp = ldsV + (kstart + 4 * g + (qi >> 2)) * VRS + (qi & 3) * 8;
    {
        s16x4 vl[2][4], vh[2][4];
#pragma unroll
        for (int d = 0; d < 4; ++d) { vl[0][d] = vtr(vp + d * 32); vh[0][d] = vtr(vp + 16 * VRS + d * 32); }
#pragma unroll
        for (int c = 0; c < NCH; ++c) { const int b = c & 1;
            if (c + 1 < NCH) {
#pragma unroll
                for (int d = 0; d < 4; ++d) { vl[b ^ 1][d] = vtr(vp + (32 * (c + 1)) * VRS + d * 32); vh[b ^ 1][d] = vtr(vp + (32 * (c + 1) + 16) * VRS + d * 32); } }
            v4u pw; pw.x = cvtpk(s[2 * c][0], s[2 * c][1]); pw.y = cvtpk(s[2 * c][2], s[2 * c][3]); pw.z = cvtpk(s[2 * c + 1][0], s[2 * c + 1][1]); pw.w = cvtpk(s[2 * c + 1][2], s[2 * c + 1][3]);
            const bf16x8 pb = __builtin_bit_cast(bf16x8, pw);
            __builtin_amdgcn_sched_barrier(0);
#pragma unroll
            for (int d = 0; d < 4; ++d) { const s16x4 lo = vl[b][d], hi = vh[b][d];
                const bf16x8 va = (bf16x8){lo[0], lo[1], lo[2], lo[3], hi[0], hi[1], hi[2], hi[3]};
                o[d] = __builtin_amdgcn_mfma_f32_16x16x32_bf16(va, pb, o[d], 0, 0, 0); }
            __builtin_amdgcn_sched_barrier(0);
        }
    }
    if (IS_A) { const float i8 = inv * 8.f;
#pragma unroll
        for (int d = 0; d < 4; ++d) *(unsigned*)((unsigned char*)orow + 16 * d + 4 * g) = pk4_fp8(o[d][0] * i8, o[d][1] * i8, o[d][2] * i8, o[d][3] * i8);
    } else {
#pragma unroll
        for (int d = 0; d < 4; ++d) { v2u w; w.x = cvtpk(o[d][0] * inv, o[d][1] * inv); w.y = cvtpk(o[d][2] * inv, o[d][3] * inv); if (!(abl & 1) || w.x == 0x12345678u) *(v2u*)(orow + 16 * d + 4 * g) = w; } }
    if (!IS_A) { if (g == 0 && !(abl & 1)) *lsep = m + __builtin_log2f(sum); }
}

struct Item { int isA, seq0, j0, Lr, Lre, dil, res, hs, pair;
    __device__ __forceinline__ int n() const { return isA ? 128 : 64; }
    __device__ __forceinline__ int nh() const { return isA ? 4 : 1; }
    __device__ __forceinline__ int kslot() const { return isA ? 8 + hs : 24 + hs; }
    __device__ __forceinline__ int vslot() const { return isA ? 10 + hs : 36 + hs; }
    __device__ __forceinline__ int qslot0() const { return isA ? hs * 4 : 12 + hs; }
    __device__ __forceinline__ int bcol0() const { return isA ? hs * 4 : 8 + hs; }
    __device__ __forceinline__ int key() const { return isA ? hs : 2 + hs; }
};
__device__ __forceinline__ Item decode(int k, int na0, int nA, int nb0) {
    Item I; int tok0;
    if (k < nA) { const int ia = na0 + k; I.isA = 1; I.hs = ia / (TT / 128); tok0 = (ia % (TT / 128)) * 128; I.dil = 1; }
    else { const int ib = nb0 + (k - nA); I.hs = ib / (TT / 256); I.isA = 0; const int gi = I.hs >> 2; tok0 = (ib % (TT / 256)) * 256; I.dil = gi == 0 ? 1 : (gi == 1 ? 4 : 16); }
    int L;
    if (tok0 < TP) { L = 2048; I.seq0 = (tok0 / 2048) * 2048; } else { L = 8192; I.seq0 = TP + ((tok0 - TP) / 8192) * 8192; }
    I.res = 0; I.j0 = tok0 - I.seq0; I.Lr = L; I.Lre = L; I.pair = 0;
    if (!I.isA) { I.Lr = L / I.dil; const int blk = (tok0 - I.seq0) / 256;
        if (I.Lr >= 256) { const int bpr = I.Lr / 256; I.res = blk / bpr; I.j0 = (blk % bpr) * 256; I.Lre = I.Lr; }
        else { I.res = 2 * blk; I.j0 = 0; I.Lre = 2 * I.Lr; I.pair = 1; } }
    return I;
}

__device__ __forceinline__ void attn_phase(LAS unsigned char* lds, const bf16* Z, const float* rel_bias, const float* sink, bf16* OA, bf16* OBG, float* LSE, int abl = 0) {
    int tid_l = threadIdx.x; asm volatile("" : "+v"(tid_l));
    const int tid = tid_l, lane = tid & 63, wave = __builtin_amdgcn_readfirstlane(tid >> 6), qi = lane & 15, g = lane >> 4;
    LAS unsigned char* ldsK = lds + L_K; LAS unsigned char* ldsV = lds + L_V; LAS float* tbl = (LAS float*)(lds + L_T); LAS float* pmt = (LAS float*)(lds + L_PM);
    const int G = gridDim.x, bx = blockIdx.x;
    const int na0 = (int)((long)bx * NITEM_A / G), nA = (int)((long)(bx + 1) * NITEM_A / G) - na0;
    const int nb0 = (int)((long)bx * NITEM_B / G), nB = (int)((long)(bx + 1) * NITEM_B / G) - nb0;
    const int nloc = nA + nB, r0 = tid >> 3, ch = tid & 7;
    v4u pk[6], pv[6];
#define ATT_ISSUE(I) do { _Pragma("unroll") for (int i_ = 0; i_ < 6; ++i_) { const int row_ = r0 + 64 * i_, kpos_ = (I).j0 - (I).n() + row_; pk[i_] = (v4u){0u, 0u, 0u, 0u}; pv[i_] = (v4u){0u, 0u, 0u, 0u}; \
        if ((unsigned)kpos_ < (unsigned)(I).Lre && !(abl & 2)) { const size_t ro_ = (size_t)((I).seq0 + (I).res * (I).Lr + kpos_) * 64 + ch * 8; pk[i_] = *(const v4u*)(Z + (size_t)(I).kslot() * TT * 64 + ro_); pv[i_] = *(const v4u*)(Z + (size_t)(I).vslot() * TT * 64 + ro_); } } } while (0)
    if (nloc <= 0) return;
    Item cur = decode(0, na0, nA, nb0), nxt = cur;
#define ATT_QT(I, i_) ((I).isA ? ((wave * 4 + (i_)) & 7) : (wave * 2 + (i_)))
#define ATT_QPTR(I, i_) (Z + ((size_t)((I).qslot0() + ((I).isA ? ((wave * 4 + (i_)) >> 3) : 0)) * TT + (I).seq0 + (I).res * (I).Lr + (I).j0 + 16 * ATT_QT(I, i_) + qi) * 64)
    bf16x8 q0, q1;
    { const bf16* qp = ATT_QPTR(cur, 0); q0 = *(const bf16x8*)(qp + g * 8); q1 = *(const bf16x8*)(qp + 32 + g * 8); }
    asm volatile("" ::: "memory");
    ATT_ISSUE(cur);
    int tkey = -1;
    for (int k = 0; k < nloc; ++k) {
        __syncthreads();
#pragma unroll
        for (int i = 0; i < 6; ++i) { const int row = r0 + 64 * i; *(LAS v4u*)(ldsK + row * KRS + ch * 16) = pk[i]; *(LAS v4u*)(ldsV + row * VRS + ch * 16) = pv[i];
            if (ch == 0) { const unsigned kp = (unsigned)(cur.j0 - cur.n() + row); const float ninf = -__builtin_inff();
                pmt[row] = (kp < (unsigned)(cur.pair ? cur.Lr : cur.Lre)) ? 0.f : ninf;
                pmt[NKS_MAX + row] = (cur.pair ? (kp - (unsigned)cur.Lr < (unsigned)cur.Lr) : (kp < (unsigned)cur.Lre)) ? 0.f : ninf; } }
        if (cur.key() != tkey) { tkey = cur.key();
            for (int i = tid; i < cur.nh() * TBL; i += 512) { const int h = i / TBL, rel = i % TBL - TBL / 2; const int ar = rel < 0 ? -rel : rel;
                tbl[i] = (ar <= cur.n()) ? rel_bias[rel_bucket(rel * cur.dil) * 20 + cur.bcol0() + h] * LOG2E : -__builtin_inff(); } }
        __syncthreads();
        const bool more = (k + 1 < nloc);
        if (more) { nxt = decode(k + 1, na0, nA, nb0); ATT_ISSUE(nxt); }
        asm volatile("" ::: "memory");
        const int ntask = cur.isA ? 4 : 2;
#ifdef ATT_DEPHASE
        if (wave >= 4) { if (cur.isA) __builtin_amdgcn_s_sleep(ATT_DEPHASE); else __builtin_amdgcn_s_sleep((ATT_DEPHASE * 5) / 8); }
#endif
#pragma unroll 1
        for (int i = 0; i < ntask; ++i) {
            const int qt = ATT_QT(cur, i); const bool lastt = (i + 1 == ntask);
            const bf16* nq = lastt ? ATT_QPTR(nxt, 0) : ATT_QPTR(cur, i + 1);
            const bool has_nq = !lastt || more;
            if (cur.isA) { const int h = (wave * 4 + i) >> 3, habs = cur.hs * 4 + h; const int qtok = cur.seq0 + cur.j0 + 16 * qt + qi; const int ks = qt < 6 ? 16 * qt : 96;
                attn_task<9, true>(ldsK, ldsV, tbl + h * TBL, pmt, ks, q0, q1, nq, has_nq, cur.n() + 16 * qt + qi, sink[habs] * LOG2E, (bf16*)((unsigned char*)OA + (size_t)qtok * 768 + habs * 64), nullptr, qi, g, abl);
            } else { const int jj = cur.j0 + 16 * qt + qi; const int jr = cur.pair ? (jj & (cur.Lr - 1)) : jj, rs = cur.res + (cur.pair ? (jj / cur.Lr) : 0);
                const int qtok = cur.seq0 + jr * cur.dil + rs; const int ks = qt < 14 ? 16 * qt : 224;
                attn_task<5, false>(ldsK, ldsV, tbl, pmt + (qt >> 3) * NKS_MAX, ks, q0, q1, nq, has_nq, cur.n() + 16 * qt + qi, 0.f, OBG + ((size_t)(cur.hs >> 2) * TT + qtok) * 256 + (cur.hs & 3) * 64, LSE + ((size_t)(cur.hs >> 2) * TT + qtok) * 4 + (cur.hs & 3), qi, g, abl);
            }
        }
        cur = nxt;
    }
    __syncthreads();
#undef ATT_ISSUE
#undef ATT_QPTR
#undef ATT_QT
}
}

#ifndef ABL_P2
#define ABL_P2 0
#endif
#ifndef REP_P0
#define REP_P0 1
#endif
#ifndef REP_P2B
#define REP_P2B 1
#endif
#ifndef REP_P3
#define REP_P3 1
#endif
#ifndef REP_P1
#define REP_P1 1
#endif
#ifndef REP_P2
#define REP_P2 1
#endif
#ifndef REP_P4
#define REP_P4 1
#endif
#ifndef REP_P5
#define REP_P5 1
#endif
__device__ __forceinline__ void grid_barrier(unsigned* ctr, unsigned target) {
    asm volatile("s_waitcnt vmcnt(0)" ::: "memory");
    __syncthreads();
    if (threadIdx.x == 0) {
        __builtin_amdgcn_fence(__ATOMIC_RELEASE, "agent");
        asm volatile("s_waitcnt vmcnt(0)" ::: "memory");
        __hip_atomic_fetch_add(ctr, 1u, __ATOMIC_RELAXED, __HIP_MEMORY_SCOPE_AGENT);
        unsigned spins = 0;
        while (__hip_atomic_load(ctr, __ATOMIC_RELAXED, __HIP_MEMORY_SCOPE_AGENT) < target) { __builtin_amdgcn_s_sleep(2); if (++spins > (1u << 24)) break; }
        __builtin_amdgcn_fence(__ATOMIC_ACQUIRE, "agent");
        asm volatile("s_waitcnt vmcnt(0)" ::: "memory");
    }
    __syncthreads();
}
#define GSYNC() do { ++bar_n; grid_barrier(bar_ctr, bar_n * (unsigned)G); } while (0)
struct Args { const float* in[14]; float* out; unsigned char* ws; };

__global__ void __launch_bounds__(512, 2) mk_fwd(Args a) {
    extern __shared__ __attribute__((aligned(16))) unsigned char lds_raw[];
    LAS unsigned char* lds = (LAS unsigned char*)lds_raw;
    cg::grid_group grid = cg::this_grid();
    const int tid = threadIdx.x, lane = tid & 63, wave = __builtin_amdgcn_readfirstlane(tid >> 6);
    const int G = gridDim.x, bx = blockIdx.x;
    const float* x_p = a.in[0]; const float* x_s = a.in[1]; const float* rel_bias = a.in[2]; const float* g_mix = a.in[3]; const float* w_in = a.in[4]; const float* b_gate = a.in[5];
    const float* w_a = a.in[6]; const float* w_b = a.in[7]; const float* w_out = a.in[8]; const float* sink = a.in[9]; const float* g_mlp = a.in[10]; const float* w_up = a.in[11]; const float* w_dn = a.in[12]; const float* g_fin = a.in[13];
    unsigned char* ws = a.ws; float* out = a.out;
    bf16* Win_t = (bf16*)(ws + WS_WIN); bf16* Wa_t = (bf16*)(ws + WS_WA); bf16* Wb_t = (bf16*)(ws + WS_WB); bf16* Wout_t = (bf16*)(ws + WS_WOUT); bf16* Wup_t = (bf16*)(ws + WS_WUP); bf16* Wdn_t = (bf16*)(ws + WS_WDN);
    float* SSQ1 = (float*)(ws + WS_SSQ1); float* SSQ2 = (float*)(ws + WS_SSQ2);
    bf16* XN = (bf16*)(ws + WS_XN); bf16* OA = (bf16*)(ws + WS_OA); bf16* OB = (bf16*)(ws + WS_OB); bf16* X1B = (bf16*)(ws + WS_X1B);
    bf16* Zb = (bf16*)(ws + WS_Z); bf16* MRG = (bf16*)(ws + WS_MRG); bf16* Hb = (bf16*)(ws + WS_H); bf16* Gt = (bf16*)(ws + WS_G);
    bf16* OBG = (bf16*)((unsigned char*)out + DO_OBG); float* LSE = (float*)((unsigned char*)out + DO_LSE);
    grid.sync();
    const int gw = bx * 8 + wave, NGW = G * 8;
    unsigned* bar_ctr = (unsigned*)ws; unsigned bar_n = 0;
    const unsigned my_xcc = (unsigned)__builtin_amdgcn_s_getreg((3 << 11) | 20) & 0xFu;
    if (tid == 0) *(LAS unsigned*)(lds + RING_BYTES + 64) = __hip_atomic_fetch_add(bar_ctr + 512 + 64 * (my_xcc & 7u), 1u, __ATOMIC_RELAXED, __HIP_MEMORY_SCOPE_AGENT);

    for (int rep0 = 0; rep0 < REP_P0; ++rep0) {
        LAS float* scr = (LAS float*)(lds + wave * 16384);
        constexpr int I_IN = (DM / 64) * (NIN / 32), I_A = (512 / 64) * (DM / 32), I_B = (256 / 64) * (DM / 32), I_O = (DM / 64) * (DM / 32), I_U = (DM / 64) * (DFF / 32), I_D = (DFF / 64) * (DM / 32);
        constexpr int NIT = I_IN + I_A + I_B + I_O + I_U + I_D;
        for (int it = gw; it < NIT; it += NGW) {
            int r = it;
            if (r < I_IN) { p0_transpose_item_fp8(w_in, DM, NIN, (unsigned char*)Win_t, scr, r, lane, 32.f); continue; } r -= I_IN;
            if (r < I_A) { p0_transpose_item_fp8(w_a, 512, DM, (unsigned char*)Wa_t, scr, r, lane, 16.f, 768, 0); continue; }     r -= I_A;
            if (r < I_B) { p0_transpose_item_fp8(w_b, 256, DM, (unsigned char*)Wa_t, scr, r, lane, 16.f, 768, 512); continue; }     r -= I_B;
            if (r < I_O) { p0_transpose_item_fp8(w_out, DM, DM, (unsigned char*)Wout_t, scr, r, lane, 32.f); continue; } r -= I_O;
            if (r < I_U) { p0_transpose_item(w_up, DM, DFF, Wup_t, g_mlp, scr, r, lane); continue; } r -= I_U;
            p0_transpose_item(w_dn, DFF, DM, Wdn_t, nullptr, scr, r, lane);
        }
        f32x4 gv[4];
#pragma unroll
        for (int j = 0; j < 4; ++j) gv[j] = ((const f32x4*)g_mix)[lane + 64 * j];
        for (int m = gw; m < TT; m += 2 * NGW) {
            const int m2 = m + NGW; const bool has2 = m2 < TT;
            const float* xrow = (m < TP) ? x_p + (size_t)m * DM : x_s + (size_t)(m - TP) * DM;
            const float* xrow2 = has2 ? ((m2 < TP) ? x_p + (size_t)m2 * DM : x_s + (size_t)(m2 - TP) * DM) : xrow;
            const f32x4* xr = (const f32x4*)xrow + lane; const f32x4* xr2 = (const f32x4*)xrow2 + lane; f32x4 v[4], w2[4]; float s2 = 0.f, t2 = 0.f;
#pragma unroll
            for (int j = 0; j < 4; ++j) { v[j] = xr[64 * j]; w2[j] = xr2[64 * j]; }
#pragma unroll
            for (int j = 0; j < 4; ++j) { s2 += (v[j].x * v[j].x + v[j].y * v[j].y) + (v[j].z * v[j].z + v[j].w * v[j].w); t2 += (w2[j].x * w2[j].x + w2[j].y * w2[j].y) + (w2[j].z * w2[j].z + w2[j].w * w2[j].w); }
            const float rs = __builtin_amdgcn_rsqf(wave_sum(s2) * (1.f / DM) + RMS_EPS), rt = __builtin_amdgcn_rsqf(wave_sum(t2) * (1.f / DM) + RMS_EPS);
            unsigned* o8 = (unsigned*)((unsigned char*)XN + (size_t)m * DM) + lane;
#pragma unroll
            for (int j = 0; j < 4; ++j) o8[64 * j] = pk4_fp8(v[j].x * rs * gv[j].x, v[j].y * rs * gv[j].y, v[j].z * rs * gv[j].z, v[j].w * rs * gv[j].w);
            if (has2) { unsigned* p8 = (unsigned*)((unsigned char*)XN + (size_t)m2 * DM) + lane;
#pragma unroll
                for (int j = 0; j < 4; ++j) p8[64 * j] = pk4_fp8(w2[j].x * rt * gv[j].x, w2[j].y * rt * gv[j].y, w2[j].z * rt * gv[j].z, w2[j].w * rt * gv[j].w); }
        }
    }
    GSYNC();
    int vbx = bx;
    { LAS int* vslot = (LAS int*)(lds + RING_BYTES);
      if (threadIdx.x == 0) { const unsigned my_rank = *(LAS unsigned*)(lds + RING_BYTES + 64); bool ok = (G % 8 == 0) && (my_xcc < 8u);
          for (int j = 0; j < 8; ++j) ok = ok && (__hip_atomic_load(bar_ctr + 512 + 64 * j, __ATOMIC_RELAXED, __HIP_MEMORY_SCOPE_AGENT) == (unsigned)(G / 8));
          *vslot = ok ? (int)(my_rank * 8u + my_xcc) : bx; }
      __syncthreads(); vbx = __builtin_amdgcn_readfirstlane(*vslot); }
#ifndef NO_P1
#ifdef STAGGER
    if ((bx & 7) >= 4) { for (int z_ = 0; z_ < STAGGER; ++z_) __builtin_amdgcn_s_sleep(127); }
#endif
    for (int rep = 0; rep < REP_P1; ++rep) { pg8::Gemm g{XN, Win_t, TT, NIN, DM / 2, 0x7F7F7F7F}; pg8::StaticOrder S; S.init(TT, NIN, G, vbx); pg8::EpiIn E{Zb, Gt, b_gate};
      pg8::gemm_phase<pg8::EpiIn, pg8::StaticOrder, true, true, true>(lds, g, S, E); }
#endif
    GSYNC();
#ifndef NO_P2
    for (int rep = 0; rep < REP_P2; ++rep) att::attn_phase(lds, Zb, rel_bias, sink, OA, OBG, LSE, rep ? ABL_P2 : 0);
#endif
    GSYNC();
#ifndef NO_P2B
#ifdef EXTRA_BAR
    for (int e_ = 0; e_ < EXTRA_BAR; ++e_) GSYNC();
#endif
    for (int repb = 0; repb < REP_P2B; ++repb)
    for (unsigned idx = (unsigned)bx * 512u + (unsigned)threadIdx.x; idx < (unsigned)TT * 32u; idx += (unsigned)G * 512u) {
        const size_t tok = idx >> 5; const int part = (int)(idx & 31u), hh = part >> 3;
        const float l0 = LSE[tok * 4 + hh], l1 = LSE[((size_t)TT + tok) * 4 + hh], l2 = LSE[((size_t)2 * TT + tok) * 4 + hh];
        const float mx = fmaxf(l0, fmaxf(l1, l2)); float w0 = __builtin_amdgcn_exp2f(l0 - mx), w1 = __builtin_amdgcn_exp2f(l1 - mx), w2 = __builtin_amdgcn_exp2f(l2 - mx);
        const float inv = 1.f / (w0 + w1 + w2); w0 *= inv; w1 *= inv; w2 *= inv;
        const v4u a0 = *(const v4u*)(OBG + tok * 256 + part * 8), a1 = *(const v4u*)(OBG + ((size_t)TT + tok) * 256 + part * 8), a2 = *(const v4u*)(OBG + ((size_t)2 * TT + tok) * 256 + part * 8);
        w0 *= 8.f; w1 *= 8.f; w2 *= 8.f;
        v2u o;
        o.x = pk4_fp8(w0 * bf_lo(a0.x) + w1 * bf_lo(a1.x) + w2 * bf_lo(a2.x), w0 * bf_hi(a0.x) + w1 * bf_hi(a1.x) + w2 * bf_hi(a2.x), w0 * bf_lo(a0.y) + w1 * bf_lo(a1.y) + w2 * bf_lo(a2.y), w0 * bf_hi(a0.y) + w1 * bf_hi(a1.y) + w2 * bf_hi(a2.y));
        o.y = pk4_fp8(w0 * bf_lo(a0.z) + w1 * bf_lo(a1.z) + w2 * bf_lo(a2.z), w0 * bf_hi(a0.z) + w1 * bf_hi(a1.z) + w2 * bf_hi(a2.z), w0 * bf_lo(a0.w) + w1 * bf_lo(a1.w) + w2 * bf_lo(a2.w), w0 * bf_hi(a0.w) + w1 * bf_hi(a1.w) + w2 * bf_hi(a2.w));
        *(v2u*)((unsigned char*)OA + tok * 768 + 512 + part * 8) = o;
    }
#endif
    GSYNC();
#ifndef NO_P3
    { pg8::Gemm g{OA, Wa_t, TT, DM, 768 / 2}; pg8::StaticOrder S; S.init(TT, DM, G, vbx); pg8::EpiGate2 E{MRG, (const unsigned char*)Gt};
      pg8::gemm_phase<pg8::EpiGate2, pg8::StaticOrder, true, true, true>(lds, g, S, E); }
#endif
    GSYNC();
#ifndef NO_P4
    for (int rep = 0; rep < REP_P4; ++rep) { pg8::Gemm g{MRG, Wout_t, TT, DM, DM / 2}; pg8::StaticOrder S; S.init(TT, DM, G, vbx); pg8::EpiRes<true> E{x_p, x_s, out, X1B, SSQ1, 1.f / 512.f};
      pg8::gemm_phase<pg8::EpiRes<true>, pg8::StaticOrder, true, true, true>(lds, g, S, E); }
#endif
    GSYNC();
#ifndef NO_P5
#ifdef STAGGER
    if ((bx & 7) >= 4) { for (int z_ = 0; z_ < STAGGER; ++z_) __builtin_amdgcn_s_sleep(127); }
#endif
    for (int rep = 0; rep < REP_P5; ++rep) { pg8::Gemm g{X1B, Wup_t, TT, DFF, DM}; pg8::StaticOrder S; S.init(TT, DFF, G, vbx); pg8::EpiUp E{Hb, SSQ1};
      pg8::gemm_phase<pg8::EpiUp, pg8::StaticOrder, true, true>(lds, g, S, E); }
#endif
    GSYNC();
#ifndef NO_P6
    { pg8::Gemm g{Hb, Wdn_t, TT, DM, DFF}; pg8::StaticOrder S; S.init(TT, DM, G, vbx); pg8::EpiFinal E{out, X1B, SSQ2, bar_ctr + 1024, g_fin};
      pg8::gemm_phase<pg8::EpiFinal, pg8::StaticOrder, true, true>(lds, g, S, E); }
#endif
}

extern "C" void kernel_launch(void* const* d_in, const int* in_sizes, int n_in, void* d_out, int out_size, void* d_ws, size_t ws_size, hipStream_t stream) {
    static int grid = 0;
    if (grid == 0) {
        if (n_in != 14 || ws_size < WS_END || out_size != TT * DM) { fprintf(stderr, "kernel_launch: unexpected shapes (n_in %d, ws %zu, out %d)\n", n_in, ws_size, out_size); grid = -1; return; }
        int dev = 0, cus = 0, per_cu = 0;
        hipGetDevice(&dev); hipDeviceGetAttribute(&cus, hipDeviceAttributeMultiprocessorCount, dev);
        if (hipFuncSetAttribute((const void*)mk_fwd, hipFuncAttributeMaxDynamicSharedMemorySize, LDS_BYTES) != hipSuccess) { fprintf(stderr, "kernel_launch: hipFuncSetAttribute failed\n"); grid = -1; return; }
        if (hipOccupancyMaxActiveBlocksPerMultiprocessor(&per_cu, (const void*)mk_fwd, 512, LDS_BYTES) != hipSuccess || per_cu < 1) { fprintf(stderr, "kernel_launch: occupancy query failed (%d)\n", per_cu); (void)hipGetLastError(); per_cu = 1; }
        grid = cus * per_cu;
        if (grid != 256) fprintf(stderr, "kernel_launch: grid %d != 256: the fused final-norm exchange assumes 256 workgroups (waits are bounded, results would be wrong)\n", grid);
    }
    if (grid < 0) return;
    if (hipMemsetAsync(d_ws, 0, 131072, stream) != hipSuccess) { fprintf(stderr, "kernel_launch: memset of the barrier words failed\n"); return; }
    Args a{};
    for (int i = 0; i < 14; ++i) a.in[i] = (const float*)d_in[i];
    a.out = (float*)d_out; a.ws = (unsigned char*)d_ws;
    void* args[] = {&a};
    hipError_t e = hipLaunchCooperativeKernel((const void*)mk_fwd, dim3(grid), dim3(512), args, LDS_BYTES, stream);
    if (e != hipSuccess) fprintf(stderr, "cooperative launch failed: %s (grid %d)\n", hipGetErrorString(e), grid);
}
```
